# Optimizing an MI355X kernel written in HIP

```python
import numpy as np
import jax, jax.numpy as jnp
from jax import lax

D_MODEL = 2048
BATCH = 2
SEQ = 4096
DEPTH = 4

D_MIX = D_MODEL
GLA_HEADS = 4
GLA_DK = 64
GLA_DV = 128
GLA_GATE_RANK = 16
GLA_GATE_NORMALIZER = 16.0
HGRN_HEADS = 4
HGRN_DK = 128
HGRN_DV = 128
MLA_HEADS = 8
MLA_Q_RANK = 512
MLA_KV_RANK = 512
MLA_NOPE = 128
MLA_ROPE = 64
MLA_DV = 128
ROPE_THETA = 10000.0
D_FF = -(-8 * D_MODEL // (3 * 256)) * 256
CHUNK = 64
Q_BLOCK = 128
EPS = 1e-6

IN_SIZES = (
    GLA_HEADS * GLA_DK,
    GLA_HEADS * GLA_DK,
    GLA_HEADS * GLA_DV,
    GLA_GATE_RANK,
    GLA_HEADS * GLA_DV,
    HGRN_HEADS * HGRN_DK,
    HGRN_HEADS * HGRN_DK,
    HGRN_HEADS * HGRN_DV,
    HGRN_HEADS * HGRN_DV,
    MLA_Q_RANK,
    MLA_KV_RANK,
    MLA_ROPE,
)
D_IN = sum(IN_SIZES)

kernel_name = "hybrid_gla_hgrn2_mla_sandwich_trunk"


def rms_norm(x, gain):
    xf = x.astype(jnp.float32)
    y = xf * lax.rsqrt(jnp.mean(xf * xf, axis=-1, keepdims=True) + EPS)
    return (y * gain.astype(jnp.float32)).astype(x.dtype)


def gated_head_norm(o, gate, gain):
    B, S, H, dv = o.shape
    y = rms_norm(o, gain) * jax.nn.silu(gate.reshape(B, S, H, dv))
    return y.reshape(B, S, H * dv)


def heads(t, n):
    B, S, _ = t.shape
    return t.reshape(B, S, n, -1).transpose(0, 2, 1, 3)


def chunk_gated_linear_attention(q, k, v, log_g, scale):
    B, H, T, dk = q.shape
    dv = v.shape[-1]
    n = T // CHUNK

    def to_chunks(t):
        return t.astype(jnp.float32).reshape(B, H, n, CHUNK, t.shape[-1]).transpose(2, 0, 1, 3, 4)

    qc, kc, vc, gc = to_chunks(q) * scale, to_chunks(k), to_chunks(v), to_chunks(log_g)
    causal = jnp.tril(jnp.ones((CHUNK, CHUNK), dtype=bool))

    def step(S, inp):
        qi, ki, vi, gi = inp
        b = jnp.cumsum(gi, axis=-2)
        diff = b[..., :, None, :] - b[..., None, :, :]
        decay = jnp.exp(jnp.where(causal[:, :, None], diff, -jnp.inf))
        A = jnp.einsum('bhid,bhijd,bhjd->bhij', qi, decay, ki)
        o = A @ vi + jnp.einsum('bhid,bhde->bhie', qi * jnp.exp(b), S)
        b_last = b[..., -1:, :]
        S = jnp.exp(b_last[..., 0, :])[..., None] * S + jnp.einsum(
            'bhjd,bhje->bhde', ki * jnp.exp(b_last - b), vi)
        return S, o

    S0 = jnp.zeros((B, H, dk, dv), jnp.float32)
    _, o = lax.scan(step, S0, (qc, kc, vc, gc))
    return o.transpose(1, 2, 0, 3, 4).reshape(B, H, T, dv)


def apply_rope(x, cos, sin):
    xf = x.astype(jnp.float32)
    x1, x2 = jnp.split(xf, 2, axis=-1)
    y = jnp.concatenate([x1 * cos - x2 * sin, x2 * cos + x1 * sin], axis=-1)
    return y.astype(x.dtype)


def causal_mla_attention(q_nope, q_pe, k_nope, k_pe, v):
    B, H, T, dn = q_nope.shape
    dv = v.shape[-1]
    nb = T // Q_BLOCK
    scale = (MLA_NOPE + MLA_ROPE) ** -0.5
    qn = q_nope.reshape(B, H, nb, Q_BLOCK, dn).transpose(2, 0, 1, 3, 4)
    qp = q_pe.reshape(B, H, nb, Q_BLOCK, MLA_ROPE).transpose(2, 0, 1, 3, 4)
    starts = jnp.arange(nb, dtype=jnp.int32) * Q_BLOCK
    key_idx = jnp.arange(T, dtype=jnp.int32)

    def block(args):
        qn_b, qp_b, start = args
        s = (jnp.einsum('bhqd,bhkd->bhqk', qn_b, k_nope)
             + jnp.einsum('bhqr,bkr->bhqk', qp_b, k_pe)).astype(jnp.float32) * scale
        q_idx = start + jnp.arange(Q_BLOCK, dtype=jnp.int32)
        s = jnp.where(key_idx[None, :] <= q_idx[:, None], s, -jnp.inf)
        p = jax.nn.softmax(s, axis=-1).astype(v.dtype)
        return jnp.einsum('bhqk,bhkd->bhqd', p, v)

    o = lax.map(block, (qn, qp, starts))
    return o.transpose(1, 0, 3, 2, 4).reshape(B, T, H, dv)


def hybrid_mixer(h, cos, sin, lb, w_in, gla_gate_w2, gla_gate_b, gla_out_norm, hgrn_out_norm,
                 mla_q_norm, mla_wq_b, mla_kv_norm, mla_wkv_b, mla_out_norm, w_out):
    B, S, _ = h.shape
    proj = h @ w_in
    split_at = [int(c) for c in np.cumsum(IN_SIZES)[:-1]]
    (gq, gk, gv, g_low, g_out, hq, hf, hi, h_out, qc, kvc, kpe) = jnp.split(proj, split_at, axis=-1)

    log_a = jax.nn.log_sigmoid((g_low @ gla_gate_w2 + gla_gate_b).astype(jnp.float32)) / GLA_GATE_NORMALIZER
    o_gla = chunk_gated_linear_attention(heads(gq, GLA_HEADS), heads(gk, GLA_HEADS), heads(gv, GLA_HEADS),
                                         heads(log_a, GLA_HEADS), GLA_DK ** -0.5)
    y_gla = gated_head_norm(o_gla.transpose(0, 2, 1, 3).astype(h.dtype), g_out, gla_out_norm)

    log_f = jnp.logaddexp(jnp.log(lb), jnp.log1p(-lb) + jax.nn.log_sigmoid(hf.astype(jnp.float32)))
    k_h = 1.0 - jnp.exp(log_f)
    o_hg = chunk_gated_linear_attention(heads(jax.nn.silu(hq), HGRN_HEADS), heads(k_h, HGRN_HEADS),
                                        heads(hi, HGRN_HEADS), heads(log_f, HGRN_HEADS), 1.0)
    y_hg = gated_head_norm(o_hg.transpose(0, 2, 1, 3).astype(h.dtype), h_out, hgrn_out_norm)

    q = (rms_norm(qc, mla_q_norm) @ mla_wq_b).reshape(B, S, MLA_HEADS, MLA_NOPE + MLA_ROPE)
    q_nope, q_pe = q[..., :MLA_NOPE], apply_rope(q[..., MLA_NOPE:], cos[:, :, None, :], sin[:, :, None, :])
    kv = (rms_norm(kvc, mla_kv_norm) @ mla_wkv_b).reshape(B, S, MLA_HEADS, MLA_NOPE + MLA_DV)
    k_nope, v = kv[..., :MLA_NOPE], kv[..., MLA_NOPE:]
    k_pe = apply_rope(kpe, cos, sin)
    o_mla = causal_mla_attention(q_nope.transpose(0, 2, 1, 3), q_pe.transpose(0, 2, 1, 3),
                                 k_nope.transpose(0, 2, 1, 3), k_pe, v.transpose(0, 2, 1, 3))
    y_mla = rms_norm(o_mla.reshape(B, S, MLA_HEADS * MLA_DV), mla_out_norm)

    return jnp.concatenate([y_gla, y_hg, y_mla], axis=-1) @ w_out


def setup_inputs(seed: int = 0) -> dict:
    key = jax.random.key(seed)
    ks = jax.random.split(key, 24)
    L = DEPTH

    def w(k, shape, fan_in):
        return jax.random.normal(k, shape, jnp.float32) * fan_in ** -0.5

    def gain(k, shape):
        return 1.0 + 0.02 * jax.random.normal(k, shape, jnp.float32)

    return {
        "x": jax.random.normal(ks[0], (BATCH, SEQ, D_MODEL), jnp.float32),
        "positions": jnp.broadcast_to(jnp.arange(SEQ, dtype=jnp.int32), (BATCH, SEQ)),
        "attn_pre_norm": gain(ks[1], (L, D_MODEL)),
        "w_in": w(ks[2], (L, D_MODEL, D_IN), D_MODEL),
        "gla_gate_w2": w(ks[3], (L, GLA_GATE_RANK, GLA_HEADS * GLA_DK), GLA_GATE_RANK),
        "gla_gate_b": 0.1 * jax.random.normal(ks[4], (L, GLA_HEADS * GLA_DK), jnp.float32),
        "gla_out_norm": gain(ks[5], (L, GLA_DV)),
        "hgrn_lb_logits": 0.5 * jax.random.normal(ks[6], (L, HGRN_HEADS * HGRN_DK), jnp.float32),
        "hgrn_out_norm": gain(ks[7], (L, HGRN_DV)),
        "mla_q_norm": gain(ks[8], (L, MLA_Q_RANK)),
        "mla_wq_b": w(ks[9], (L, MLA_Q_RANK, MLA_HEADS * (MLA_NOPE + MLA_ROPE)), MLA_Q_RANK),
        "mla_kv_norm": gain(ks[10], (L, MLA_KV_RANK)),
        "mla_wkv_b": w(ks[11], (L, MLA_KV_RANK, MLA_HEADS * (MLA_NOPE + MLA_DV)), MLA_KV_RANK),
        "mla_out_norm": gain(ks[12], (L, MLA_HEADS * MLA_DV)),
        "w_out": w(ks[13], (L, D_MIX, D_MODEL), D_MIX),
        "attn_post_norm": gain(ks[14], (L, D_MODEL)),
        "ffn_pre_norm": gain(ks[15], (L, D_MODEL)),
        "w_gate": w(ks[16], (L, D_MODEL, D_FF), D_MODEL),
        "w_up": w(ks[17], (L, D_MODEL, D_FF), D_MODEL),
        "w_down": w(ks[18], (L, D_FF, D_MODEL), D_FF),
        "ffn_post_norm": gain(ks[19], (L, D_MODEL)),
    }


def reference(x, positions, attn_pre_norm, w_in, gla_gate_w2, gla_gate_b, gla_out_norm,
              hgrn_lb_logits, hgrn_out_norm, mla_q_norm, mla_wq_b, mla_kv_norm, mla_wkv_b,
              mla_out_norm, w_out, attn_post_norm, ffn_pre_norm, w_gate, w_up, w_down, ffn_post_norm):
    inv_freq = ROPE_THETA ** (-jnp.arange(0, MLA_ROPE, 2, dtype=jnp.float32) / MLA_ROPE)
    ang = positions.astype(jnp.float32)[..., None] * inv_freq
    cos, sin = jnp.cos(ang), jnp.sin(ang)
    cs = jnp.cumsum(jax.nn.softmax(hgrn_lb_logits.astype(jnp.float32), axis=0), axis=0)
    lower_bounds = cs - cs[0]

    for l in range(DEPTH):
        h = rms_norm(x, attn_pre_norm[l])
        m = hybrid_mixer(h, cos, sin, lower_bounds[l], w_in[l], gla_gate_w2[l], gla_gate_b[l],
                         gla_out_norm[l], hgrn_out_norm[l], mla_q_norm[l], mla_wq_b[l],
                         mla_kv_norm[l], mla_wkv_b[l], mla_out_norm[l], w_out[l])
        x = x + rms_norm(m, attn_post_norm[l])
        u = rms_norm(x, ffn_pre_norm[l])
        f = (jax.nn.silu(u @ w_gate[l]) * (u @ w_up[l])) @ w_down[l]
        x = x + rms_norm(f, ffn_post_norm[l])
    return x
```

```cpp
#include <hip/hip_runtime.h>
#include <hip/hip_cooperative_groups.h>
#include <cstdio>
#include <cstdint>
namespace cg = cooperative_groups;
#ifndef MK_PER_PHASE
#define MK_PER_PHASE 0
#endif
namespace pg8 {
#define PG8_LAS __attribute__((address_space(3)))
typedef unsigned short bf16_t;
typedef short bf16x8 __attribute__((ext_vector_type(8)));
typedef float f32x4 __attribute__((ext_vector_type(4)));
typedef unsigned u32x4 __attribute__((ext_vector_type(4)));
constexpr int BM = 256, BK = 64, HALF = 128, HTB = HALF * BK * 2  , STAGE_BYTES = 8 * HTB, NXCD = 8, WGM = 8;

__host__ __device__ __forceinline__ int lds_byte(int r, int c) { const int st = (r >> 4) * 2 + (c >> 5), rr = r & 15, cc = c & 31, ob = rr * 64 + cc * 2; return st * 1024 + (ob ^ (((ob >> 9) & 1) << 5)); }
__host__ __device__ __forceinline__ void stage_rc(int b, int& R, int& C) { const int st = b / 1024, sb = b % 1024, swz = sb ^ (((sb >> 9) & 1) << 5); R = (st >> 1) * 16 + swz / 64; C = (st & 1) * 32 + (swz % 64) / 2; }
__host__ __device__ __forceinline__ int perm32(int rho) { const int n = rho >> 4, i = rho & 15; return 8 * (i >> 2) + 4 * n + (i & 3); }

struct Unit { int pm, pn; };
struct Gemm { const bf16_t* A; const bf16_t* Bt; int M, N, K, lda, ldb; };

struct StaticOrder {
    int nM, nN, nwg, G, c;
    __host__ __device__ void init(int M, int N, int G_, int c_) { nM = M / BM; nN = N / BM; nwg = nM * nN; G = G_; c = c_; }
    __host__ __device__ bool next(int i, Unit& u) const {
        const long L = (long)i * G + c; if (L >= nwg) return false;
        int wgid = (int)L; { const int q = nwg / NXCD, r = nwg % NXCD, xcd = wgid % NXCD, off = wgid / NXCD; wgid = (xcd < r ? xcd * (q + 1) : r * (q + 1) + (xcd - r) * q) + off; }
        const int nig = WGM * nN, gid = wgid / nig, fm = gid * WGM, gsz = (nM - fm) < WGM ? (nM - fm) : WGM;
        u.pm = fm + ((wgid % nig) % gsz); u.pn = (wgid % nig) / gsz; return true;
    }
    __device__ __forceinline__ void a_ready(const Unit&) const {}
    __device__ __forceinline__ void done(const Unit&) const {}
};

__device__ __forceinline__ unsigned cvt_pk_bf16(float lo, float hi) { unsigned r; asm volatile("v_cvt_pk_bf16_f32 %0, %1, %2" : "=v"(r) : "v"(lo), "v"(hi)); return r; }
typedef float f32x2 __attribute__((ext_vector_type(2)));
__device__ __forceinline__ float quad_col_sum(float v) { v += __shfl_xor(v, 16); v += __shfl_xor(v, 32); return v; }
struct EpiRow {
    static constexpr bool PERM = true, AFTER_DRAIN = false;
    bf16_t* O; int ldc; const float* rs; int rs_ld, rs_n; float rs_mul; float eps;
    float* ps; int ps_ld, pn_lo, pn_hi;
    __device__ __forceinline__ void operator()(const f32x4 (&acc)[2][2][4][2], const Unit& u, int wr, int wc, int fr, int fq) const {
        const int row0 = u.pm * BM + wr * 64 + fr, col0 = u.pn * BM + wc * 32 + 8 * fq;
        float* sq = (ps && u.pn >= pn_lo && u.pn < pn_hi) ? ps + (u.pn - pn_lo) * 4 + wc : nullptr;
#pragma unroll
        for (int ai = 0; ai < 2; ++ai)
#pragma unroll
            for (int m = 0; m < 4; ++m) { const int row = row0 + ai * HALF + m * 16; bf16_t* rowp = O + (size_t)row * ldc + col0;
                float sc = 1.f; if (rs) { if (rs_n == 0) sc = rs[row]; else { float t = 0.f; for (int i = 0; i < rs_n; i += 4) { const f32x4 q = *(const f32x4*)(rs + (size_t)row * rs_ld + i); t += (q[0] + q[1]) + (q[2] + q[3]); } sc = __builtin_amdgcn_rsqf(t * rs_mul + eps); } }
                float ss = 0.f;
#pragma unroll
                for (int bj = 0; bj < 2; ++bj) { f32x4 v0 = acc[ai][bj][m][0] * sc, v1 = acc[ai][bj][m][1] * sc;
                    ss += (v0[0] * v0[0] + v0[1] * v0[1]) + (v0[2] * v0[2] + v0[3] * v0[3]) + (v1[0] * v1[0] + v1[1] * v1[1]) + (v1[2] * v1[2] + v1[3] * v1[3]);
                    u32x4 w; w.x = cvt_pk_bf16(v0[0], v0[1]); w.y = cvt_pk_bf16(v0[2], v0[3]); w.z = cvt_pk_bf16(v1[0], v1[1]); w.w = cvt_pk_bf16(v1[2], v1[3]);
                    *(u32x4*)(rowp + bj * HALF) = w; }
                if (sq) { ss = quad_col_sum(ss); if (fq == 0) sq[(size_t)row * ps_ld] = ss; } }
    }
};
struct EpiQ {
    static constexpr bool PERM = true, AFTER_DRAIN = false;
    bf16_t* O; const float* ssq; float eps; float qscale; const float* ctab; const float* stab;
    __device__ __forceinline__ void operator()(const f32x4 (&acc)[2][2][4][2], const Unit& u, int wr, int wc, int fr, int fq) const {
        const int row0 = u.pm * BM + wr * 64 + fr; const bool rope = u.pn >= 4;
#pragma unroll
        for (int ai = 0; ai < 2; ++ai)
#pragma unroll
            for (int m = 0; m < 4; ++m) { const int row = row0 + ai * HALF + m * 16; const f32x4 s0 = *(const f32x4*)(ssq + (size_t)row * 16), s1 = *(const f32x4*)(ssq + (size_t)row * 16 + 4);
                const float sc = __builtin_amdgcn_rsqf((((s0[0] + s0[1]) + (s0[2] + s0[3])) + ((s1[0] + s1[1]) + (s1[2] + s1[3]))) * (1.f / 512.f) + eps) * qscale;
#pragma unroll
                for (int bj = 0; bj < 2; ++bj) { f32x4 v0 = acc[ai][bj][m][0] * sc, v1 = acc[ai][bj][m][1] * sc; int dst;
                    if (!rope) { const int c = u.pn * BM + bj * HALF + wc * 32 + 8 * fq; dst = (c >> 7) * 192 + (c & 127); }
                    else { const int c = (u.pn - 4) * BM + bj * HALF + wc * 32 + 8 * fq; const int hh = c >> 6, j = c & 63; dst = hh * 192 + 128 + j;
                        const f32x4 cs = *(const f32x4*)(ctab + (size_t)row * 32 + (j >> 1)), sn = *(const f32x4*)(stab + (size_t)row * 32 + (j >> 1));
                        f32x4 a0, a1; a0[0] = v0[0] * cs[0] - v0[1] * sn[0]; a0[1] = v0[1] * cs[0] + v0[0] * sn[0]; a0[2] = v0[2] * cs[1] - v0[3] * sn[1]; a0[3] = v0[3] * cs[1] + v0[2] * sn[1];
                        a1[0] = v1[0] * cs[2] - v1[1] * sn[2]; a1[1] = v1[1] * cs[2] + v1[0] * sn[2]; a1[2] = v1[2] * cs[3] - v1[3] * sn[3]; a1[3] = v1[3] * cs[3] + v1[2] * sn[3]; v0 = a0; v1 = a1; }
                    u32x4 w; w.x = cvt_pk_bf16(v0[0], v0[1]); w.y = cvt_pk_bf16(v0[2], v0[3]); w.z = cvt_pk_bf16(v1[0], v1[1]); w.w = cvt_pk_bf16(v1[2], v1[3]);
                    *(u32x4*)(O + (size_t)row * 1536 + dst) = w; } }
    }
};
struct EpiVT {
    static constexpr bool PERM = true, AFTER_DRAIN = false;
    bf16_t* O; int ldc; const float* ssq; float eps;
    __device__ __forceinline__ void operator()(const f32x4 (&acc)[2][2][4][2], const Unit& u, int wr, int wc, int fr, int fq) const {
        const int row0 = u.pm * BM + wr * 64 + fr, col0 = u.pn * BM + wc * 32 + 8 * fq;
        f32x4 s[2][2];
#pragma unroll
        for (int bj = 0; bj < 2; ++bj)
#pragma unroll
            for (int n = 0; n < 2; ++n)
#pragma unroll
                for (int e = 0; e < 4; ++e) { const float* p = ssq + (size_t)(col0 + bj * HALF + 4 * n + e) * 16 + 8; const f32x4 s0 = *(const f32x4*)p, s1 = *(const f32x4*)(p + 4);
                    s[bj][n][e] = __builtin_amdgcn_rsqf((((s0[0] + s0[1]) + (s0[2] + s0[3])) + ((s1[0] + s1[1]) + (s1[2] + s1[3]))) * (1.f / 512.f) + eps); }
#pragma unroll
        for (int ai = 0; ai < 2; ++ai)
#pragma unroll
            for (int m = 0; m < 4; ++m) { bf16_t* rowp = O + (size_t)(row0 + ai * HALF + m * 16) * ldc + col0;
#pragma unroll
                for (int bj = 0; bj < 2; ++bj) { const f32x4 v0 = acc[ai][bj][m][0] * s[bj][0], v1 = acc[ai][bj][m][1] * s[bj][1];
                    u32x4 w; w.x = cvt_pk_bf16(v0[0], v0[1]); w.y = cvt_pk_bf16(v0[2], v0[3]); w.z = cvt_pk_bf16(v1[0], v1[1]); w.w = cvt_pk_bf16(v1[2], v1[3]);
                    *(u32x4*)(rowp + bj * HALF) = w; } }
    }
};
struct EpiGU {
    static constexpr bool PERM = true, AFTER_DRAIN = false;
    bf16_t* O; int ldc; const float* rs;
    __device__ __forceinline__ void operator()(const f32x4 (&acc)[2][2][4][2], const Unit& u, int wr, int wc, int fr, int fq) const {
        const int row0 = u.pm * BM + wr * 64 + fr, col0 = u.pn * HALF + wc * 32 + 8 * fq;
#pragma unroll
        for (int ai = 0; ai < 2; ++ai)
#pragma unroll
            for (int m = 0; m < 4; ++m) { const int row = row0 + ai * HALF + m * 16; const float sc = rs[row]; float o[8];
#pragma unroll
                for (int n = 0; n < 2; ++n)
#pragma unroll
                    for (int e = 0; e < 4; ++e) { const float gv = acc[ai][0][m][n][e] * sc, uv = acc[ai][1][m][n][e] * sc;
                        o[4 * n + e] = gv * __builtin_amdgcn_rcpf(1.f + __expf(-gv)) * uv; }
                u32x4 w; w.x = cvt_pk_bf16(o[0], o[1]); w.y = cvt_pk_bf16(o[2], o[3]); w.z = cvt_pk_bf16(o[4], o[5]); w.w = cvt_pk_bf16(o[6], o[7]);
                *(u32x4*)(O + (size_t)row * ldc + col0) = w; }
    }
};
template <class Epi, class Sched, bool ALIGN_EPI = false, bool SP2 = false>
__device__ __forceinline__ void gemm_phase(PG8_LAS unsigned char* lds, const Gemm g, const Sched& S, const Epi& E) {
    int tid_o = threadIdx.x; asm volatile("" : "+v"(tid_o)); const int tid = tid_o, wid = __builtin_amdgcn_readfirstlane(tid >> 6), lane = tid & 63, wr = wid >> 2, wc = wid & 3, fr = lane & 15, fq = lane >> 4;
    const int K = g.K, nt = K / BK;
    unsigned voffA[2], voffB[2];
#pragma unroll
    for (int i = 0; i < 2; ++i) { int R, C; stage_rc(tid * 16 + i * 8192, R, C); const int Rb = Epi::PERM ? ((R & ~31) + perm32(R & 31)) : R;
        voffA[i] = (unsigned)(R * g.lda + C) * 2u; voffB[i] = (unsigned)(Rb * g.ldb + C) * 2u; }
    const size_t kstep = (size_t)(BK * 2);
    const size_t hstepA = (size_t)HALF * g.lda * 2, hstepB = (size_t)HALF * g.ldb * 2;
    const size_t tstepA = 2 * hstepA, tstepB = 2 * hstepB;
    const unsigned ldsw = (unsigned)wid * 1024u;
    const int aoff = lds_byte(wr * 64 + fr, fq * 8), boff = lds_byte(wc * 32 + fr, fq * 8);
#define PG8_SA(b, h) (((b) * 2 + (h)) * HTB)
#define PG8_SB(b, h) ((4 + (b) * 2 + (h)) * HTB)
#define PG8_STAGE(bufoff, gbase, voff) do { _Pragma("unroll") for (int _i = 0; _i < 2; ++_i) \
        __builtin_amdgcn_global_load_lds((const unsigned*)((const char*)(gbase) + (voff)[_i]), (PG8_LAS unsigned*)(lds + (bufoff) + ldsw + _i * 8192), 16, 0, 0); } while (0)
#define PG8_LDA(dst, b, h) do { _Pragma("unroll") for (int m = 0; m < 4; ++m) _Pragma("unroll") for (int k = 0; k < 2; ++k) dst[m][k] = *(const PG8_LAS bf16x8*)(lds + PG8_SA(b, h) + aoff + m * 2048 + k * 1024); } while (0)
#define PG8_LDB(dst, b, h) do { _Pragma("unroll") for (int n = 0; n < 2; ++n) _Pragma("unroll") for (int k = 0; k < 2; ++k) dst[n][k] = *(const PG8_LAS bf16x8*)(lds + PG8_SB(b, h) + boff + n * 2048 + k * 1024); } while (0)
#define PG8_MMA(ai, bj, At, Bt) do { __builtin_amdgcn_s_setprio(1); _Pragma("unroll") for (int m = 0; m < 4; ++m) _Pragma("unroll") for (int n = 0; n < 2; ++n) _Pragma("unroll") for (int k = 0; k < 2; ++k) \
        acc[ai][bj][m][n] = __builtin_amdgcn_mfma_f32_16x16x32_bf16(Bt[n][k], At[m][k], acc[ai][bj][m][n], 0, 0, 0); __builtin_amdgcn_s_setprio(0); } while (0)
#define PG8_WAIT_V(n) asm volatile("s_waitcnt vmcnt(" #n ")" ::: "memory")
#define PG8_WAIT_L(n) asm volatile("s_waitcnt lgkmcnt(" #n ")" ::: "memory")
#define PG8_BAR __builtin_amdgcn_s_barrier()
#define PG8_SCHED __builtin_amdgcn_sched_barrier(0)
    Unit cur, nxt; int ui = 0;
    if (!S.next(0, cur)) return;
    f32x4 acc[2][2][4][2];
#pragma unroll
    for (int a = 0; a < 2; ++a)
#pragma unroll
        for (int b = 0; b < 2; ++b)
#pragma unroll
            for (int m = 0; m < 4; ++m)
#pragma unroll
                for (int n = 0; n < 2; ++n) acc[a][b][m][n] = (f32x4){0.f, 0.f, 0.f, 0.f};
    bf16x8 At[4][2], B0[2][2], B1[2][2];
    const char* cA = (const char*)g.A + (size_t)cur.pm * tstepA; const char* cB = (const char*)g.Bt + (size_t)cur.pn * tstepB;
    S.a_ready(cur);
    if constexpr (SP2) {
        PG8_STAGE(PG8_SB(0, 0), cB, voffB); PG8_STAGE(PG8_SB(0, 1), cB + hstepB, voffB); PG8_STAGE(PG8_SA(0, 0), cA, voffA); PG8_STAGE(PG8_SA(0, 1), cA + hstepA, voffA);
        if (wr == 1) PG8_BAR;
        PG8_WAIT_V(2); PG8_BAR;
        PG8_STAGE(PG8_SB(1, 0), cB + kstep, voffB); PG8_STAGE(PG8_SA(1, 0), cA + kstep, voffA); PG8_STAGE(PG8_SB(1, 1), cB + hstepB + kstep, voffB);
        PG8_WAIT_V(6); PG8_BAR;
    } else {
        PG8_STAGE(PG8_SB(0, 0), cB, voffB); PG8_STAGE(PG8_SA(0, 0), cA, voffA); PG8_STAGE(PG8_SB(0, 1), cB + hstepB, voffB); PG8_STAGE(PG8_SA(0, 1), cA + hstepA, voffA);
        if (wr == 1) PG8_BAR;
        PG8_WAIT_V(4); PG8_BAR;
        PG8_STAGE(PG8_SB(1, 0), cB + kstep, voffB); PG8_STAGE(PG8_SA(1, 0), cA + kstep, voffA); PG8_STAGE(PG8_SB(1, 1), cB + hstepB + kstep, voffB);
        PG8_WAIT_V(6); PG8_BAR;
    }
    for (;;) {
        const bool has_next = S.next(ui + 1, nxt);
        const char* nA = has_next ? (const char*)g.A + (size_t)nxt.pm * tstepA : cA; const char* nB = has_next ? (const char*)g.Bt + (size_t)nxt.pn * tstepB : cB;
        for (int t = 0; t < nt; t += 2) {
            const bool last = (t == nt - 2);
            const char* a1 = cA + (size_t)(t + 1) * kstep;
            const char* a2 = last ? nA : cA + (size_t)(t + 2) * kstep; const char* b2 = last ? nB : cB + (size_t)(t + 2) * kstep;
            const char* a3 = a2 + kstep; const char* b3 = b2 + kstep;
            if (last && has_next) S.a_ready(nxt);
            if constexpr (SP2) {
            PG8_LDB(B0, 0, 0); PG8_LDB(B1, 0, 1); PG8_SCHED; PG8_LDA(At, 0, 0); PG8_STAGE(PG8_SA(1, 1), a1 + hstepA, voffA);
            PG8_WAIT_V(8); PG8_WAIT_L(0); PG8_BAR; PG8_MMA(0, 0, At, B0); PG8_MMA(0, 1, At, B1); PG8_BAR; PG8_SCHED;
            PG8_LDA(At, 0, 1); PG8_STAGE(PG8_SB(0, 0), b2, voffB); PG8_STAGE(PG8_SB(0, 1), b2 + hstepB, voffB); PG8_STAGE(PG8_SA(0, 0), a2, voffA);
            PG8_WAIT_V(8); PG8_WAIT_L(0); PG8_BAR; PG8_MMA(1, 0, At, B0); PG8_MMA(1, 1, At, B1); PG8_BAR; PG8_SCHED;
            PG8_LDB(B0, 1, 0); PG8_LDB(B1, 1, 1); PG8_SCHED; PG8_LDA(At, 1, 0); PG8_STAGE(PG8_SA(0, 1), a2 + hstepA, voffA);
            PG8_WAIT_V(8); PG8_WAIT_L(0); PG8_BAR; PG8_MMA(0, 0, At, B0); PG8_MMA(0, 1, At, B1); PG8_BAR; PG8_SCHED;
            PG8_LDA(At, 1, 1); PG8_STAGE(PG8_SB(1, 0), b3, voffB); PG8_STAGE(PG8_SB(1, 1), b3 + hstepB, voffB); PG8_STAGE(PG8_SA(1, 0), a3, voffA);
            PG8_WAIT_V(8); PG8_WAIT_L(0); PG8_BAR; PG8_MMA(1, 0, At, B0); PG8_MMA(1, 1, At, B1); PG8_BAR; PG8_SCHED;
            } else {
            PG8_LDB(B0, 0, 0); PG8_SCHED; PG8_LDA(At, 0, 0); PG8_STAGE(PG8_SA(1, 1), a1 + hstepA, voffA);
            PG8_WAIT_L(8); PG8_BAR; PG8_WAIT_L(0); PG8_MMA(0, 0, At, B0); PG8_BAR; PG8_SCHED;
            PG8_LDB(B1, 0, 1); PG8_STAGE(PG8_SB(0, 0), b2, voffB);
            PG8_BAR; PG8_WAIT_L(0); PG8_MMA(0, 1, At, B1); PG8_BAR;
            PG8_LDA(At, 0, 1); PG8_STAGE(PG8_SA(0, 0), a2, voffA);
            PG8_BAR; PG8_WAIT_L(0); PG8_MMA(1, 0, At, B0); PG8_BAR; PG8_SCHED;
            PG8_STAGE(PG8_SB(0, 1), b2 + hstepB, voffB);
            PG8_WAIT_V(6); PG8_BAR; PG8_MMA(1, 1, At, B1); PG8_BAR;
            PG8_LDB(B0, 1, 0); PG8_SCHED; PG8_LDA(At, 1, 0); PG8_STAGE(PG8_SA(0, 1), a2 + hstepA, voffA);
            PG8_WAIT_L(8); PG8_BAR; PG8_WAIT_L(0); PG8_MMA(0, 0, At, B0); PG8_BAR; PG8_SCHED;
            PG8_LDB(B1, 1, 1); PG8_STAGE(PG8_SB(1, 0), b3, voffB);
            PG8_BAR; PG8_WAIT_L(0); PG8_MMA(0, 1, At, B1); PG8_BAR;
            PG8_LDA(At, 1, 1); PG8_STAGE(PG8_SA(1, 0), a3, voffA);
            PG8_BAR; PG8_WAIT_L(0); PG8_MMA(1, 0, At, B0); PG8_BAR; PG8_SCHED;
            PG8_STAGE(PG8_SB(1, 1), b3 + hstepB, voffB);
            PG8_WAIT_V(6); PG8_BAR; PG8_MMA(1, 1, At, B1); PG8_BAR;
            }
        }
        if constexpr (ALIGN_EPI) { if (wr == 0) PG8_BAR; }
        if constexpr (!Epi::AFTER_DRAIN) { E(acc, cur, wr, wc, fr, fq); S.done(cur); }
        if (!has_next) break;
#pragma unroll
        for (int a = 0; a < 2; ++a)
#pragma unroll
            for (int b = 0; b < 2; ++b)
#pragma unroll
                for (int m = 0; m < 4; ++m)
#pragma unroll
                    for (int n = 0; n < 2; ++n) acc[a][b][m][n] = (f32x4){0.f, 0.f, 0.f, 0.f};
        cur = nxt; cA = nA; cB = nB; ++ui;
        if constexpr (ALIGN_EPI) { if (wr == 1) PG8_BAR; }
    }
    PG8_WAIT_V(0);
    if constexpr (!ALIGN_EPI) { if (wr == 0) PG8_BAR; }
    PG8_BAR;
    if constexpr (Epi::AFTER_DRAIN) { E.fused(acc, cur, wr, wc, fr, fq, lds, wid, lane); S.done(cur); }
#undef PG8_SA
#undef PG8_SB
#undef PG8_STAGE
#undef PG8_LDA
#undef PG8_LDB
#undef PG8_MMA
#undef PG8_WAIT_V
#undef PG8_WAIT_L
#undef PG8_BAR
#undef PG8_SCHED
}
}
#define LAS __attribute__((address_space(3)))
typedef unsigned short bf16;
typedef short bf16x8 __attribute__((ext_vector_type(8)));
typedef float f32x4 __attribute__((ext_vector_type(4)));
typedef float f32x16 __attribute__((ext_vector_type(16)));
typedef unsigned u32x4 __attribute__((ext_vector_type(4)));
typedef unsigned u32x2 __attribute__((ext_vector_type(2)));
constexpr int NB = 2, SEQ = 4096, MT = NB * SEQ, DM = 2048, DEPTH = 4, DIN = 4688, NIN = 4864, DFF = 5632, NGU = 2 * DFF;
constexpr int C_GQ = 0, C_GK = 256, C_GV = 512, C_GO = 1024, C_HQ = 1536, C_HF = 2048, C_HI = 2560, C_HO = 3072, C_QC = 3584, C_KVC = 4096, C_KPE = 4608, C_GLOW = 4672;
constexpr float EPS = 1e-6f;
constexpr float QSCALE = 0.07216878364870322f * 1.4426950408889634f;
constexpr int NWAVES = 8, NTHR = 512;
constexpr int LDS_BYTES = 143360;
constexpr size_t W_IN = 0, W_Q = W_IN + (size_t)NIN * DM, W_K = W_Q + 1536 * 512, W_V = W_K + 1024 * 512, W_OUT = W_V + 1024 * 512, W_GU = W_OUT + (size_t)DM * DM,
                 W_DN = W_GU + (size_t)NGU * DM, W_LAYER = W_DN + (size_t)DM * DFF;
constexpr size_t al256(size_t x) { return (x + 255) & ~(size_t)255; }
constexpr size_t WS_PS_QKV = 0, WS_PS_O = WS_PS_QKV + (size_t)MT * 16 * 4, WS_PS_M = WS_PS_O + (size_t)MT * 8 * 4, WS_RSTD = WS_PS_M + (size_t)MT * 32 * 4;
constexpr size_t WS_COS = WS_RSTD + MT * 4, WS_SIN = WS_COS + (size_t)MT * 32 * 4, WS_DL_G = WS_SIN + (size_t)MT * 32 * 4, WS_DL_H = WS_DL_G + 8 * 64 * 64 * 4, WS_KPE = WS_DL_H + 8 * 64 * 128 * 4;
constexpr size_t WS_ML = al256(WS_KPE + (size_t)MT * 64 * 2);
constexpr size_t WS_BAR = al256(WS_ML + (size_t)2 * 16 * 8 * 256 * 2 * 4), BAR_BYTES = 16384;
constexpr size_t WS_W = al256(WS_BAR + BAR_BYTES);
constexpr size_t WS_XB = al256(WS_W + W_LAYER * DEPTH * 2);
constexpr size_t WS_Y = WS_XB + (size_t)MT * DM * 2;
constexpr size_t WS_MB = WS_Y + (size_t)MT * DM * 2;
constexpr size_t WS_VT = WS_MB + (size_t)MT * DM * 2;
constexpr size_t WS_QE_G = WS_VT + (size_t)1024 * MT * 2;
constexpr size_t WS_QE_H = WS_QE_G + (size_t)MT * 256 * 2;
constexpr size_t WS_UT_G = WS_QE_H + (size_t)MT * 512 * 2;
constexpr size_t WS_UT_H = WS_UT_G + (size_t)8 * 64 * 128 * 64 * 4;
constexpr size_t WS_SP_G = WS_UT_H + (size_t)8 * 64 * 128 * 128 * 4;
constexpr size_t WS_SP_H = WS_SP_G + (size_t)8 * 64 * 128 * 64 * 2;
constexpr size_t WS_OI = WS_SP_H + (size_t)8 * 64 * 128 * 128 * 2;
constexpr size_t WS_R1 = WS_OI + (size_t)2 * MT * 512 * 4;
constexpr size_t WS_PROJ = WS_R1, WS_Q = WS_PROJ + (size_t)MT * NIN * 2, WS_KN = WS_Q + (size_t)MT * 1536 * 2, WS_R1_END = WS_KN + (size_t)MT * 1024 * 2;
constexpr size_t WS_HDN = WS_R1;
static_assert(WS_HDN + (size_t)MT * DFF * 2 <= WS_R1_END, "hdn overlay");
constexpr size_t WS_END = WS_R1_END;

struct Args {
    const float* x; const int* pos; const float* attn_pre; const float* w_in; const float* gate_w2; const float* gate_b; const float* gla_norm; const float* lb_logits; const float* hgrn_norm;
    const float* q_norm; const float* wq_b; const float* kv_norm; const float* wkv_b; const float* mla_out_norm; const float* w_out; const float* attn_post; const float* ffn_pre;
    const float* w_gate; const float* w_up; const float* w_down; const float* ffn_post; float* out; unsigned char* ws; int ph_lo, ph_hi;
};

__device__ __forceinline__ unsigned f2bf(float f) { unsigned u = __builtin_bit_cast(unsigned, f); return (u + 0x7fffu + ((u >> 16) & 1u)) >> 16; }
__device__ __forceinline__ float bf2f(bf16 b) { return __builtin_bit_cast(float, (unsigned)b << 16); }
__device__ __forceinline__ unsigned pk2(float lo, float hi) { return pg8::cvt_pk_bf16(lo, hi); }
__device__ __forceinline__ float wave_sum(float v) {
#pragma unroll
    for (int o = 1; o < 64; o <<= 1) v += __shfl_xor(v, o);
    return v;
}
__device__ __forceinline__ int crow(int r, int hi) { return (r & 3) + 8 * (r >> 2) + 4 * hi; }
#define LDS_WAIT() asm volatile("s_waitcnt lgkmcnt(0)" ::: "memory")

__device__ __forceinline__ int w_srccol(int mat, int n) {
    switch (mat) {
    case 0: return n < 1024 ? n : (n < 4672 ? n + 16 : (n < 4688 ? n - 3648 : -1));
    case 1: { if (n < 1024) return (n >> 7) * 192 + (n & 127); const int c = n - 1024, hh = c >> 6, j = c & 63, i = j >> 1; return hh * 192 + 128 + ((j & 1) ? i + 32 : i); }
    case 2: return (n >> 7) * 256 + (n & 127);
    case 3: return (n >> 7) * 256 + 128 + (n & 127);
    case 5: return (n >> 8) * 128 + (n & 127);
    default: return n;
    }
}
struct ConvDesc { const float* src; const float* gain; bf16* dst; int ldsrc, mat, gmin, k0, K, n0; };
constexpr int I_IN = (NIN / 128) * (DM / 128), I_Q = 12 * 4, I_K = 8 * 4, I_V = 8 * 4, I_OUT = 16 * 16, I_GU = (NGU / 128) * 16, I_DN = 16 * (DFF / 128);
constexpr int I_LAYER = I_IN + I_Q + I_K + I_V + I_OUT + I_GU + I_DN;
__device__ __forceinline__ ConvDesc conv_decode(const Args& a, int l, int r) {
    bf16* wl = (bf16*)(a.ws + WS_W) + (size_t)l * W_LAYER; ConvDesc d;
    if (r < I_IN) { const int nb = r % (NIN / 128), kb = r / (NIN / 128); d = ConvDesc{a.w_in + (size_t)l * DM * DIN, a.attn_pre + l * DM, wl + W_IN, DIN, 0, 0, kb * 128, DM, nb * 128}; return d; } r -= I_IN;
    if (r < I_Q) { const int nb = r % 12, kb = r / 12; d = ConvDesc{a.wq_b + (size_t)l * 512 * 1536, a.q_norm + l * 512, wl + W_Q, 1536, 1, 0, kb * 128, 512, nb * 128}; return d; } r -= I_Q;
    if (r < I_K) { const int nb = r % 8, kb = r / 8; d = ConvDesc{a.wkv_b + (size_t)l * 512 * 2048, a.kv_norm + l * 512, wl + W_K, 2048, 2, 0, kb * 128, 512, nb * 128}; return d; } r -= I_K;
    if (r < I_V) { const int nb = r % 8, kb = r / 8; d = ConvDesc{a.wkv_b + (size_t)l * 512 * 2048, a.kv_norm + l * 512, wl + W_V, 2048, 3, 0, kb * 128, 512, nb * 128}; return d; } r -= I_V;
    if (r < I_OUT) { const int nb = r % 16, kb = r / 16; d = ConvDesc{a.w_out + (size_t)l * DM * DM, a.mla_out_norm + l * 1024, wl + W_OUT, DM, 4, 1024, kb * 128, DM, nb * 128}; return d; } r -= I_OUT;
    if (r < I_GU) { const int nb = r % (NGU / 128), kb = r / (NGU / 128); d = ConvDesc{((nb & 1) ? a.w_up : a.w_gate) + (size_t)l * DM * DFF, a.ffn_pre + l * DM, wl + W_GU, DFF, 5, 0, kb * 128, DM, nb * 128}; return d; } r -= I_GU;
    { const int nb = r % 16, kb = r / 16; d = ConvDesc{a.w_down + (size_t)l * DFF * DM, nullptr, wl + W_DN, DM, 6, 0, kb * 128, DFF, nb * 128}; return d; }
}
__device__ __forceinline__ void conv_load(const ConvDesc& d, int tid, f32x4 (&v)[4][2], float (&gn)[4][2]) {
    const int c4 = tid & 31, rp = tid >> 5; int sc[4];
#pragma unroll
    for (int j = 0; j < 4; ++j) sc[j] = w_srccol(d.mat, d.n0 + 4 * c4 + j);
    const bool contig = sc[0] >= 0 && sc[1] == sc[0] + 1 && sc[2] == sc[0] + 2 && sc[3] == sc[0] + 3;
#pragma unroll
    for (int i = 0; i < 4; ++i)
#pragma unroll
        for (int e = 0; e < 2; ++e) { const int k = d.k0 + i * 32 + 2 * rp + e; const float* rowp = d.src + (size_t)k * d.ldsrc;
            if (contig) v[i][e] = *(const f32x4*)(rowp + sc[0]);
            else { v[i][e][0] = sc[0] >= 0 ? rowp[sc[0]] : 0.f; v[i][e][1] = sc[1] >= 0 ? rowp[sc[1]] : 0.f; v[i][e][2] = sc[2] >= 0 ? rowp[sc[2]] : 0.f; v[i][e][3] = sc[3] >= 0 ? rowp[sc[3]] : 0.f; }
            gn[i][e] = (d.gain && k >= d.gmin) ? d.gain[k - d.gmin] : 1.f; }
}
__device__ __forceinline__ void conv_store(const ConvDesc& d, int tid, const f32x4 (&v)[4][2], const float (&gn)[4][2], LAS unsigned* T) {
    constexpr int SD = 65; const int c4 = tid & 31, rp = tid >> 5;
#pragma unroll
    for (int i = 0; i < 4; ++i)
#pragma unroll
        for (int j = 0; j < 4; ++j) T[(c4 + 32 * j) * SD + i * 16 + rp] = pk2(v[i][0][j] * gn[i][0], v[i][1][j] * gn[i][1]);
    __syncthreads();
#pragma unroll
    for (int i = 0; i < 4; ++i) { const int n = i * 32 + (tid >> 4), kc = tid & 15; const LAS unsigned* p = T + n * SD + kc * 4; u32x4 o; o.x = p[0]; o.y = p[1]; o.z = p[2]; o.w = p[3];
        *(u32x4*)(d.dst + (size_t)(d.n0 + 4 * (n & 31) + (n >> 5)) * d.K + d.k0 + kc * 8) = o; }
    __syncthreads();
}
__device__ __forceinline__ void conv_layer(const Args& a, int l, LAS unsigned char* lds, unsigned* ctr) {
    int tid_o = threadIdx.x; asm volatile("" : "+v"(tid_o)); const int tid = tid_o;
    LAS unsigned* T = (LAS unsigned*)lds; volatile LAS unsigned* slot = (volatile LAS unsigned*)(lds + 131072 + 128);
    int stat = (int)blockIdx.x - (int)gridDim.x;
    unsigned pend = 0u;
#define CONV_ISSUE() do { if (ctr && tid == 0) pend = __hip_atomic_fetch_add(ctr, 1u, __ATOMIC_RELAXED, __HIP_MEMORY_SCOPE_AGENT); } while (0)
#define CONV_NEXT(r) do { if (ctr) { sl ^= 1; if (tid == 0) slot[sl] = pend; __syncthreads(); r = (int)slot[sl]; } else { stat += (int)gridDim.x; r = stat; } } while (0)
    int sl = 0;
    __syncthreads();
    f32x4 vA[4][2], vB[4][2], vC[4][2]; float gA[4][2], gB[4][2], gC[4][2]; ConvDesc d0, d1, d2; int r0, r1, r2;
    CONV_ISSUE(); CONV_NEXT(r0); CONV_ISSUE(); if (r0 < I_LAYER) { d0 = conv_decode(a, l, r0); conv_load(d0, tid, vA, gA); }
    CONV_NEXT(r1); CONV_ISSUE(); if (r1 < I_LAYER) { d1 = conv_decode(a, l, r1); conv_load(d1, tid, vB, gB); }
    for (;;) {
        if (r0 >= I_LAYER) break;
        CONV_NEXT(r2); CONV_ISSUE(); if (r2 < I_LAYER) { d2 = conv_decode(a, l, r2); conv_load(d2, tid, vC, gC); }
        conv_store(d0, tid, vA, gA, T);
        if (r1 >= I_LAYER) break;
        CONV_NEXT(r0); CONV_ISSUE(); if (r0 < I_LAYER) { d0 = conv_decode(a, l, r0); conv_load(d0, tid, vA, gA); }
        conv_store(d1, tid, vB, gB, T);
        if (r2 >= I_LAYER) break;
        CONV_NEXT(r1); CONV_ISSUE(); if (r1 < I_LAYER) { d1 = conv_decode(a, l, r1); conv_load(d1, tid, vB, gB); }
        conv_store(d2, tid, vC, gC, T);
    }
#undef CONV_NEXT
#undef CONV_ISSUE
}
__device__ __forceinline__ void p0_prologue(const Args& a, LAS unsigned char* lds) {
    int tid_o = threadIdx.x; asm volatile("" : "+v"(tid_o)); const int tid = tid_o, lane = tid & 63, wave = tid >> 6, G = gridDim.x;
    const int gw = blockIdx.x * NWAVES + wave, NGW = G * NWAVES;
    conv_layer(a, 0, lds, nullptr);
    float* ct = (float*)(a.ws + WS_COS); float* st = (float*)(a.ws + WS_SIN);
    for (int i = blockIdx.x * NTHR + tid; i < MT * 32; i += G * NTHR) { const int row = i >> 5, j = i & 31;
        const float inv = (float)exp(-((double)(2 * j) / 64.0) * 9.210340371976184);
        const float ang = (float)a.pos[row] * inv;
        double rev = (double)ang * 0.15915494309189535; rev -= rint(rev); const float rf = (float)rev;
        ct[i] = __builtin_amdgcn_cosf(rf); st[i] = __builtin_amdgcn_sinf(rf); }
    bf16* xb = (bf16*)(a.ws + WS_XB); float* rstd = (float*)(a.ws + WS_RSTD);
    for (int row = gw; row < MT; row += NGW) { const f32x4* xr = (const f32x4*)(a.x + (size_t)row * DM); u32x2* ob = (u32x2*)(xb + (size_t)row * DM); float ss = 0.f;
#pragma unroll
        for (int j = 0; j < 8; ++j) { const f32x4 v = xr[j * 64 + lane]; ss += (v[0] * v[0] + v[1] * v[1]) + (v[2] * v[2] + v[3] * v[3]); u32x2 o; o.x = pk2(v[0], v[1]); o.y = pk2(v[2], v[3]); ob[j * 64 + lane] = o; }
        ss = wave_sum(ss);
        if (lane == 0) rstd[row] = 1.f / sqrtf(ss * (1.f / DM) + EPS); }
}
__device__ __forceinline__ void rowpass(const float* xin, float* xout, const bf16* mb, const float* ps, const float* gain, bf16* xb, float* rstd) {
    int tid_o = threadIdx.x; asm volatile("" : "+v"(tid_o)); const int tid = tid_o, lane = tid & 63, wave = tid >> 6; const int gw = blockIdx.x * NWAVES + wave, NGW = gridDim.x * NWAVES;
    for (int row = gw; row < MT; row += NGW) { const f32x4* xr = (const f32x4*)(xin + (size_t)row * DM); f32x4* xo = (f32x4*)(xout + (size_t)row * DM);
        const u32x2* mr = (const u32x2*)(mb + (size_t)row * DM); u32x2* ob = (u32x2*)(xb + (size_t)row * DM); const f32x4* gr = (const f32x4*)gain;
        f32x4 xv[8]; u32x2 mv[8];
#pragma unroll
        for (int j = 0; j < 8; ++j) { xv[j] = xr[j * 64 + lane]; mv[j] = mr[j * 64 + lane]; }
        const float r = 1.f / sqrtf(wave_sum(lane < 32 ? ps[(size_t)row * 32 + lane] : 0.f) * (1.f / DM) + EPS); float ss = 0.f;
#pragma unroll
        for (int j = 0; j < 8; ++j) { const int i = j * 64 + lane; f32x4 v = xv[j]; const u32x2 mm = mv[j]; const f32x4 g = gr[i];
            v[0] += __builtin_bit_cast(float, mm.x << 16) * r * g[0]; v[1] += __builtin_bit_cast(float, mm.x & 0xffff0000u) * r * g[1];
            v[2] += __builtin_bit_cast(float, mm.y << 16) * r * g[2]; v[3] += __builtin_bit_cast(float, mm.y & 0xffff0000u) * r * g[3];
            xv[j] = v; ss += (v[0] * v[0] + v[1] * v[1]) + (v[2] * v[2] + v[3] * v[3]); }
#pragma unroll
        for (int j = 0; j < 8; ++j) { const int i = j * 64 + lane; xo[i] = xv[j]; u32x2 o; o.x = pk2(xv[j][0], xv[j][1]); o.y = pk2(xv[j][2], xv[j][3]); ob[i] = o; }
        ss = wave_sum(ss);
        if (lane == 0) rstd[row] = 1.f / sqrtf(ss * (1.f / DM) + EPS); }
}
__device__ __forceinline__ f32x16 mfma32(bf16x8 a, bf16x8 b, f32x16 c) { return __builtin_amdgcn_mfma_f32_32x32x16_bf16(a, b, c, 0, 0, 0); }
template <int KD> __device__ __forceinline__ f32x16 mm32(const LAS bf16* A, int lda, const LAS bf16* B, int ldb, int ql, int g, f32x16 acc) {
#pragma unroll
    for (int s = 0; s < KD / 16; ++s) { const bf16x8 a = *(const LAS bf16x8*)(A + ql * lda + 16 * s + 8 * g), b = *(const LAS bf16x8*)(B + ql * ldb + 16 * s + 8 * g); acc = mfma32(a, b, acc); }
    return acc;
}
constexpr f32x16 Z16 = {0.f, 0.f, 0.f, 0.f, 0.f, 0.f, 0.f, 0.f, 0.f, 0.f, 0.f, 0.f, 0.f, 0.f, 0.f, 0.f};
template <int TYPE> __device__ __forceinline__ void gla_local_item(const Args& a, LAS unsigned char* lds, int layer, int bh, int c) {
    constexpr int DK = TYPE ? 128 : 64, QS = DK + 8, TS = 72, NTG = NTHR / DK, RPT = 64 / NTG;
    LAS bf16* qh = (LAS bf16*)lds; LAS bf16* kh = qh + 64 * QS; LAS bf16* ktT = kh + 64 * QS; LAS bf16* vT = ktT + DK * TS; LAS bf16* Ab = vT + 128 * TS; LAS float* bc = (LAS float*)(Ab + 64 * TS);
    int tid_o = threadIdx.x; asm volatile("" : "+v"(tid_o)); const int tid = tid_o, lane = tid & 63, wave = tid >> 6, ql = lane & 31, g = lane >> 5;
    const int b = bh >> 2, h = bh & 3, t0 = b * SEQ + c * 64;
    const bf16* prow = (const bf16*)(a.ws + WS_PROJ) + (size_t)t0 * NIN;
    const int d = tid % DK, tg = tid / DK;
    float lbv = 0.f;
    bf16 rq[RPT], rk[RPT], rv[16];
#pragma unroll
    for (int tt = 0; tt < RPT; ++tt) { const int t = tg * RPT + tt; rq[tt] = prow[(size_t)t * NIN + (TYPE ? C_HQ : C_GQ) + h * DK + d]; rk[tt] = prow[(size_t)t * NIN + (TYPE ? C_HF : C_GK) + h * DK + d]; }
    { const int e = tid & 127, tq = tid >> 7; const int vcol = (TYPE ? C_HI : C_GV) + h * 128 + e;
#pragma unroll
      for (int i = 0; i < 16; ++i) rv[i] = prow[(size_t)(tq * 16 + i) * NIN + vcol]; }
    {
        float run = 0.f;
        if (TYPE == 0) {
            float w2c[16]; const float* w2 = a.gate_w2 + (size_t)layer * 16 * 256 + h * 64 + d;
#pragma unroll
            for (int r = 0; r < 16; ++r) w2c[r] = w2[r * 256];
            const float bias = a.gate_b[layer * 256 + h * 64 + d];
            bf16x8 rg0[RPT], rg1[RPT];
#pragma unroll
            for (int tt = 0; tt < RPT; ++tt) { const bf16x8* gl = (const bf16x8*)(prow + (size_t)(tg * RPT + tt) * NIN + C_GLOW); rg0[tt] = gl[0]; rg1[tt] = gl[1]; }
#pragma unroll
            for (int tt = 0; tt < RPT; ++tt) { const int t = tg * RPT + tt; const bf16x8 g0 = rg0[tt], g1 = rg1[tt]; float z = bias;
#pragma unroll
                for (int r = 0; r < 8; ++r) { z += bf2f((bf16)g0[r]) * w2c[r]; z += bf2f((bf16)g1[r]) * w2c[8 + r]; }
                const float lg = (fminf(z, 0.f) - __logf(1.f + __expf(-fabsf(z)))) * (1.f / 16.f);
                run += lg; bc[t * DK + d] = run; }
        } else {
            const float* lg4 = a.lb_logits + h * 128 + d; const float l0 = lg4[0], l1 = lg4[512], l2 = lg4[1024], l3 = lg4[1536];
            const float mx = fmaxf(fmaxf(l0, l1), fmaxf(l2, l3)); const float e0 = __expf(l0 - mx), e1 = __expf(l1 - mx), e2 = __expf(l2 - mx), e3 = __expf(l3 - mx); const float inv = 1.f / (e0 + e1 + e2 + e3);
            lbv = (layer >= 1 ? e1 : 0.f) + (layer >= 2 ? e2 : 0.f) + (layer >= 3 ? e3 : 0.f); lbv *= inv;
#pragma unroll
            for (int tt = 0; tt < RPT; ++tt) { const int t = tg * RPT + tt; const float hf = bf2f(rk[tt]);
                const float sg = 1.f / (1.f + __expf(-hf)); const float f = lbv + (1.f - lbv) * sg;
                run += __logf(f); bc[t * DK + d] = run; }
        }
    }
    __syncthreads();
    { float off = 0.f; for (int s = 0; s < tg; ++s) off += bc[(s * RPT + RPT - 1) * DK + d];
      __syncthreads();
      if (tg > 0) for (int tt = 0; tt < RPT; ++tt) bc[(tg * RPT + tt) * DK + d] += off; }
    __syncthreads();
    {
        const float bmid = bc[32 * DK + d], blast = bc[63 * DK + d]; const float scale = TYPE ? 1.f : 0.125f;
        bf16* qe = (bf16*)(a.ws + (TYPE ? WS_QE_H : WS_QE_G));
#pragma unroll
        for (int tt = 0; tt < RPT; ++tt) { const int t = tg * RPT + tt; const float bb = bc[t * DK + d]; float q = bf2f(rq[tt]), k = bf2f(rk[tt]);
            if (TYPE == 1) { const float hq = q, hf = k; q = hq / (1.f + __expf(-hq)); k = (1.f - lbv) / (1.f + __expf(hf)); }
            q *= scale;
            qh[t * QS + d] = (bf16)f2bf(q * __expf(bb - bmid)); kh[t * QS + d] = (bf16)f2bf(k * __expf(bmid - bb));
            ktT[d * TS + t] = (bf16)f2bf(k * __expf(blast - bb));
            qe[(size_t)(t0 + t) * (4 * DK) + h * DK + d] = (bf16)f2bf(q * __expf(bb)); }
        if (tg == 0) ((float*)(a.ws + (TYPE ? WS_DL_H : WS_DL_G)))[(bh * 64 + c) * DK + d] = __expf(blast);
        const int e = tid & 127, tq = tid >> 7;
#pragma unroll
        for (int i = 0; i < 16; ++i) vT[e * TS + tq * 16 + i] = rv[i];
    }
    __syncthreads();
    if (wave < 4) {
        const int jb = wave & 1, ib = wave >> 1; f32x16 acc = Z16;
        if (!(jb == 1 && ib == 0)) acc = mm32<DK>(kh + 32 * jb * QS, QS, qh + 32 * ib * QS, QS, ql, g, acc);
        const int i = 32 * ib + ql;
#pragma unroll
        for (int rg = 0; rg < 4; ++rg) { const int j0 = 32 * jb + 8 * rg + 4 * g; float v[4];
#pragma unroll
            for (int e = 0; e < 4; ++e) v[e] = (j0 + e <= i) ? acc[4 * rg + e] : 0.f;
            u32x2 o; o.x = pk2(v[0], v[1]); o.y = pk2(v[2], v[3]); *(LAS u32x2*)(Ab + i * TS + j0) = o; }
    }
    __syncthreads();
    {
        const int eb = wave & 3, ib = wave >> 2; f32x16 acc = mm32<64>(vT + 32 * eb * TS, TS, Ab + 32 * ib * TS, TS, ql, g, Z16);
        float* oi = (float*)(a.ws + WS_OI) + (size_t)TYPE * MT * 512 + (size_t)(t0 + 32 * ib + ql) * 512 + h * 128 + 32 * eb + 4 * g;
#pragma unroll
        for (int rg = 0; rg < 4; ++rg) { f32x4 o = {acc[4 * rg], acc[4 * rg + 1], acc[4 * rg + 2], acc[4 * rg + 3]}; *(f32x4*)(oi + 8 * rg) = o; }
    }
    {
        float* ut = (float*)(a.ws + (TYPE ? WS_UT_H : WS_UT_G)) + (size_t)(bh * 64 + c) * 128 * DK;
#pragma unroll
        for (int bi = 0; bi < DK / 64; ++bi) { const int blk = wave + 8 * bi, eb = blk & 3, db = blk >> 2;
            f32x16 acc = mm32<64>(ktT + 32 * db * TS, TS, vT + 32 * eb * TS, TS, ql, g, Z16);
            float* up = ut + (size_t)(32 * eb + ql) * DK + 32 * db + 4 * g;
#pragma unroll
            for (int rg = 0; rg < 4; ++rg) { f32x4 o = {acc[4 * rg], acc[4 * rg + 1], acc[4 * rg + 2], acc[4 * rg + 3]}; *(f32x4*)(up + 8 * rg) = o; } }
    }
    __syncthreads();
}
__device__ __forceinline__ void scan_item(const Args& a, int si) {
    int tid_o = threadIdx.x; asm volatile("" : "+v"(tid_o)); const int tid = tid_o; const bool hg = si >= 32; const int DK = hg ? 128 : 64; const int idx = (hg ? si - 32 : si) * NTHR + tid;
    const int per_bh = 128 * DK / 4; const int bh = idx / per_bh, rem = idx % per_bh, e = rem / (DK / 4), d = 4 * (rem % (DK / 4));
    const float* ut = (const float*)(a.ws + (hg ? WS_UT_H : WS_UT_G)) + (size_t)bh * 64 * 128 * DK + (size_t)e * DK + d;
    bf16* sp = (bf16*)(a.ws + (hg ? WS_SP_H : WS_SP_G)) + (size_t)bh * 64 * 128 * DK + (size_t)e * DK + d;
    const float* dl = (const float*)(a.ws + (hg ? WS_DL_H : WS_DL_G)) + (size_t)bh * 64 * DK + d;
    f32x4 S = {0.f, 0.f, 0.f, 0.f}; const size_t cs = (size_t)128 * DK;
    for (int cb = 0; cb < 64; cb += 16) {
        f32x4 u[16], dd[16];
#pragma unroll
        for (int i = 0; i < 16; ++i) { u[i] = __builtin_nontemporal_load((const f32x4*)(ut + (size_t)(cb + i) * cs)); dd[i] = *(const f32x4*)(dl + (cb + i) * DK); }
#pragma unroll
        for (int i = 0; i < 16; ++i) { u32x2 o; o.x = pk2(S[0], S[1]); o.y = pk2(S[2], S[3]); *(u32x2*)(sp + (size_t)(cb + i) * cs) = o; S = dd[i] * S + u[i]; }
    }
}
__device__ __forceinline__ void gla_final_item(const Args& a, int layer, int item) {
    const int type = item >> 7, bh = (item >> 4) & 7, cg4 = item & 15; const int DK = type ? 128 : 64;
    int tid_o = threadIdx.x; asm volatile("" : "+v"(tid_o)); const int tid = tid_o, lane = tid & 63, wave = tid >> 6, ql = lane & 31, g = lane >> 5;
    const int b = bh >> 2, h = bh & 3, c = cg4 * 4 + (wave >> 1), t = b * SEQ + c * 64 + (wave & 1) * 32 + ql;
    const float* oi = (const float*)(a.ws + WS_OI) + (size_t)type * MT * 512 + (size_t)t * 512 + h * 128 + 4 * g;
    f32x16 acc[4];
#pragma unroll
    for (int eb = 0; eb < 4; ++eb)
#pragma unroll
        for (int rg = 0; rg < 4; ++rg) { const f32x4 v = *(const f32x4*)(oi + 32 * eb + 8 * rg); acc[eb][4 * rg] = v[0]; acc[eb][4 * rg + 1] = v[1]; acc[eb][4 * rg + 2] = v[2]; acc[eb][4 * rg + 3] = v[3]; }
    const bf16* qe = (const bf16*)(a.ws + (type ? WS_QE_H : WS_QE_G)) + (size_t)t * (4 * DK) + h * DK + 8 * g;
    const bf16* sp = (const bf16*)(a.ws + (type ? WS_SP_H : WS_SP_G)) + ((size_t)(bh * 64 + c) * 128 + ql) * DK + 8 * g;
    for (int s = 0; s < DK / 16; ++s) { const bf16x8 bq = *(const bf16x8*)(qe + 16 * s);
#pragma unroll
        for (int eb = 0; eb < 4; ++eb) { const bf16x8 as = *(const bf16x8*)(sp + (size_t)32 * eb * DK + 16 * s); acc[eb] = mfma32(as, bq, acc[eb]); } }
    float ss = 0.f;
#pragma unroll
    for (int eb = 0; eb < 4; ++eb)
#pragma unroll
        for (int r = 0; r < 16; ++r) ss += acc[eb][r] * acc[eb][r];
    ss += __shfl_xor(ss, 32);
    const float rstd = 1.f / sqrtf(ss * (1.f / 128.f) + EPS);
    const float* gn = (type ? a.hgrn_norm : a.gla_norm) + layer * 128 + 4 * g;
    const bf16* gt = (const bf16*)(a.ws + WS_PROJ) + (size_t)t * NIN + (type ? C_HO : C_GO) + h * 128 + 4 * g;
    bf16* y = (bf16*)(a.ws + WS_Y) + (size_t)t * DM + type * 512 + h * 128 + 4 * g;
    u32x2 gbv[16]; f32x4 gvv[16];
#pragma unroll
    for (int i = 0; i < 16; ++i) { const int eo = 32 * (i >> 2) + 8 * (i & 3); gbv[i] = *(const u32x2*)(gt + eo); gvv[i] = *(const f32x4*)(gn + eo); }
#pragma unroll
    for (int eb = 0; eb < 4; ++eb)
#pragma unroll
        for (int rg = 0; rg < 4; ++rg) { const int eo = 32 * eb + 8 * rg; const f32x4 gv = gvv[4 * eb + rg]; const u32x2 gb = gbv[4 * eb + rg];
            const float g0 = __builtin_bit_cast(float, gb.x << 16), g1 = __builtin_bit_cast(float, gb.x & 0xffff0000u), g2 = __builtin_bit_cast(float, gb.y << 16), g3 = __builtin_bit_cast(float, gb.y & 0xffff0000u);
            const float o0 = acc[eb][4 * rg] * rstd * gv[0] * g0 / (1.f + __expf(-g0)), o1 = acc[eb][4 * rg + 1] * rstd * gv[1] * g1 / (1.f + __expf(-g1));
            const float o2 = acc[eb][4 * rg + 2] * rstd * gv[2] * g2 / (1.f + __expf(-g2)), o3 = acc[eb][4 * rg + 3] * rstd * gv[3] * g3 / (1.f + __expf(-g3));
            u32x2 o; o.x = pk2(o0, o1); o.y = pk2(o2, o3); *(u32x2*)(y + eo) = o; }
}
__device__ __forceinline__ void kpe_rope(const Args& a) {
    const bf16* proj = (const bf16*)(a.ws + WS_PROJ); bf16* kpe = (bf16*)(a.ws + WS_KPE); const float* ct = (const float*)(a.ws + WS_COS); const float* st = (const float*)(a.ws + WS_SIN);
    int tid_o = threadIdx.x; asm volatile("" : "+v"(tid_o));
    for (int i = blockIdx.x * NTHR + tid_o; i < MT * 32; i += gridDim.x * NTHR) { const int row = i >> 5, j = i & 31;
        const float x1 = bf2f(proj[(size_t)row * NIN + C_KPE + j]), x2 = bf2f(proj[(size_t)row * NIN + C_KPE + 32 + j]); const float c = ct[i], s = st[i];
        *(unsigned*)(kpe + (size_t)row * 64 + 2 * j) = pk2(x1 * c - x2 * s, x2 * c + x1 * s); }
}
__device__ __forceinline__ void mla_out_norm(const Args& a) {
    bf16* y = (bf16*)(a.ws + WS_Y); const float* ssq = (const float*)(a.ws + WS_PS_O);
    int tid_o = threadIdx.x; asm volatile("" : "+v"(tid_o));
    const int i0 = blockIdx.x * NTHR + tid_o, stride = gridDim.x * NTHR;
    for (int ib = i0; ib < MT * 128; ib += 8 * stride) {
        u32x4 v[8]; f32x4 s0[8], s1[8];
#pragma unroll
        for (int k = 0; k < 8; ++k) { const int i = ib + k * stride; if (i < MT * 128) { const int row = i >> 7, cc = i & 127; v[k] = *(const u32x4*)(y + (size_t)row * DM + 1024 + cc * 8); s0[k] = *(const f32x4*)(ssq + (size_t)row * 8); s1[k] = *(const f32x4*)(ssq + (size_t)row * 8 + 4); } }
#pragma unroll
        for (int k = 0; k < 8; ++k) { const int i = ib + k * stride; if (i < MT * 128) { const int row = i >> 7, cc = i & 127;
            const float r = 1.f / sqrtf((((s0[k][0] + s0[k][1]) + (s0[k][2] + s0[k][3])) + ((s1[k][0] + s1[k][1]) + (s1[k][2] + s1[k][3]))) * (1.f / 1024.f) + EPS); u32x4 w = v[k];
#pragma unroll
            for (int e = 0; e < 4; ++e) { const float lo = __builtin_bit_cast(float, w[e] << 16) * r, hi = __builtin_bit_cast(float, w[e] & 0xffff0000u) * r; w[e] = pk2(lo, hi); }
            *(u32x4*)(y + (size_t)row * DM + 1024 + cc * 8) = w; } }
    }
}
constexpr int KSTR = 400, VSTR = 136, KBYTES = 64 * KSTR, VBYTES = 128 * VSTR, OSTR = 272;
__device__ __forceinline__ void attn_item(const Args& a, LAS unsigned char* lds, int b, int h, int qb, int t0, int t1, int part) {
    int tid_o = threadIdx.x; asm volatile("" : "+v"(tid_o)); const int tid = tid_o, lane = tid & 63, wave = tid >> 6, ql = lane & 31, g = lane >> 5;
    const bf16* Q = (const bf16*)(a.ws + WS_Q); const bf16* KN = (const bf16*)(a.ws + WS_KN); const bf16* KP = (const bf16*)(a.ws + WS_KPE); const bf16* VT = (const bf16*)(a.ws + WS_VT);
    const int tq0 = b * SEQ + qb * 256 + wave * 32, qpos = qb * 256 + wave * 32 + ql;
    bf16x8 qf[12];
    { const bf16* qp = Q + (size_t)(tq0 + ql) * 1536 + h * 192 + 8 * g;
#pragma unroll
      for (int s = 0; s < 12; ++s) qf[s] = *(const bf16x8*)(qp + 16 * s); }
    f32x16 oacc[4] = {Z16, Z16, Z16, Z16}; float mrun = -1e30f, lrun = 0.f;
    const int nt = 4 * (qb + 1);
    int ksrc_off[3]; int kdst[3]; bool kpe_sel[3]; int vsrc_off[2]; int vdst[2];
#pragma unroll
    for (int i = 0; i < 3; ++i) { const int cid = tid + NTHR * i, key = cid / 24, cc = cid % 24; kpe_sel[i] = cc >= 16; kdst[i] = key * KSTR + cc * 16;
        ksrc_off[i] = kpe_sel[i] ? key * 64 + (cc - 16) * 8 : key * 1024 + h * 128 + cc * 8; }
#pragma unroll
    for (int i = 0; i < 2; ++i) { const int cid = tid + NTHR * i, row = cid >> 3, cc = cid & 7; vdst[i] = row * VSTR + cc * 16; vsrc_off[i] = (h * 128 + row) * MT + cc * 8; }
    u32x4 sk[3], sv[2];
#define ATT_GLOAD(t) do { const size_t tk = (size_t)(b * SEQ + (t) * 64); _Pragma("unroll") for (int i = 0; i < 3; ++i) sk[i] = kpe_sel[i] ? *(const u32x4*)(KP + tk * 64 + ksrc_off[i]) : *(const u32x4*)(KN + tk * 1024 + ksrc_off[i]); \
        _Pragma("unroll") for (int i = 0; i < 2; ++i) sv[i] = *(const u32x4*)(VT + (size_t)vsrc_off[i] + tk); } while (0)
#define ATT_LSTORE(buf) do { LAS unsigned char* kb_ = lds + (buf) * KBYTES; LAS unsigned char* vb_ = lds + 2 * KBYTES + (buf) * VBYTES; \
        _Pragma("unroll") for (int i = 0; i < 3; ++i) *(LAS u32x4*)(kb_ + kdst[i]) = sk[i]; _Pragma("unroll") for (int i = 0; i < 2; ++i) { *(LAS u32x2*)(vb_ + vdst[i]) = (u32x2){sv[i].x, sv[i].y}; *(LAS u32x2*)(vb_ + vdst[i] + 8) = (u32x2){sv[i].z, sv[i].w}; } } while (0)
    __syncthreads();
    ATT_GLOAD(t0); ATT_LSTORE(0);
    __syncthreads();
    for (int t = t0; t < t1; ++t) {
        if (t + 1 < t1) ATT_GLOAD(t + 1);
        const int bsel = (t - t0) & 1;
        const LAS unsigned char* kb_ = lds + bsel * KBYTES; const LAS unsigned char* vb_ = lds + 2 * KBYTES + bsel * VBYTES;
        f32x16 p0 = Z16, p1 = Z16;
        { const LAS unsigned char* kp = kb_ + ql * KSTR + 16 * g;
#pragma unroll
          for (int s = 0; s < 12; ++s) { const bf16x8 k0 = *(const LAS bf16x8*)(kp + 32 * s), k1 = *(const LAS bf16x8*)(kp + 32 * KSTR + 32 * s); p0 = mfma32(k0, qf[s], p0); p1 = mfma32(k1, qf[s], p1); } }
        if (t >= nt - 4) { const int kb0 = t * 64 + 4 * g; const float NEG = -__builtin_inff();
#pragma unroll
            for (int r = 0; r < 16; ++r) { const int kk = kb0 + (r & 3) + 8 * (r >> 2); if (kk > qpos) p0[r] = NEG; if (kk + 32 > qpos) p1[r] = NEG; } }
        float mx = p0[0];
#pragma unroll
        for (int r = 1; r < 16; ++r) mx = fmaxf(mx, p0[r]);
#pragma unroll
        for (int r = 0; r < 16; ++r) mx = fmaxf(mx, p1[r]);
        mx = fmaxf(mx, __shfl_xor(mx, 32));
        float mn = mrun;
        if (__builtin_amdgcn_ballot_w64(mx > mrun + 8.f) != 0ull) {
            mn = fmaxf(mrun, mx); const float alpha = __builtin_amdgcn_exp2f(mrun - mn); mrun = mn; lrun *= alpha;
#pragma unroll
            for (int db = 0; db < 4; ++db) oacc[db] = oacc[db] * alpha; }
        float rs = 0.f;
#pragma unroll
        for (int r = 0; r < 16; ++r) { p0[r] = __builtin_amdgcn_exp2f(p0[r] - mn); p1[r] = __builtin_amdgcn_exp2f(p1[r] - mn); rs += p0[r] + p1[r]; }
        lrun += rs;
        bf16x8 pf[4];
        { u32x4 w;
          w.x = pk2(p0[0], p0[1]); w.y = pk2(p0[2], p0[3]); w.z = pk2(p0[4], p0[5]); w.w = pk2(p0[6], p0[7]); pf[0] = __builtin_bit_cast(bf16x8, w);
          w.x = pk2(p0[8], p0[9]); w.y = pk2(p0[10], p0[11]); w.z = pk2(p0[12], p0[13]); w.w = pk2(p0[14], p0[15]); pf[1] = __builtin_bit_cast(bf16x8, w);
          w.x = pk2(p1[0], p1[1]); w.y = pk2(p1[2], p1[3]); w.z = pk2(p1[4], p1[5]); w.w = pk2(p1[6], p1[7]); pf[2] = __builtin_bit_cast(bf16x8, w);
          w.x = pk2(p1[8], p1[9]); w.y = pk2(p1[10], p1[11]); w.z = pk2(p1[12], p1[13]); w.w = pk2(p1[14], p1[15]); pf[3] = __builtin_bit_cast(bf16x8, w); }
#pragma unroll
        for (int db = 0; db < 4; ++db) { const LAS unsigned char* vp = vb_ + (32 * db + ql) * VSTR + 8 * g;
#pragma unroll
            for (int sl = 0; sl < 4; ++sl) { const u32x2 lo = *(const LAS u32x2*)(vp + 32 * sl), hi = *(const LAS u32x2*)(vp + 32 * sl + 16); const u32x4 w = {lo.x, lo.y, hi.x, hi.y};
                oacc[db] = mfma32(__builtin_bit_cast(bf16x8, w), pf[sl], oacc[db]); } }
        if (t + 1 < t1) ATT_LSTORE(bsel ^ 1);
        __syncthreads();
    }
#undef ATT_GLOAD
#undef ATT_LSTORE
    const float lt = lrun + __shfl_xor(lrun, 32), inv = 1.f / lt;
    LAS unsigned char* ob = lds + wave * (32 * OSTR);
#pragma unroll
    for (int db = 0; db < 4; ++db)
#pragma unroll
        for (int rg = 0; rg < 4; ++rg) { const float o0 = oacc[db][4 * rg] * inv, o1 = oacc[db][4 * rg + 1] * inv, o2 = oacc[db][4 * rg + 2] * inv, o3 = oacc[db][4 * rg + 3] * inv;
            u32x2 o; o.x = pk2(o0, o1); o.y = pk2(o2, o3); *(LAS u32x2*)(ob + ql * OSTR + (32 * db + 8 * rg + 4 * g) * 2) = o; }
    LDS_WAIT(); asm volatile("" ::: "memory");
    bf16* dst; int pitch;
    if (part < 0) { dst = (bf16*)(a.ws + WS_Y) + (size_t)tq0 * DM + 1024 + h * 128; pitch = DM; }
    else { const size_t rec = ((size_t)((part * 16 + b * 8 + h) * 8 + (qb - 8)) * 256 + wave * 32); dst = (bf16*)(a.ws + WS_MB) + rec * 128; pitch = 128;
        if (g == 0) { float* ml = (float*)(a.ws + WS_ML) + (rec + ql) * 2; ml[0] = mrun; ml[1] = lt; } }
#pragma unroll
    for (int i = 0; i < 8; ++i) { const int cid = lane + 64 * i, row = cid >> 4, cc = cid & 15; const u32x4 v = *(const LAS u32x4*)(ob + row * OSTR + cc * 16);
        *(u32x4*)(dst + (size_t)row * pitch + cc * 8) = v; }
}
__device__ __forceinline__ void attn_queue(const Args& a, LAS unsigned char* lds, unsigned* ctr) {
    int tid_o = threadIdx.x; asm volatile("" : "+v"(tid_o)); const int tid = tid_o; const int grp = blockIdx.x & 7;
    volatile LAS unsigned* slot = (volatile LAS unsigned*)(lds + 131072 + 160);
    for (;;) {
        if (tid == 0) *slot = __hip_atomic_fetch_add(ctr + grp, 1u, __ATOMIC_RELAXED, __HIP_MEMORY_SCOPE_AGENT);
        __syncthreads();
        const int idx = (int)*slot;
        if (idx >= 48) break;
        const int bh = 2 * grp + (idx & 1), k = idx >> 1; int qb, part;
        if (k < 20) { const int j = k / 5, r = k % 5; if (r == 0) { qb = 7 - j; part = -1; } else if (r < 3) { qb = 15 - 2 * j; part = r - 1; } else { qb = 14 - 2 * j; part = r - 3; } }
        else { qb = 23 - k; part = -1; }
        const int nt = 4 * (qb + 1);
        attn_item(a, lds, bh >> 3, bh & 7, qb, part == 1 ? nt / 2 : 0, part == 0 ? nt / 2 : nt, part);
    }
}
__device__ __forceinline__ void mla_finish(const Args& a) {
    int tid_o = threadIdx.x; asm volatile("" : "+v"(tid_o)); const int tid = tid_o, lane = tid & 63, wave = tid >> 6; const int gw = blockIdx.x * NWAVES + wave, NGW = gridDim.x * NWAVES;
    bf16* y = (bf16*)(a.ws + WS_Y); const bf16* po = (const bf16*)(a.ws + WS_MB); const float* ml = (const float*)(a.ws + WS_ML);
    for (int row = gw; row < MT; row += NGW) { const int b = row >> 12, pos = row & 4095, qb = pos >> 8, r = pos & 255; float o0[8], o1[8];
        if (qb < 8) {
#pragma unroll
            for (int h = 0; h < 8; ++h) { const unsigned u = *(const unsigned*)(y + (size_t)row * DM + 1024 + h * 128 + 2 * lane); o0[h] = __builtin_bit_cast(float, u << 16); o1[h] = __builtin_bit_cast(float, u & 0xffff0000u); }
        } else {
            unsigned ua[8], ub[8]; float ma[8], la[8], mb_[8], lb_[8];
#pragma unroll
            for (int h = 0; h < 8; ++h) { const size_t ra = (size_t)((0 * 16 + b * 8 + h) * 8 + (qb - 8)) * 256 + r, rb = (size_t)((1 * 16 + b * 8 + h) * 8 + (qb - 8)) * 256 + r;
                ua[h] = *(const unsigned*)(po + ra * 128 + 2 * lane); ub[h] = *(const unsigned*)(po + rb * 128 + 2 * lane);
                ma[h] = ml[ra * 2]; la[h] = ml[ra * 2 + 1]; mb_[h] = ml[rb * 2]; lb_[h] = ml[rb * 2 + 1]; }
#pragma unroll
            for (int h = 0; h < 8; ++h) { const float m = fmaxf(ma[h], mb_[h]); const float wa = la[h] * __builtin_amdgcn_exp2f(ma[h] - m), wb = lb_[h] * __builtin_amdgcn_exp2f(mb_[h] - m), iw = 1.f / (wa + wb);
                o0[h] = (wa * __builtin_bit_cast(float, ua[h] << 16) + wb * __builtin_bit_cast(float, ub[h] << 16)) * iw;
                o1[h] = (wa * __builtin_bit_cast(float, ua[h] & 0xffff0000u) + wb * __builtin_bit_cast(float, ub[h] & 0xffff0000u)) * iw; }
        }
        float ss = 0.f;
#pragma unroll
        for (int h = 0; h < 8; ++h) ss += o0[h] * o0[h] + o1[h] * o1[h];
        ss = wave_sum(ss); const float rs = 1.f / sqrtf(ss * (1.f / 1024.f) + EPS);
#pragma unroll
        for (int h = 0; h < 8; ++h) *(unsigned*)(y + (size_t)row * DM + 1024 + h * 128 + 2 * lane) = pk2(o0[h] * rs, o1[h] * rs);
    }
}
#define XB_TMO      128
#define XB_XCNT(j)  (256  + 64 * (j))
#define XB_XSUB(j)  (1280 + 64 * (j))
#define XB_XGEN(j)  (2304 + 64 * (j))
#define XB_TOP      3328
#define XB_TOPGEN   3392
#define XCD_BAR_WORDS 3456
#define XB_SPIN_CAP (1u << 18)

__device__ __forceinline__ unsigned xb_ld(unsigned* p)              { return __hip_atomic_load(p, __ATOMIC_RELAXED, __HIP_MEMORY_SCOPE_AGENT); }
__device__ __forceinline__ unsigned xb_add(unsigned* p, unsigned v) { return __hip_atomic_fetch_add(p, v, __ATOMIC_RELAXED, __HIP_MEMORY_SCOPE_AGENT); }
__device__ __forceinline__ unsigned xb_xcc_id() { return (unsigned)__builtin_amdgcn_s_getreg((3 << 11) | 20) & 0xFu; }
#define XB_SPIN(cond, bar) do { unsigned _sp = 0; while (cond) { __builtin_amdgcn_s_sleep(1); \
    if ((++_sp & 255u) == 0u) { if (xb_ld(&(bar)[XB_TMO])) break; if (_sp > XB_SPIN_CAP) { atomicAdd(&(bar)[XB_TMO], 1u); break; } } } } while (0)

struct XcdBarrier {
    unsigned* bar; unsigned x;
    volatile LAS unsigned* st;
};

__device__ __forceinline__ XcdBarrier xcd_barrier_post(unsigned* bar, volatile LAS unsigned* st) {
    XcdBarrier b; b.bar = bar; b.x = xb_xcc_id(); b.st = st;
    if (threadIdx.x == 0) (void)xb_add(&bar[XB_XCNT(b.x)], 1u);
    return b;
}
__device__ __forceinline__ void xcd_barrier_complete(unsigned* bar, unsigned x, unsigned& nloc, unsigned& nx) {
    const unsigned G = gridDim.x * gridDim.y * gridDim.z;
    unsigned sum, cnt, mine, sp = 0u;
    for (;;) {
        sum = 0u; cnt = 0u; mine = 0u;
#pragma unroll
        for (unsigned j = 0; j < 16; ++j) { const unsigned c = xb_ld(&bar[XB_XCNT(j)]); sum += c; cnt += (c > 0u) ? 1u : 0u; mine = (j == x) ? c : mine; }
        if (sum == G) break;
        __builtin_amdgcn_s_sleep(1);
        if ((++sp & 255u) == 0u) { if (xb_ld(&bar[XB_TMO])) break; if (sp > XB_SPIN_CAP) { atomicAdd(&bar[XB_TMO], 1u); break; } }
    }
    nloc = mine > 0u ? mine : 1u; nx = cnt > 0u ? cnt : 1u;
}

__device__ __forceinline__ void xcd_barrier(const XcdBarrier& b) {
    asm volatile("s_waitcnt vmcnt(0)" ::: "memory");
    __syncthreads();
    if (threadIdx.x == 0) {
        unsigned* bar = b.bar;
        __builtin_amdgcn_s_waitcnt(0);
        unsigned nloc = b.st[0], nx = b.st[1];
        if (nloc == 0u) { xcd_barrier_complete(bar, b.x, nloc, nx); b.st[0] = nloc; b.st[1] = nx; }
        const unsigned old = xb_add(&bar[XB_XSUB(b.x)], 1u);
        const unsigned gen = old / nloc;
        if (old + 1u == (gen + 1u) * nloc) {
            __builtin_amdgcn_fence(__ATOMIC_RELEASE, "agent");
            asm volatile("s_waitcnt vmcnt(0)" ::: "memory");
            const unsigned og = xb_add(&bar[XB_TOP], 1u);
            const unsigned tg = og / nx;
            if (og + 1u == (tg + 1u) * nx) xb_add(&bar[XB_TOPGEN], 1u);
            else XB_SPIN(xb_ld(&bar[XB_TOPGEN]) == tg, bar);
            __builtin_amdgcn_fence(__ATOMIC_ACQUIRE, "agent");
            xb_add(&bar[XB_XGEN(b.x)], 1u);
            asm volatile("s_waitcnt vmcnt(0)" ::: "memory");
        } else {
            XB_SPIN(xb_ld(&bar[XB_XGEN(b.x)]) == gen, bar);
            __builtin_amdgcn_fence(__ATOMIC_ACQUIRE, "agent");
            asm volatile("s_waitcnt vmcnt(0)" ::: "memory");
        }
    }
    __syncthreads();
}


constexpr int N_PHASES = 1 + 9 * DEPTH;
#ifndef DBG_REP
#define DBG_REP 0
#endif
#define NREP(j) (1 + ((DBG_REP >> (j)) & 1))
#ifndef DBG_MASK
#define DBG_MASK 0x3ff
#endif
#define EN(j) ((DBG_MASK >> (j)) & 1)
__device__ __forceinline__ const Args* args_here() { const Args* p = (const Args*)__builtin_amdgcn_kernarg_segment_ptr(); asm volatile("" : "+s"(p)); return p; }
#define PH_ARGS Args a = a_in; { unsigned char* w_ = a.ws; asm volatile("" : "+s"(w_)); a.ws = w_; } unsigned char* const ws = a.ws; (void)ws
__global__ void __launch_bounds__(NTHR, 2) mega_fwd(Args a_in) {
    extern __shared__ __attribute__((aligned(16))) unsigned char lds_raw[];
    LAS unsigned char* lds = (LAS unsigned char*)lds_raw;
    cg::grid_group grid = cg::this_grid();
    volatile LAS unsigned* bst = (volatile LAS unsigned*)(lds + 131072 + 64);
    if (threadIdx.x < 2) bst[threadIdx.x] = 0u;
    __syncthreads();
    XcdBarrier bar = xcd_barrier_post((unsigned*)(a_in.ws + WS_BAR), bst);
    const int G = gridDim.x, bid = blockIdx.x;
    const int lo = a_in.ph_lo, hi = a_in.ph_hi;
#define IN(k) (lo <= (k) && (k) < hi)
#define SEAM(k) do { if (IN((k) + 1)) { if ((k) == 0) grid.sync(); else { XcdBarrier b2 = bar; asm volatile("" : "+s"(b2.bar)); xcd_barrier(b2); } } } while (0)
    if (IN(0) && EN(0)) for (int rep = 0; rep < NREP(0); ++rep) { PH_ARGS; p0_prologue(a, lds); SEAM(0); }
    for (int l = 0; l < DEPTH; ++l) {
        const int P = 1 + 9 * l;
        if (IN(P) && EN(1)) for (int rep = 0; rep < NREP(1); ++rep) {
            PH_ARGS; const bf16* wl = (const bf16*)(ws + WS_W) + (size_t)l * W_LAYER;
            pg8::Gemm gm{(const bf16*)(ws + WS_XB), wl + W_IN, MT, NIN, DM, DM, DM}; pg8::StaticOrder S; S.init(MT, NIN, G, bid);
            pg8::EpiRow E{(bf16*)(ws + WS_PROJ), NIN, (const float*)(ws + WS_RSTD), 0, 0, 0.f, EPS, (float*)(ws + WS_PS_QKV), 16, 14, 18};
            pg8::gemm_phase<pg8::EpiRow, pg8::StaticOrder, true, true>(lds, gm, S, E); SEAM(P); }
        if (IN(P + 1) && EN(2)) for (int rep = 0; rep < NREP(2); ++rep) {
#define P1_ARGS PH_ARGS; const bf16* wl = (const bf16*)(ws + WS_W) + (size_t)l * W_LAYER; const bf16* proj = (const bf16*)(ws + WS_PROJ); float* ps_qkv = (float*)(ws + WS_PS_QKV); (void)wl; (void)proj; (void)ps_qkv
            { P1_ARGS; pg8::Gemm gm{proj + C_QC, wl + W_Q, MT, 1536, 512, NIN, 512}; pg8::StaticOrder S; S.init(MT, 1536, G, bid);
              pg8::EpiQ E{(bf16*)(ws + WS_Q), ps_qkv, EPS, QSCALE, (const float*)(ws + WS_COS), (const float*)(ws + WS_SIN)};
              pg8::gemm_phase<pg8::EpiQ, pg8::StaticOrder, true, true>(lds, gm, S, E); }
            { P1_ARGS; pg8::Gemm gm{proj + C_KVC, wl + W_K, MT, 1024, 512, NIN, 512}; pg8::StaticOrder S; S.init(MT, 1024, G, (bid + 64) % G);
              pg8::EpiRow E{(bf16*)(ws + WS_KN), 1024, ps_qkv + 8, 16, 8, 1.f / 512.f, EPS, nullptr, 0, 0, 0};
              pg8::gemm_phase<pg8::EpiRow, pg8::StaticOrder, true, true>(lds, gm, S, E); }
            { P1_ARGS; pg8::Gemm gm{wl + W_V, proj + C_KVC, 1024, MT, 512, 512, NIN}; pg8::StaticOrder S; S.init(1024, MT, G, (bid + 192) % G);
              pg8::EpiVT E{(bf16*)(ws + WS_VT), MT, ps_qkv, EPS};
              pg8::gemm_phase<pg8::EpiVT, pg8::StaticOrder, true, true>(lds, gm, S, E); }
            { PH_ARGS; kpe_rope(a); }
            __syncthreads();
            PH_ARGS;
            for (int it = bid; it < 1024; it += G) { if (it < 512) gla_local_item<0>(a, lds, l, it >> 6, it & 63); else gla_local_item<1>(a, lds, l, (it - 512) >> 6, it & 63); }
            SEAM(P + 1); }
        if (IN(P + 2) && EN(3)) for (int rep = 0; rep < NREP(3); ++rep) {
            PH_ARGS;
            for (int it = bid; it < 96; it += G) scan_item(a, it);
            attn_queue(a, lds, (unsigned*)(ws + WS_BAR) + 8 + 8 * l);
            if (l + 1 < DEPTH && rep == 0) conv_layer(a, l + 1, lds, (unsigned*)(ws + WS_BAR) + l);
            SEAM(P + 2); }
        if (IN(P + 3) && EN(4)) for (int rep = 0; rep < NREP(4); ++rep) {
            PH_ARGS;
            for (int it = bid; it < 256; it += G) gla_final_item(a, l, it);
            if (rep + 1 == NREP(4)) mla_finish(a);
            SEAM(P + 3); }
        if (IN(P + 4) && EN(5)) for (int rep = 0; rep < NREP(5); ++rep) {
            PH_ARGS; const bf16* wl = (const bf16*)(ws + WS_W) + (size_t)l * W_LAYER;
            pg8::Gemm gm{(const bf16*)(ws + WS_Y), wl + W_OUT, MT, DM, DM, DM, DM}; pg8::StaticOrder S; S.init(MT, DM, G, bid);
            pg8::EpiRow E{(bf16*)(ws + WS_MB), DM, nullptr, 0, 0, 0.f, EPS, (float*)(ws + WS_PS_M), 32, 0, 8};
            pg8::gemm_phase<pg8::EpiRow, pg8::StaticOrder, true, true>(lds, gm, S, E); SEAM(P + 4); }
        if (IN(P + 5) && EN(6)) { PH_ARGS; rowpass(l == 0 ? a.x : a.out, a.out, (const bf16*)(ws + WS_MB), (const float*)(ws + WS_PS_M), a.attn_post + l * DM, (bf16*)(ws + WS_XB), (float*)(ws + WS_RSTD)); SEAM(P + 5); }
        if (IN(P + 6) && EN(7)) for (int rep = 0; rep < NREP(7); ++rep) {
            PH_ARGS; const bf16* wl = (const bf16*)(ws + WS_W) + (size_t)l * W_LAYER;
            pg8::Gemm gm{(const bf16*)(ws + WS_XB), wl + W_GU, MT, NGU, DM, DM, DM}; pg8::StaticOrder S; S.init(MT, NGU, G, bid);
            pg8::EpiGU E{(bf16*)(ws + WS_HDN), DFF, (const float*)(ws + WS_RSTD)};
            pg8::gemm_phase<pg8::EpiGU, pg8::StaticOrder, true, true>(lds, gm, S, E); SEAM(P + 6); }
        if (IN(P + 7) && EN(8)) for (int rep = 0; rep < NREP(8); ++rep) {
            PH_ARGS; const bf16* wl = (const bf16*)(ws + WS_W) + (size_t)l * W_LAYER;
            pg8::Gemm gm{(const bf16*)(ws + WS_HDN), wl + W_DN, MT, DM, DFF, DFF, DFF}; pg8::StaticOrder S; S.init(MT, DM, G, bid);
            pg8::EpiRow E{(bf16*)(ws + WS_MB), DM, nullptr, 0, 0, 0.f, EPS, (float*)(ws + WS_PS_M), 32, 0, 8};
            pg8::gemm_phase<pg8::EpiRow, pg8::StaticOrder, true, true>(lds, gm, S, E); SEAM(P + 7); }
        if (IN(P + 8) && EN(9)) { PH_ARGS; rowpass(a.out, a.out, (const bf16*)(ws + WS_MB), (const float*)(ws + WS_PS_M), a.ffn_post + l * DM, (bf16*)(ws + WS_XB), (float*)(ws + WS_RSTD)); if (l + 1 < DEPTH) SEAM(P + 8); }
    }
#undef IN
#undef SEAM
}

extern "C" void kernel_launch(void* const* d_in, const int* in_sizes, int n_in, void* d_out, int out_size, void* d_ws, size_t ws_size, hipStream_t stream) {
    static int grid = 0;
    if (grid == 0) {
        if (n_in != 21 || in_sizes[0] != MT * DM || out_size != MT * DM || ws_size < WS_END) { fprintf(stderr, "kernel_launch: unexpected shapes (n_in %d, in0 %d, out %d, ws %zu, need %zu)\n", n_in, n_in > 0 ? in_sizes[0] : -1, out_size, ws_size, (size_t)WS_END); grid = -1; return; }
        int dev = 0, cus = 0, per_cu = 0;
        hipGetDevice(&dev); hipDeviceGetAttribute(&cus, hipDeviceAttributeMultiprocessorCount, dev);
        if (hipFuncSetAttribute((const void*)mega_fwd, hipFuncAttributeMaxDynamicSharedMemorySize, LDS_BYTES) != hipSuccess) { fprintf(stderr, "kernel_launch: hipFuncSetAttribute failed\n"); grid = -1; return; }
        if (hipOccupancyMaxActiveBlocksPerMultiprocessor(&per_cu, (const void*)mega_fwd, NTHR, LDS_BYTES) != hipSuccess || per_cu < 1) { fprintf(stderr, "kernel_launch: occupancy query says %d blocks per CU\n", per_cu); (void)hipGetLastError(); per_cu = 1; }
        grid = cus > 0 ? cus : 256;
    }
    if (grid < 0) return;
    Args a{};
    a.x = (const float*)d_in[0]; a.pos = (const int*)d_in[1]; a.attn_pre = (const float*)d_in[2]; a.w_in = (const float*)d_in[3]; a.gate_w2 = (const float*)d_in[4]; a.gate_b = (const float*)d_in[5];
    a.gla_norm = (const float*)d_in[6]; a.lb_logits = (const float*)d_in[7]; a.hgrn_norm = (const float*)d_in[8]; a.q_norm = (const float*)d_in[9]; a.wq_b = (const float*)d_in[10]; a.kv_norm = (const float*)d_in[11];
    a.wkv_b = (const float*)d_in[12]; a.mla_out_norm = (const float*)d_in[13]; a.w_out = (const float*)d_in[14]; a.attn_post = (const float*)d_in[15]; a.ffn_pre = (const float*)d_in[16];
    a.w_gate = (const float*)d_in[17]; a.w_up = (const float*)d_in[18]; a.w_down = (const float*)d_in[19]; a.ffn_post = (const float*)d_in[20]; a.out = (float*)d_out; a.ws = (unsigned char*)d_ws;
    if (hipMemsetAsync((char*)d_ws + WS_BAR, 0, BAR_BYTES, stream) != hipSuccess) { fprintf(stderr, "kernel_launch: memset failed\n"); return; }
#if MK_PER_PHASE
    for (int p = 0; p < N_PHASES; ++p) { a.ph_lo = p; a.ph_hi = p + 1; hipLaunchKernelGGL(mega_fwd, dim3(grid), dim3(NTHR), LDS_BYTES, stream, a); }
#else
    a.ph_lo = 0; a.ph_hi = N_PHASES; void* args[] = {&a};
    hipError_t e = hipLaunchCooperativeKernel((const void*)mega_fwd, dim3(grid), dim3(NTHR), args, LDS_BYTES, stream);
    if (e != hipSuccess) fprintf(stderr, "kernel_launch: cooperative launch failed: %s (grid %d)\n", hipGetErrorString(e), grid);
#endif
}
```

```cpp
#include <hip/hip_runtime.h>
#include <hip/hip_cooperative_groups.h>
#include <cstdio>
#include <cstdint>
namespace cg = cooperative_groups;
#ifndef MK_PER_PHASE
#define MK_PER_PHASE 0
#endif
namespace pg8 {
#define PG8_LAS __attribute__((address_space(3)))
typedef unsigned short bf16_t;
typedef short bf16x8 __attribute__((ext_vector_type(8)));
typedef float f32x4 __attribute__((ext_vector_type(4)));
typedef unsigned u32x4 __attribute__((ext_vector_type(4)));
constexpr int BM = 256, BK = 64, HALF = 128, HTB = HALF * BK * 2  , STAGE_BYTES = 8 * HTB, NXCD = 8, WGM = 8;

__host__ __device__ __forceinline__ int lds_byte(int r, int c) { const int st = (r >> 4) * 2 + (c >> 5), rr = r & 15, cc = c & 31, ob = rr * 64 + cc * 2; return st * 1024 + (ob ^ (((ob >> 9) & 1) << 5)); }
__host__ __device__ __forceinline__ void stage_rc(int b, int& R, int& C) { const int st = b / 1024, sb = b % 1024, swz = sb ^ (((sb >> 9) & 1) << 5); R = (st >> 1) * 16 + swz / 64; C = (st & 1) * 32 + (swz % 64) / 2; }
__host__ __device__ __forceinline__ int perm32(int rho) { const int n = rho >> 4, i = rho & 15; return 8 * (i >> 2) + 4 * n + (i & 3); }

struct Unit { int pm, pn; };
struct Gemm { const bf16_t* A; const bf16_t* Bt; int M, N, K, lda, ldb; };

struct StaticOrder {
    int nM, nN, nwg, G, c;
    __host__ __device__ void init(int M, int N, int G_, int c_) { nM = M / BM; nN = N / BM; nwg = nM * nN; G = G_; c = c_; }
    __host__ __device__ bool next(int i, Unit& u) const {
        const long L = (long)i * G + c; if (L >= nwg) return false;
        int wgid = (int)L; { const int q = nwg / NXCD, r = nwg % NXCD, xcd = wgid % NXCD, off = wgid / NXCD; wgid = (xcd < r ? xcd * (q + 1) : r * (q + 1) + (xcd - r) * q) + off; }
        const int nig = WGM * nN, gid = wgid / nig, fm = gid * WGM, gsz = (nM - fm) < WGM ? (nM - fm) : WGM;
        u.pm = fm + ((wgid % nig) % gsz); u.pn = (wgid % nig) / gsz; return true;
    }
    __device__ __forceinline__ void a_ready(const Unit&) const {}
    __device__ __forceinline__ void done(const Unit&) const {}
};

__device__ __forceinline__ unsigned cvt_pk_bf16(float lo, float hi) { unsigned r; asm volatile("v_cvt_pk_bf16_f32 %0, %1, %2" : "=v"(r) : "v"(lo), "v"(hi)); return r; }
typedef float f32x2 __attribute__((ext_vector_type(2)));
__device__ __forceinline__ float quad_col_sum(float v) { v += __shfl_xor(v, 16); v += __shfl_xor(v, 32); return v; }
struct EpiRow {
    static constexpr bool PERM = true, AFTER_DRAIN = false;
    bf16_t* O; int ldc; const float* rs; int rs_ld, rs_n; float rs_mul; float eps;
    float* ps; int ps_ld, pn_lo, pn_hi;
    __device__ __forceinline__ void operator()(const f32x4 (&acc)[2][2][4][2], const Unit& u, int wr, int wc, int fr, int fq) const {
        const int row0 = u.pm * BM + wr * 64 + fr, col0 = u.pn * BM + wc * 32 + 8 * fq;
        float* sq = (ps && u.pn >= pn_lo && u.pn < pn_hi) ? ps + (u.pn - pn_lo) * 4 + wc : nullptr;
#pragma unroll
        for (int ai = 0; ai < 2; ++ai)
#pragma unroll
            for (int m = 0; m < 4; ++m) { const int row = row0 + ai * HALF + m * 16; bf16_t* rowp = O + (size_t)row * ldc + col0;
                float sc = 1.f; if (rs) { if (rs_n == 0) sc = rs[row]; else { float t = 0.f; for (int i = 0; i < rs_n; i += 4) { const f32x4 q = *(const f32x4*)(rs + (size_t)row * rs_ld + i); t += (q[0] + q[1]) + (q[2] + q[3]); } sc = __builtin_amdgcn_rsqf(t * rs_mul + eps); } }
                float ss = 0.f;
#pragma unroll
                for (int bj = 0; bj < 2; ++bj) { f32x4 v0 = acc[ai][bj][m][0] * sc, v1 = acc[ai][bj][m][1] * sc;
                    ss += (v0[0] * v0[0] + v0[1] * v0[1]) + (v0[2] * v0[2] + v0[3] * v0[3]) + (v1[0] * v1[0] + v1[1] * v1[1]) + (v1[2] * v1[2] + v1[3] * v1[3]);
                    u32x4 w; w.x = cvt_pk_bf16(v0[0], v0[1]); w.y = cvt_pk_bf16(v0[2], v0[3]); w.z = cvt_pk_bf16(v1[0], v1[1]); w.w = cvt_pk_bf16(v1[2], v1[3]);
                    *(u32x4*)(rowp + bj * HALF) = w; }
                if (sq) { ss = quad_col_sum(ss); if (fq == 0) sq[(size_t)row * ps_ld] = ss; } }
    }
};
struct EpiQ {
    static constexpr bool PERM = true, AFTER_DRAIN = false;
    bf16_t* O; const float* ssq; float eps; float qscale; const float* ctab; const float* stab;
    __device__ __forceinline__ void operator()(const f32x4 (&acc)[2][2][4][2], const Unit& u, int wr, int wc, int fr, int fq) const {
        const int row0 = u.pm * BM + wr * 64 + fr; const bool rope = u.pn >= 4;
#pragma unroll
        for (int ai = 0; ai < 2; ++ai)
#pragma unroll
            for (int m = 0; m < 4; ++m) { const int row = row0 + ai * HALF + m * 16; const f32x4 s0 = *(const f32x4*)(ssq + (size_t)row * 16), s1 = *(const f32x4*)(ssq + (size_t)row * 16 + 4);
                const float sc = __builtin_amdgcn_rsqf((((s0[0] + s0[1]) + (s0[2] + s0[3])) + ((s1[0] + s1[1]) + (s1[2] + s1[3]))) * (1.f / 512.f) + eps) * qscale;
#pragma unroll
                for (int bj = 0; bj < 2; ++bj) { f32x4 v0 = acc[ai][bj][m][0] * sc, v1 = acc[ai][bj][m][1] * sc; int dst;
                    if (!rope) { const int c = u.pn * BM + bj * HALF + wc * 32 + 8 * fq; dst = (c >> 7) * 192 + (c & 127); }
                    else { const int c = (u.pn - 4) * BM + bj * HALF + wc * 32 + 8 * fq; const int hh = c >> 6, j = c & 63; dst = hh * 192 + 128 + j;
                        const f32x4 cs = *(const f32x4*)(ctab + (size_t)row * 32 + (j >> 1)), sn = *(const f32x4*)(stab + (size_t)row * 32 + (j >> 1));
                        f32x4 a0, a1; a0[0] = v0[0] * cs[0] - v0[1] * sn[0]; a0[1] = v0[1] * cs[0] + v0[0] * sn[0]; a0[2] = v0[2] * cs[1] - v0[3] * sn[1]; a0[3] = v0[3] * cs[1] + v0[2] * sn[1];
                        a1[0] = v1[0] * cs[2] - v1[1] * sn[2]; a1[1] = v1[1] * cs[2] + v1[0] * sn[2]; a1[2] = v1[2] * cs[3] - v1[3] * sn[3]; a1[3] = v1[3] * cs[3] + v1[2] * sn[3]; v0 = a0; v1 = a1; }
                    u32x4 w; w.x = cvt_pk_bf16(v0[0], v0[1]); w.y = cvt_pk_bf16(v0[2], v0[3]); w.z = cvt_pk_bf16(v1[0], v1[1]); w.w = cvt_pk_bf16(v1[2], v1[3]);
                    *(u32x4*)(O + (size_t)row * 1536 + dst) = w; } }
    }
};
struct EpiVT {
    static constexpr bool PERM = true, AFTER_DRAIN = false;
    bf16_t* O; int ldc; const float* ssq; float eps;
    __device__ __forceinline__ void operator()(const f32x4 (&acc)[2][2][4][2], const Unit& u, int wr, int wc, int fr, int fq) const {
        const int row0 = u.pm * BM + wr * 64 + fr, col0 = u.pn * BM + wc * 32 + 8 * fq;
        f32x4 s[2][2];
#pragma unroll
        for (int bj = 0; bj < 2; ++bj)
#pragma unroll
            for (int n = 0; n < 2; ++n)
#pragma unroll
                for (int e = 0; e < 4; ++e) { const float* p = ssq + (size_t)(col0 + bj * HALF + 4 * n + e) * 16 + 8; const f32x4 s0 = *(const f32x4*)p, s1 = *(const f32x4*)(p + 4);
                    s[bj][n][e] = __builtin_amdgcn_rsqf((((s0[0] + s0[1]) + (s0[2] + s0[3])) + ((s1[0] + s1[1]) + (s1[2] + s1[3]))) * (1.f / 512.f) + eps); }
#pragma unroll
        for (int ai = 0; ai < 2; ++ai)
#pragma unroll
            for (int m = 0; m < 4; ++m) { bf16_t* rowp = O + (size_t)(row0 + ai * HALF + m * 16) * ldc + col0;
#pragma unroll
                for (int bj = 0; bj < 2; ++bj) { const f32x4 v0 = acc[ai][bj][m][0] * s[bj][0], v1 = acc[ai][bj][m][1] * s[bj][1];
                    u32x4 w; w.x = cvt_pk_bf16(v0[0], v0[1]); w.y = cvt_pk_bf16(v0[2], v0[3]); w.z = cvt_pk_bf16(v1[0], v1[1]); w.w = cvt_pk_bf16(v1[2], v1[3]);
                    *(u32x4*)(rowp + bj * HALF) = w; } }
    }
};
struct EpiGU {
    static constexpr bool PERM = true, AFTER_DRAIN = false;
    bf16_t* O; int ldc; const float* rs;
    __device__ __forceinline__ void operator()(const f32x4 (&acc)[2][2][4][2], const Unit& u, int wr, int wc, int fr, int fq) const {
        const int row0 = u.pm * BM + wr * 64 + fr, col0 = u.pn * HALF + wc * 32 + 8 * fq;
#pragma unroll
        for (int ai = 0; ai < 2; ++ai)
#pragma unroll
            for (int m = 0; m < 4; ++m) { const int row = row0 + ai * HALF + m * 16; const float sc = rs[row]; float o[8];
#pragma unroll
                for (int n = 0; n < 2; ++n)
#pragma unroll
                    for (int e = 0; e < 4; ++e) { const float gv = acc[ai][0][m][n][e] * sc, uv = acc[ai][1][m][n][e] * sc;
                        o[4 * n + e] = gv * __builtin_amdgcn_rcpf(1.f + __expf(-gv)) * uv; }
                u32x4 w; w.x = cvt_pk_bf16(o[0], o[1]); w.y = cvt_pk_bf16(o[2], o[3]); w.z = cvt_pk_bf16(o[4], o[5]); w.w = cvt_pk_bf16(o[6], o[7]);
                *(u32x4*)(O + (size_t)row * ldc + col0) = w; }
    }
};
template <class Epi, class Sched, bool ALIGN_EPI = false, bool SP2 = false>
__device__ __forceinline__ void gemm_phase(PG8_LAS unsigned char* lds, const Gemm g, const Sched& S, const Epi& E) {
    int tid_o = threadIdx.x; asm volatile("" : "+v"(tid_o)); const int tid = tid_o, wid = __builtin_amdgcn_readfirstlane(tid >> 6), lane = tid & 63, wr = wid >> 2, wc = wid & 3, fr = lane & 15, fq = lane >> 4;
    const int K = g.K, nt = K / BK;
    unsigned voffA[2], voffB[2];
#pragma unroll
    for (int i = 0; i < 2; ++i) { int R, C; stage_rc(tid * 16 + i * 8192, R, C); const int Rb = Epi::PERM ? ((R & ~31) + perm32(R & 31)) : R;
        voffA[i] = (unsigned)(R * g.lda + C) * 2u; voffB[i] = (unsigned)(Rb * g.ldb + C) * 2u; }
    const size_t kstep = (size_t)(BK * 2);
    const size_t hstepA = (size_t)HALF * g.lda * 2, hstepB = (size_t)HALF * g.ldb * 2;
    const size_t tstepA = 2 * hstepA, tstepB = 2 * hstepB;
    const unsigned ldsw = (unsigned)wid * 1024u;
    const int aoff = lds_byte(wr * 64 + fr, fq * 8), boff = lds_byte(wc * 32 + fr, fq * 8);
#define PG8_SA(b, h) (((b) * 2 + (h)) * HTB)
#define PG8_SB(b, h) ((4 + (b) * 2 + (h)) * HTB)
#define PG8_STAGE(bufoff, gbase, voff) do { _Pragma("unroll") for (int _i = 0; _i < 2; ++_i) \
        __builtin_amdgcn_global_load_lds((const unsigned*)((const char*)(gbase) + (voff)[_i]), (PG8_LAS unsigned*)(lds + (bufoff) + ldsw + _i * 8192), 16, 0, 0); } while (0)
#define PG8_LDA(dst, b, h) do { _Pragma("unroll") for (int m = 0; m < 4; ++m) _Pragma("unroll") for (int k = 0; k < 2; ++k) dst[m][k] = *(const PG8_LAS bf16x8*)(lds + PG8_SA(b, h) + aoff + m * 2048 + k * 1024); } while (0)
#define PG8_LDB(dst, b, h) do { _Pragma("unroll") for (int n = 0; n < 2; ++n) _Pragma("unroll") for (int k = 0; k < 2; ++k) dst[n][k] = *(const PG8_LAS bf16x8*)(lds + PG8_SB(b, h) + boff + n * 2048 + k * 1024); } while (0)
#define PG8_MMA(ai, bj, At, Bt) do { __builtin_amdgcn_s_setprio(1); _Pragma("unroll") for (int m = 0; m < 4; ++m) _Pragma("unroll") for (int n = 0; n < 2; ++n) _Pragma("unroll") for (int k = 0; k < 2; ++k) \
        acc[ai][bj][m][n] = __builtin_amdgcn_mfma_f32_16x16x32_bf16(Bt[n][k], At[m][k], acc[ai][bj][m][n], 0, 0, 0); __builtin_amdgcn_s_setprio(0); } while (0)
#define PG8_WAIT_V(n) asm volatile("s_waitcnt vmcnt(" #n ")" ::: "memory")
#define PG8_WAIT_L(n) asm volatile("s_waitcnt lgkmcnt(" #n ")" ::: "memory")
#define PG8_BAR __builtin_amdgcn_s_barrier()
#define PG8_SCHED __builtin_amdgcn_sched_barrier(0)
    Unit cur, nxt; int ui = 0;
    if (!S.next(0, cur)) return;
    f32x4 acc[2][2][4][2];
#pragma unroll
    for (int a = 0; a < 2; ++a)
#pragma unroll
        for (int b = 0; b < 2; ++b)
#pragma unroll
            for (int m = 0; m < 4; ++m)
#pragma unroll
                for (int n = 0; n < 2; ++n) acc[a][b][m][n] = (f32x4){0.f, 0.f, 0.f, 0.f};
    bf16x8 At[4][2], B0[2][2], B1[2][2];
    const char* cA = (const char*)g.A + (size_t)cur.pm * tstepA; const char* cB = (const char*)g.Bt + (size_t)cur.pn * tstepB;
    S.a_ready(cur);
    if constexpr (SP2) {
        PG8_STAGE(PG8_SB(0, 0), cB, voffB); PG8_STAGE(PG8_SB(0, 1), cB + hstepB, voffB); PG8_STAGE(PG8_SA(0, 0), cA, voffA); PG8_STAGE(PG8_SA(0, 1), cA + hstepA, voffA);
        if (wr == 1) PG8_BAR;
        PG8_WAIT_V(2); PG8_BAR;
        PG8_STAGE(PG8_SB(1, 0), cB + kstep, voffB); PG8_STAGE(PG8_SA(1, 0), cA + kstep, voffA); PG8_STAGE(PG8_SB(1, 1), cB + hstepB + kstep, voffB);
        PG8_WAIT_V(6); PG8_BAR;
    } else {
        PG8_STAGE(PG8_SB(0, 0), cB, voffB); PG8_STAGE(PG8_SA(0, 0), cA, voffA); PG8_STAGE(PG8_SB(0, 1), cB + hstepB, voffB); PG8_STAGE(PG8_SA(0, 1), cA + hstepA, voffA);
        if (wr == 1) PG8_BAR;
        PG8_WAIT_V(4); PG8_BAR;
        PG8_STAGE(PG8_SB(1, 0), cB + kstep, voffB); PG8_STAGE(PG8_SA(1, 0), cA + kstep, voffA); PG8_STAGE(PG8_SB(1, 1), cB + hstepB + kstep, voffB);
        PG8_WAIT_V(6); PG8_BAR;
    }
    for (;;) {
        const bool has_next = S.next(ui + 1, nxt);
        const char* nA = has_next ? (const char*)g.A + (size_t)nxt.pm * tstepA : cA; const char* nB = has_next ? (const char*)g.Bt + (size_t)nxt.pn * tstepB : cB;
        for (int t = 0; t < nt; t += 2) {
            const bool last = (t == nt - 2);
            const char* a1 = cA + (size_t)(t + 1) * kstep;
            const char* a2 = last ? nA : cA + (size_t)(t + 2) * kstep; const char* b2 = last ? nB : cB + (size_t)(t + 2) * kstep;
            const char* a3 = a2 + kstep; const char* b3 = b2 + kstep;
            if (last && has_next) S.a_ready(nxt);
            if constexpr (SP2) {
            PG8_LDB(B0, 0, 0); PG8_LDB(B1, 0, 1); PG8_SCHED; PG8_LDA(At, 0, 0); PG8_STAGE(PG8_SA(1, 1), a1 + hstepA, voffA);
            PG8_WAIT_V(8); PG8_WAIT_L(0); PG8_BAR; PG8_MMA(0, 0, At, B0); PG8_MMA(0, 1, At, B1); PG8_BAR; PG8_SCHED;
            PG8_LDA(At, 0, 1); PG8_STAGE(PG8_SB(0, 0), b2, voffB); PG8_STAGE(PG8_SB(0, 1), b2 + hstepB, voffB); PG8_STAGE(PG8_SA(0, 0), a2, voffA);
            PG8_WAIT_V(8); PG8_WAIT_L(0); PG8_BAR; PG8_MMA(1, 0, At, B0); PG8_MMA(1, 1, At, B1); PG8_BAR; PG8_SCHED;
            PG8_LDB(B0, 1, 0); PG8_LDB(B1, 1, 1); PG8_SCHED; PG8_LDA(At, 1, 0); PG8_STAGE(PG8_SA(0, 1), a2 + hstepA, voffA);
            PG8_WAIT_V(8); PG8_WAIT_L(0); PG8_BAR; PG8_MMA(0, 0, At, B0); PG8_MMA(0, 1, At, B1); PG8_BAR; PG8_SCHED;
            PG8_LDA(At, 1, 1); PG8_STAGE(PG8_SB(1, 0), b3, voffB); PG8_STAGE(PG8_SB(1, 1), b3 + hstepB, voffB); PG8_STAGE(PG8_SA(1, 0), a3, voffA);
            PG8_WAIT_V(8); PG8_WAIT_L(0); PG8_BAR; PG8_MMA(1, 0, At, B0); PG8_MMA(1, 1, At, B1); PG8_BAR; PG8_SCHED;
            } else {
            PG8_LDB(B0, 0, 0); PG8_SCHED; PG8_LDA(At, 0, 0); PG8_STAGE(PG8_SA(1, 1), a1 + hstepA, voffA);
            PG8_WAIT_L(8); PG8_BAR; PG8_WAIT_L(0); PG8_MMA(0, 0, At, B0); PG8_BAR; PG8_SCHED;
            PG8_LDB(B1, 0, 1); PG8_STAGE(PG8_SB(0, 0), b2, voffB);
            PG8_BAR; PG8_WAIT_L(0); PG8_MMA(0, 1, At, B1); PG8_BAR;
            PG8_LDA(At, 0, 1); PG8_STAGE(PG8_SA(0, 0), a2, voffA);
            PG8_BAR; PG8_WAIT_L(0); PG8_MMA(1, 0, At, B0); PG8_BAR; PG8_SCHED;
            PG8_STAGE(PG8_SB(0, 1), b2 + hstepB, voffB);
            PG8_WAIT_V(6); PG8_BAR; PG8_MMA(1, 1, At, B1); PG8_BAR;
            PG8_LDB(B0, 1, 0); PG8_SCHED; PG8_LDA(At, 1, 0); PG8_STAGE(PG8_SA(0, 1), a2 + hstepA, voffA);
            PG8_WAIT_L(8); PG8_BAR; PG8_WAIT_L(0); PG8_MMA(0, 0, At, B0); PG8_BAR; PG8_SCHED;
            PG8_LDB(B1, 1, 1); PG8_STAGE(PG8_SB(1, 0), b3, voffB);
            PG8_BAR; PG8_WAIT_L(0); PG8_MMA(0, 1, At, B1); PG8_BAR;
            PG8_LDA(At, 1, 1); PG8_STAGE(PG8_SA(1, 0), a3, voffA);
            PG8_BAR; PG8_WAIT_L(0); PG8_MMA(1, 0, At, B0); PG8_BAR; PG8_SCHED;
            PG8_STAGE(PG8_SB(1, 1), b3 + hstepB, voffB);
            PG8_WAIT_V(6); PG8_BAR; PG8_MMA(1, 1, At, B1); PG8_BAR;
            }
        }
        if constexpr (ALIGN_EPI) { if (wr == 0) PG8_BAR; }
        if constexpr (!Epi::AFTER_DRAIN) { E(acc, cur, wr, wc, fr, fq); S.done(cur); }
        if (!has_next) break;
#pragma unroll
        for (int a = 0; a < 2; ++a)
#pragma unroll
            for (int b = 0; b < 2; ++b)
#pragma unroll
                for (int m = 0; m < 4; ++m)
#pragma unroll
                    for (int n = 0; n < 2; ++n) acc[a][b][m][n] = (f32x4){0.f, 0.f, 0.f, 0.f};
        cur = nxt; cA = nA; cB = nB; ++ui;
        if constexpr (ALIGN_EPI) { if (wr == 1) PG8_BAR; }
    }
    PG8_WAIT_V(0);
    if constexpr (!ALIGN_EPI) { if (wr == 0) PG8_BAR; }
    PG8_BAR;
    if constexpr (Epi::AFTER_DRAIN) { E.fused(acc, cur, wr, wc, fr, fq, lds, wid, lane); S.done(cur); }
#undef PG8_SA
#undef PG8_SB
#undef PG8_STAGE
#undef PG8_LDA
#undef PG8_LDB
#undef PG8_MMA
#undef PG8_WAIT_V
#undef PG8_WAIT_L
#undef PG8_BAR
#undef PG8_SCHED
}
}
#define LAS __attribute__((address_space(3)))
typedef unsigned short bf16;
typedef short bf16x8 __attribute__((ext_vector_type(8)));
typedef float f32x4 __attribute__((ext_vector_type(4)));
typedef float f32x16 __attribute__((ext_vector_type(16)));
typedef unsigned u32x4 __attribute__((ext_vector_type(4)));
typedef unsigned u32x2 __attribute__((ext_vector_type(2)));
constexpr int NB = 2, SEQ = 4096, MT = NB * SEQ, DM = 2048, DEPTH = 4, DIN = 4688, NIN = 4864, DFF = 5632, NGU = 2 * DFF;
constexpr int C_GQ = 0, C_GK = 256, C_GV = 512, C_GO = 1024, C_HQ = 1536, C_HF = 2048, C_HI = 2560, C_HO = 3072, C_QC = 3584, C_KVC = 4096, C_KPE = 4608, C_GLOW = 4672;
constexpr float EPS = 1e-6f;
constexpr float QSCALE = 0.07216878364870322f * 1.4426950408889634f;
constexpr int NWAVES = 8, NTHR = 512;
constexpr int LDS_BYTES = 143360;
constexpr size_t W_IN = 0, W_Q = W_IN + (size_t)NIN * DM, W_K = W_Q + 1536 * 512, W_V = W_K + 1024 * 512, W_OUT = W_V + 1024 * 512, W_GU = W_OUT + (size_t)DM * DM,
                 W_DN = W_GU + (size_t)NGU * DM, W_LAYER = W_DN + (size_t)DM * DFF;
constexpr size_t al256(size_t x) { return (x + 255) & ~(size_t)255; }
constexpr size_t WS_PS_QKV = 0, WS_PS_O = WS_PS_QKV + (size_t)MT * 16 * 4, WS_PS_M = WS_PS_O + (size_t)MT * 8 * 4, WS_RSTD = WS_PS_M + (size_t)MT * 32 * 4;
constexpr size_t WS_COS = WS_RSTD + MT * 4, WS_SIN = WS_COS + (size_t)MT * 32 * 4, WS_DL_G = WS_SIN + (size_t)MT * 32 * 4, WS_DL_H = WS_DL_G + 8 * 64 * 64 * 4, WS_KPE = WS_DL_H + 8 * 64 * 128 * 4;
constexpr size_t WS_ML = al256(WS_KPE + (size_t)MT * 64 * 2);
constexpr size_t WS_BAR = al256(WS_ML + (size_t)2 * 16 * 8 * 256 * 2 * 4), BAR_BYTES = 16384;
constexpr size_t WS_W = al256(WS_BAR + BAR_BYTES);
constexpr size_t WS_XB = al256(WS_W + W_LAYER * DEPTH * 2);
constexpr size_t WS_Y = WS_XB + (size_t)MT * DM * 2;
constexpr size_t WS_MB = WS_Y + (size_t)MT * DM * 2;
constexpr size_t WS_VT = WS_MB + (size_t)MT * DM * 2;
constexpr size_t WS_QE_G = WS_VT + (size_t)1024 * MT * 2;
constexpr size_t WS_QE_H = WS_QE_G + (size_t)MT * 256 * 2;
constexpr size_t WS_UT_G = WS_QE_H + (size_t)MT * 512 * 2;
constexpr size_t WS_UT_H = WS_UT_G + (size_t)8 * 64 * 128 * 64 * 4;
constexpr size_t WS_SP_G = WS_UT_H + (size_t)8 * 64 * 128 * 128 * 4;
constexpr size_t WS_SP_H = WS_SP_G + (size_t)8 * 64 * 128 * 64 * 2;
constexpr size_t WS_OI = WS_SP_H + (size_t)8 * 64 * 128 * 128 * 2;
constexpr size_t WS_R1 = WS_OI + (size_t)2 * MT * 512 * 4;
constexpr size_t WS_PROJ = WS_R1, WS_Q = WS_PROJ + (size_t)MT * NIN * 2, WS_KN = WS_Q + (size_t)MT * 1536 * 2, WS_R1_END = WS_KN + (size_t)MT * 1024 * 2;
constexpr size_t WS_HDN = WS_R1;
static_assert(WS_HDN + (size_t)MT * DFF * 2 <= WS_R1_END, "hdn overlay");
constexpr size_t WS_END = WS_R1_END;

struct Args {
    const float* x; const int* pos; const float* attn_pre; const float* w_in; const float* gate_w2; const float* gate_b; const float* gla_norm; const float* lb_logits; const float* hgrn_norm;
    const float* q_norm; const float* wq_b; const float* kv_norm; const float* wkv_b; const float* mla_out_norm; const float* w_out; const float* attn_post; const float* ffn_pre;
    const float* w_gate; const float* w_up; const float* w_down; const float* ffn_post; float* out; unsigned char* ws; int ph_lo, ph_hi;
};

__device__ __forceinline__ unsigned f2bf(float f) { unsigned u = __builtin_bit_cast(unsigned, f); return (u + 0x7fffu + ((u >> 16) & 1u)) >> 16; }
__device__ __forceinline__ float bf2f(bf16 b) { return __builtin_bit_cast(float, (unsigned)b << 16); }
__device__ __forceinline__ unsigned pk2(float lo, float hi) { return pg8::cvt_pk_bf16(lo, hi); }
__device__ __forceinline__ float wave_sum(float v) {
#pragma unroll
    for (int o = 1; o < 64; o <<= 1) v += __shfl_xor(v, o);
    return v;
}
__device__ __forceinline__ int crow(int r, int hi) { return (r & 3) + 8 * (r >> 2) + 4 * hi; }
#define LDS_WAIT() asm volatile("s_waitcnt lgkmcnt(0)" ::: "memory")

__device__ __forceinline__ int w_srccol(int mat, int n) {
    switch (mat) {
    case 0: return n < 1024 ? n : (n < 4672 ? n + 16 : (n < 4688 ? n - 3648 : -1));
    case 1: { if (n < 1024) return (n >> 7) * 192 + (n & 127); const int c = n - 1024, hh = c >> 6, j = c & 63, i = j >> 1; return hh * 192 + 128 + ((j & 1) ? i + 32 : i); }
    case 2: return (n >> 7) * 256 + (n & 127);
    case 3: return (n >> 7) * 256 + 128 + (n & 127);
    case 5: return (n >> 8) * 128 + (n & 127);
    default: return n;
    }
}
struct ConvDesc { const float* src; const float* gain; bf16* dst; int ldsrc, mat, gmin, k0, K, n0; };
constexpr int I_IN = (NIN / 128) * (DM / 128), I_Q = 12 * 4, I_K = 8 * 4, I_V = 8 * 4, I_OUT = 16 * 16, I_GU = (NGU / 128) * 16, I_DN = 16 * (DFF / 128);
constexpr int I_LAYER = I_IN + I_Q + I_K + I_V + I_OUT + I_GU + I_DN;
__device__ __forceinline__ ConvDesc conv_decode(const Args& a, int l, int r) {
    bf16* wl = (bf16*)(a.ws + WS_W) + (size_t)l * W_LAYER; ConvDesc d;
    if (r < I_IN) { const int nb = r % (NIN / 128), kb = r / (NIN / 128); d = ConvDesc{a.w_in + (size_t)l * DM * DIN, a.attn_pre + l * DM, wl + W_IN, DIN, 0, 0, kb * 128, DM, nb * 128}; return d; } r -= I_IN;
    if (r < I_Q) { const int nb = r % 12, kb = r / 12; d = ConvDesc{a.wq_b + (size_t)l * 512 * 1536, a.q_norm + l * 512, wl + W_Q, 1536, 1, 0, kb * 128, 512, nb * 128}; return d; } r -= I_Q;
    if (r < I_K) { const int nb = r % 8, kb = r / 8; d = ConvDesc{a.wkv_b + (size_t)l * 512 * 2048, a.kv_norm + l * 512, wl + W_K, 2048, 2, 0, kb * 128, 512, nb * 128}; return d; } r -= I_K;
    if (r < I_V) { const int nb = r % 8, kb = r / 8; d = ConvDesc{a.wkv_b + (size_t)l * 512 * 2048, a.kv_norm + l * 512, wl + W_V, 2048, 3, 0, kb * 128, 512, nb * 128}; return d; } r -= I_V;
    if (r < I_OUT) { const int nb = r % 16, kb = r / 16; d = ConvDesc{a.w_out + (size_t)l * DM * DM, a.mla_out_norm + l * 1024, wl + W_OUT, DM, 4, 1024, kb * 128, DM, nb * 128}; return d; } r -= I_OUT;
    if (r < I_GU) { const int nb = r % (NGU / 128), kb = r / (NGU / 128); d = ConvDesc{((nb & 1) ? a.w_up : a.w_gate) + (size_t)l * DM * DFF, a.ffn_pre + l * DM, wl + W_GU, DFF, 5, 0, kb * 128, DM, nb * 128}; return d; } r -= I_GU;
    { const int nb = r % 16, kb = r / 16; d = ConvDesc{a.w_down + (size_t)l * DFF * DM, nullptr, wl + W_DN, DM, 6, 0, kb * 128, DFF, nb * 128}; return d; }
}
__device__ __forceinline__ void conv_load(const ConvDesc& d, int tid, f32x4 (&v)[4][2], float (&gn)[4][2]) {
    const int c4 = tid & 31, rp = tid >> 5; int sc[4];
#pragma unroll
    for (int j = 0; j < 4; ++j) sc[j] = w_srccol(d.mat, d.n0 + 4 * c4 + j);
    const bool contig = sc[0] >= 0 && sc[1] == sc[0] + 1 && sc[2] == sc[0] + 2 && sc[3] == sc[0] + 3;
#pragma unroll
    for (int i = 0; i < 4; ++i)
#pragma unroll
        for (int e = 0; e < 2; ++e) { const int k = d.k0 + i * 32 + 2 * rp + e; const float* rowp = d.src + (size_t)k * d.ldsrc;
            if (contig) v[i][e] = *(const f32x4*)(rowp + sc[0]);
            else { v[i][e][0] = sc[0] >= 0 ? rowp[sc[0]] : 0.f; v[i][e][1] = sc[1] >= 0 ? rowp[sc[1]] : 0.f; v[i][e][2] = sc[2] >= 0 ? rowp[sc[2]] : 0.f; v[i][e][3] = sc[3] >= 0 ? rowp[sc[3]] : 0.f; }
            gn[i][e] = (d.gain && k >= d.gmin) ? d.gain[k - d.gmin] : 1.f; }
}
__device__ __forceinline__ void conv_store(const ConvDesc& d, int tid, const f32x4 (&v)[4][2], const float (&gn)[4][2], LAS unsigned* T) {
    constexpr int SD = 65; const int c4 = tid & 31, rp = tid >> 5;
#pragma unroll
    for (int i = 0; i < 4; ++i)
#pragma unroll
        for (int j = 0; j < 4; ++j) T[(c4 + 32 * j) * SD + i * 16 + rp] = pk2(v[i][0][j] * gn[i][0], v[i][1][j] * gn[i][1]);
    __syncthreads();
#pragma unroll
    for (int i = 0; i < 4; ++i) { const int n = i * 32 + (tid >> 4), kc = tid & 15; const LAS unsigned* p = T + n * SD + kc * 4; u32x4 o; o.x = p[0]; o.y = p[1]; o.z = p[2]; o.w = p[3];
        *(u32x4*)(d.dst + (size_t)(d.n0 + 4 * (n & 31) + (n >> 5)) * d.K + d.k0 + kc * 8) = o; }
    __syncthreads();
}
__device__ __forceinline__ void conv_layer(const Args& a, int l, LAS unsigned char* lds, unsigned* ctr) {
    int tid_o = threadIdx.x; asm volatile("" : "+v"(tid_o)); const int tid = tid_o;
    LAS unsigned* T = (LAS unsigned*)lds; volatile LAS unsigned* slot = (volatile LAS unsigned*)(lds + 131072 + 128);
    int stat = (int)blockIdx.x - (int)gridDim.x;
    unsigned pend = 0u;
#define CONV_ISSUE() do { if (ctr && tid == 0) pend = __hip_atomic_fetch_add(ctr, 1u, __ATOMIC_RELAXED, __HIP_MEMORY_SCOPE_AGENT); } while (0)
#define CONV_NEXT(r) do { if (ctr) { sl ^= 1; if (tid == 0) slot[sl] = pend; __syncthreads(); r = (int)slot[sl]; } else { stat += (int)gridDim.x; r = stat; } } while (0)
    int sl = 0;
    __syncthreads();
    f32x4 vA[4][2], vB[4][2], vC[4][2]; float gA[4][2], gB[4][2], gC[4][2]; ConvDesc d0, d1, d2; int r0, r1, r2;
    CONV_ISSUE(); CONV_NEXT(r0); CONV_ISSUE(); if (r0 < I_LAYER) { d0 = conv_decode(a, l, r0); conv_load(d0, tid, vA, gA); }
    CONV_NEXT(r1); CONV_ISSUE(); if (r1 < I_LAYER) { d1 = conv_decode(a, l, r1); conv_load(d1, tid, vB, gB); }
    for (;;) {
        if (r0 >= I_LAYER) break;
        CONV_NEXT(r2); CONV_ISSUE(); if (r2 < I_LAYER) { d2 = conv_decode(a, l, r2); conv_load(d2, tid, vC, gC); }
        conv_store(d0, tid, vA, gA, T);
        if (r1 >= I_LAYER) break;
        CONV_NEXT(r0); CONV_ISSUE(); if (r0 < I_LAYER) { d0 = conv_decode(a, l, r0); conv_load(d0, tid, vA, gA); }
        conv_store(d1, tid, vB, gB, T);
        if (r2 >= I_LAYER) break;
        CONV_NEXT(r1); CONV_ISSUE(); if (r1 < I_LAYER) { d1 = conv_decode(a, l, r1); conv_load(d1, tid, vB, gB); }
        conv_store(d2, tid, vC, gC, T);
    }
#undef CONV_NEXT
#undef CONV_ISSUE
}
__device__ __forceinline__ void p0_prologue(const Args& a, LAS unsigned char* lds) {
    int tid_o = threadIdx.x; asm volatile("" : "+v"(tid_o)); const int tid = tid_o, lane = tid & 63, wave = tid >> 6, G = gridDim.x;
    const int gw = blockIdx.x * NWAVES + wave, NGW = G * NWAVES;
    conv_layer(a, 0, lds, nullptr);
    float* ct = (float*)(a.ws + WS_COS); float* st = (float*)(a.ws + WS_SIN);
    for (int i = blockIdx.x * NTHR + tid; i < MT * 32; i += G * NTHR) { const int row = i >> 5, j = i & 31;
        const float inv = (float)exp(-((double)(2 * j) / 64.0) * 9.210340371976184);
        const float ang = (float)a.pos[row] * inv;
        double rev = (double)ang * 0.15915494309189535; rev -= rint(rev); const float rf = (float)rev;
        ct[i] = __builtin_amdgcn_cosf(rf); st[i] = __builtin_amdgcn_sinf(rf); }
    bf16* xb = (bf16*)(a.ws + WS_XB); float* rstd = (float*)(a.ws + WS_RSTD);
    for (int row = gw; row < MT; row += NGW) { const f32x4* xr = (const f32x4*)(a.x + (size_t)row * DM); u32x2* ob = (u32x2*)(xb + (size_t)row * DM); float ss = 0.f;
#pragma unroll
        for (int j = 0; j < 8; ++j) { const f32x4 v = xr[j * 64 + lane]; ss += (v[0] * v[0] + v[1] * v[1]) + (v[2] * v[2] + v[3] * v[3]); u32x2 o; o.x = pk2(v[0], v[1]); o.y = pk2(v[2], v[3]); ob[j * 64 + lane] = o; }
        ss = wave_sum(ss);
        if (lane == 0) rstd[row] = 1.f / sqrtf(ss * (1.f / DM) + EPS); }
}
__device__ __forceinline__ void rowpass(const float* xin, float* xout, const bf16* mb, const float* ps, const float* gain, bf16* xb, float* rstd) {
    int tid_o = threadIdx.x; asm volatile("" : "+v"(tid_o)); const int tid = tid_o, lane = tid & 63, wave = tid >> 6; const int gw = blockIdx.x * NWAVES + wave, NGW = gridDim.x * NWAVES;
    for (int row = gw; row < MT; row += NGW) { const f32x4* xr = (const f32x4*)(xin + (size_t)row * DM); f32x4* xo = (f32x4*)(xout + (size_t)row * DM);
        const u32x2* mr = (const u32x2*)(mb + (size_t)row * DM); u32x2* ob = (u32x2*)(xb + (size_t)row * DM); const f32x4* gr = (const f32x4*)gain;
        f32x4 xv[8]; u32x2 mv[8];
#pragma unroll
        for (int j = 0; j < 8; ++j) { xv[j] = xr[j * 64 + lane]; mv[j] = mr[j * 64 + lane]; }
        const float r = 1.f / sqrtf(wave_sum(lane < 32 ? ps[(size_t)row * 32 + lane] : 0.f) * (1.f / DM) + EPS); float ss = 0.f;
#pragma unroll
        for (int j = 0; j < 8; ++j) { const int i = j * 64 + lane; f32x4 v = xv[j]; const u32x2 mm = mv[j]; const f32x4 g = gr[i];
            v[0] += __builtin_bit_cast(float, mm.x << 16) * r * g[0]; v[1] += __builtin_bit_cast(float, mm.x & 0xffff0000u) * r * g[1];
            v[2] += __builtin_bit_cast(float, mm.y << 16) * r * g[2]; v[3] += __builtin_bit_cast(float, mm.y & 0xffff0000u) * r * g[3];
            xv[j] = v; ss += (v[0] * v[0] + v[1] * v[1]) + (v[2] * v[2] + v[3] * v[3]); }
#pragma unroll
        for (int j = 0; j < 8; ++j) { const int i = j * 64 + lane; xo[i] = xv[j]; u32x2 o; o.x = pk2(xv[j][0], xv[j][1]); o.y = pk2(xv[j][2], xv[j][3]); ob[i] = o; }
        ss = wave_sum(ss);
        if (lane == 0) rstd[row] = 1.f / sqrtf(ss * (1.f / DM) + EPS); }
}
__device__ __forceinline__ f32x16 mfma32(bf16x8 a, bf16x8 b, f32x16 c) { return __builtin_amdgcn_mfma_f32_32x32x16_bf16(a, b, c, 0, 0, 0); }
template <int KD> __device__ __forceinline__ f32x16 mm32(const LAS bf16* A, int lda, const LAS bf16* B, int ldb, int ql, int g, f32x16 acc) {
#pragma unroll
    for (int s = 0; s < KD / 16; ++s) { const bf16x8 a = *(const LAS bf16x8*)(A + ql * lda + 16 * s + 8 * g), b = *(const LAS bf16x8*)(B + ql * ldb + 16 * s + 8 * g); acc = mfma32(a, b, acc); }
    return acc;
}
constexpr f32x16 Z16 = {0.f, 0.f, 0.f, 0.f, 0.f, 0.f, 0.f, 0.f, 0.f, 0.f, 0.f, 0.f, 0.f, 0.f, 0.f, 0.f};
template <int TYPE> __device__ __forceinline__ void gla_local_item(const Args& a, LAS unsigned char* lds, int layer, int bh, int c) {
    constexpr int DK = TYPE ? 128 : 64, QS = DK + 8, TS = 72, NTG = NTHR / DK, RPT = 64 / NTG;
    LAS bf16* qh = (LAS bf16*)lds; LAS bf16* kh = qh + 64 * QS; LAS bf16* ktT = kh + 64 * QS; LAS bf16* vT = ktT + DK * TS; LAS bf16* Ab = vT + 128 * TS; LAS float* bc = (LAS float*)(Ab + 64 * TS);
    int tid_o = threadIdx.x; asm volatile("" : "+v"(tid_o)); const int tid = tid_o, lane = tid & 63, wave = tid >> 6, ql = lane & 31, g = lane >> 5;
    const int b = bh >> 2, h = bh & 3, t0 = b * SEQ + c * 64;
    const bf16* prow = (const bf16*)(a.ws + WS_PROJ) + (size_t)t0 * NIN;
    const int d = tid % DK, tg = tid / DK;
    float lbv = 0.f;
    bf16 rq[RPT], rk[RPT], rv[16];
#pragma unroll
    for (int tt = 0; tt < RPT; ++tt) { const int t = tg * RPT + tt; rq[tt] = prow[(size_t)t * NIN + (TYPE ? C_HQ : C_GQ) + h * DK + d]; rk[tt] = prow[(size_t)t * NIN + (TYPE ? C_HF : C_GK) + h * DK + d]; }
    { const int e = tid & 127, tq = tid >> 7; const int vcol = (TYPE ? C_HI : C_GV) + h * 128 + e;
#pragma unroll
      for (int i = 0; i < 16; ++i) rv[i] = prow[(size_t)(tq * 16 + i) * NIN + vcol]; }
    {
        float run = 0.f;
        if (TYPE == 0) {
            float w2c[16]; const float* w2 = a.gate_w2 + (size_t)layer * 16 * 256 + h * 64 + d;
#pragma unroll
            for (int r = 0; r < 16; ++r) w2c[r] = w2[r * 256];
            const float bias = a.gate_b[layer * 256 + h * 64 + d];
            bf16x8 rg0[RPT], rg1[RPT];
#pragma unroll
            for (int tt = 0; tt < RPT; ++tt) { const bf16x8* gl = (const bf16x8*)(prow + (size_t)(tg * RPT + tt) * NIN + C_GLOW); rg0[tt] = gl[0]; rg1[tt] = gl[1]; }
#pragma unroll
            for (int tt = 0; tt < RPT; ++tt) { const int t = tg * RPT + tt; const bf16x8 g0 = rg0[tt], g1 = rg1[tt]; float z = bias;
#pragma unroll
                for (int r = 0; r < 8; ++r) { z += bf2f((bf16)g0[r]) * w2c[r]; z += bf2f((bf16)g1[r]) * w2c[8 + r]; }
                const float lg = (fminf(z, 0.f) - __logf(1.f + __expf(-fabsf(z)))) * (1.f / 16.f);
                run += lg; bc[t * DK + d] = run; }
        } else {
            const float* lg4 = a.lb_logits + h * 128 + d; const float l0 = lg4[0], l1 = lg4[512], l2 = lg4[1024], l3 = lg4[1536];
            const float mx = fmaxf(fmaxf(l0, l1), fmaxf(l2, l3)); const float e0 = __expf(l0 - mx), e1 = __expf(l1 - mx), e2 = __expf(l2 - mx), e3 = __expf(l3 - mx); const float inv = 1.f / (e0 + e1 + e2 + e3);
            lbv = (layer >= 1 ? e1 : 0.f) + (layer >= 2 ? e2 : 0.f) + (layer >= 3 ? e3 : 0.f); lbv *= inv;
#pragma unroll
            for (int tt = 0; tt < RPT; ++tt) { const int t = tg * RPT + tt; const float hf = bf2f(rk[tt]);
                const float sg = 1.f / (1.f + __expf(-hf)); const float f = lbv + (1.f - lbv) * sg;
                run += __logf(f); bc[t * DK + d] = run; }
        }
    }
    __syncthreads();
    { float off = 0.f; for (int s = 0; s < tg; ++s) off += bc[(s * RPT + RPT - 1) * DK + d];
      __syncthreads();
      if (tg > 0) for (int tt = 0; tt < RPT; ++tt) bc[(tg * RPT + tt) * DK + d] += off; }
    __syncthreads();
    {
        const float bmid = bc[32 * DK + d], blast = bc[63 * DK + d]; const float scale = TYPE ? 1.f : 0.125f;
        bf16* qe = (bf16*)(a.ws + (TYPE ? WS_QE_H : WS_QE_G));
#pragma unroll
        for (int tt = 0; tt < RPT; ++tt) { const int t = tg * RPT + tt; const float bb = bc[t * DK + d]; float q = bf2f(rq[tt]), k = bf2f(rk[tt]);
            if (TYPE == 1) { const float hq = q, hf = k; q = hq / (1.f + __expf(-hq)); k = (1.f - lbv) / (1.f + __expf(hf)); }
            q *= scale;
            qh[t * QS + d] = (bf16)f2bf(q * __expf(bb - bmid)); kh[t * QS + d] = (bf16)f2bf(k * __expf(bmid - bb));
            ktT[d * TS + t] = (bf16)f2bf(k * __expf(blast - bb));
            qe[(size_t)(t0 + t) * (4 * DK) + h * DK + d] = (bf16)f2bf(q * __expf(bb)); }
        if (tg == 0) ((float*)(a.ws + (TYPE ? WS_DL_H : WS_DL_G)))[(bh * 64 + c) * DK + d] = __expf(blast);
        const int e = tid & 127, tq = tid >> 7;
#pragma unroll
        for (int i = 0; i < 16; ++i) vT[e * TS + tq * 16 + i] = rv[i];
    }
    __syncthreads();
    if (wave < 4) {
        const int jb = wave & 1, ib = wave >> 1; f32x16 acc = Z16;
        if (!(jb == 1 && ib == 0)) acc = mm32<DK>(kh + 32 * jb * QS, QS, qh + 32 * ib * QS, QS, ql, g, acc);
        const int i = 32 * ib + ql;
#pragma unroll
        for (int rg = 0; rg < 4; ++rg) { const int j0 = 32 * jb + 8 * rg + 4 * g; float v[4];
#pragma unroll
            for (int e = 0; e < 4; ++e) v[e] = (j0 + e <= i) ? acc[4 * rg + e] : 0.f;
            u32x2 o; o.x = pk2(v[0], v[1]); o.y = pk2(v[2], v[3]); *(LAS u32x2*)(Ab + i * TS + j0) = o; }
    }
    __syncthreads();
    {
        const int eb = wave & 3, ib = wave >> 2; f32x16 acc = mm32<64>(vT + 32 * eb * TS, TS, Ab + 32 * ib * TS, TS, ql, g, Z16);
        float* oi = (float*)(a.ws + WS_OI) + (size_t)TYPE * MT * 512 + (size_t)(t0 + 32 * ib + ql) * 512 + h * 128 + 32 * eb + 4 * g;
#pragma unroll
        for (int rg = 0; rg < 4; ++rg) { f32x4 o = {acc[4 * rg], acc[4 * rg + 1], acc[4 * rg + 2], acc[4 * rg + 3]}; *(f32x4*)(oi + 8 * rg) = o; }
    }
    {
        float* ut = (float*)(a.ws + (TYPE ? WS_UT_H : WS_UT_G)) + (size_t)(bh * 64 + c) * 128 * DK;
#pragma unroll
        for (int bi = 0; bi < DK / 64; ++bi) { const int blk = wave + 8 * bi, eb = blk & 3, db = blk >> 2;
            f32x16 acc = mm32<64>(ktT + 32 * db * TS, TS, vT + 32 * eb * TS, TS, ql, g, Z16);
            float* up = ut + (size_t)(32 * eb + ql) * DK + 32 * db + 4 * g;
#pragma unroll
            for (int rg = 0; rg < 4; ++rg) { f32x4 o = {acc[4 * rg], acc[4 * rg + 1], acc[4 * rg + 2], acc[4 * rg + 3]}; *(f32x4*)(up + 8 * rg) = o; } }
    }
    __syncthreads();
}
__device__ __forceinline__ void scan_item(const Args& a, int si) {
    int tid_o = threadIdx.x; asm volatile("" : "+v"(tid_o)); const int tid = tid_o; const bool hg = si >= 32; const int DK = hg ? 128 : 64; const int idx = (hg ? si - 32 : si) * NTHR + tid;
    const int per_bh = 128 * DK / 4; const int bh = idx / per_bh, rem = idx % per_bh, e = rem / (DK / 4), d = 4 * (rem % (DK / 4));
    const float* ut = (const float*)(a.ws + (hg ? WS_UT_H : WS_UT_G)) + (size_t)bh * 64 * 128 * DK + (size_t)e * DK + d;
    bf16* sp = (bf16*)(a.ws + (hg ? WS_SP_H : WS_SP_G)) + (size_t)bh * 64 * 128 * DK + (size_t)e * DK + d;
    const float* dl = (const float*)(a.ws + (hg ? WS_DL_H : WS_DL_G)) + (size_t)bh * 64 * DK + d;
    f32x4 S = {0.f, 0.f, 0.f, 0.f}; const size_t cs = (size_t)128 * DK;
    for (int cb = 0; cb < 64; cb += 16) {
        f32x4 u[16], dd[16];
#pragma unroll
        for (int i = 0; i < 16; ++i) { u[i] = __builtin_nontemporal_load((const f32x4*)(ut + (size_t)(cb + i) * cs)); dd[i] = *(const f32x4*)(dl + (cb + i) * DK); }
#pragma unroll
        for (int i = 0; i < 16; ++i) { u32x2 o; o.x = pk2(S[0], S[1]); o.y = pk2(S[2], S[3]); *(u32x2*)(sp + (size_t)(cb + i) * cs) = o; S = dd[i] * S + u[i]; }
    }
}
__device__ __forceinline__ void gla_final_item(const Args& a, int layer, int item) {
    const int type = item >> 7, bh = (item >> 4) & 7, cg4 = item & 15; const int DK = type ? 128 : 64;
    int tid_o = threadIdx.x; asm volatile("" : "+v"(tid_o)); const int tid = tid_o, lane = tid & 63, wave = tid >> 6, ql = lane & 31, g = lane >> 5;
    const int b = bh >> 2, h = bh & 3, c = cg4 * 4 + (wave >> 1), t = b * SEQ + c * 64 + (wave & 1) * 32 + ql;
    const float* oi = (const float*)(a.ws + WS_OI) + (size_t)type * MT * 512 + (size_t)t * 512 + h * 128 + 4 * g;
    f32x16 acc[4];
#pragma unroll
    for (int eb = 0; eb < 4; ++eb)
#pragma unroll
        for (int rg = 0; rg < 4; ++rg) { const f32x4 v = *(const f32x4*)(oi + 32 * eb + 8 * rg); acc[eb][4 * rg] = v[0]; acc[eb][4 * rg + 1] = v[1]; acc[eb][4 * rg + 2] = v[2]; acc[eb][4 * rg + 3] = v[3]; }
    const bf16* qe = (const bf16*)(a.ws + (type ? WS_QE_H : WS_QE_G)) + (size_t)t * (4 * DK) + h * DK + 8 * g;
    const bf16* sp = (const bf16*)(a.ws + (type ? WS_SP_H : WS_SP_G)) + ((size_t)(bh * 64 + c) * 128 + ql) * DK + 8 * g;
    for (int s = 0; s < DK / 16; ++s) { const bf16x8 bq = *(const bf16x8*)(qe + 16 * s);
#pragma unroll
        for (int eb = 0; eb < 4; ++eb) { const bf16x8 as = *(const bf16x8*)(sp + (size_t)32 * eb * DK + 16 * s); acc[eb] = mfma32(as, bq, acc[eb]); } }
    float ss = 0.f;
#pragma unroll
    for (int eb = 0; eb < 4; ++eb)
#pragma unroll
        for (int r = 0; r < 16; ++r) ss += acc[eb][r] * acc[eb][r];
    ss += __shfl_xor(ss, 32);
    const float rstd = 1.f / sqrtf(ss * (1.f / 128.f) + EPS);
    const float* gn = (type ? a.hgrn_norm : a.gla_norm) + layer * 128 + 4 * g;
    const bf16* gt = (const bf16*)(a.ws + WS_PROJ) + (size_t)t * NIN + (type ? C_HO : C_GO) + h * 128 + 4 * g;
    bf16* y = (bf16*)(a.ws + WS_Y) + (size_t)t * DM + type * 512 + h * 128 + 4 * g;
    u32x2 gbv[16]; f32x4 gvv[16];
#pragma unroll
    for (int i = 0; i < 16; ++i) { const int eo = 32 * (i >> 2) + 8 * (i & 3); gbv[i] = *(const u32x2*)(gt + eo); gvv[i] = *(const f32x4*)(gn + eo); }
#pragma unroll
    for (int eb = 0; eb < 4; ++eb)
#pragma unroll
        for (int rg = 0; rg < 4; ++rg) { const int eo = 32 * eb + 8 * rg; const f32x4 gv = gvv[4 * eb + rg]; const u32x2 gb = gbv[4 * eb + rg];
            const float g0 = __builtin_bit_cast(float, gb.x << 16), g1 = __builtin_bit_cast(float, gb.x & 0xffff0000u), g2 = __builtin_bit_cast(float, gb.y << 16), g3 = __builtin_bit_cast(float, gb.y & 0xffff0000u);
            const float o0 = acc[eb][4 * rg] * rstd * gv[0] * g0 / (1.f + __expf(-g0)), o1 = acc[eb][4 * rg + 1] * rstd * gv[1] * g1 / (1.f + __expf(-g1));
            const float o2 = acc[eb][4 * rg + 2] * rstd * gv[2] * g2 / (1.f + __expf(-g2)), o3 = acc[eb][4 * rg + 3] * rstd * gv[3] * g3 / (1.f + __expf(-g3));
            u32x2 o; o.x = pk2(o0, o1); o.y = pk2(o2, o3); *(u32x2*)(y + eo) = o; }
}
__device__ __forceinline__ void kpe_rope(const Args& a) {
    const bf16* proj = (const bf16*)(a.ws + WS_PROJ); bf16* kpe = (bf16*)(a.ws + WS_KPE); const float* ct = (const float*)(a.ws + WS_COS); const float* st = (const float*)(a.ws + WS_SIN);
    int tid_o = threadIdx.x; asm volatile("" : "+v"(tid_o));
    for (int i = blockIdx.x * NTHR + tid_o; i < MT * 32; i += gridDim.x * NTHR) { const int row = i >> 5, j = i & 31;
        const float x1 = bf2f(proj[(size_t)row * NIN + C_KPE + j]), x2 = bf2f(proj[(size_t)row * NIN + C_KPE + 32 + j]); const float c = ct[i], s = st[i];
        *(unsigned*)(kpe + (size_t)row * 64 + 2 * j) = pk2(x1 * c - x2 * s, x2 * c + x1 * s); }
}
__device__ __forceinline__ void mla_out_norm(const Args& a) {
    bf16* y = (bf16*)(a.ws + WS_Y); const float* ssq = (const float*)(a.ws + WS_PS_O);
    int tid_o = threadIdx.x; asm volatile("" : "+v"(tid_o));
    const int i0 = blockIdx.x * NTHR + tid_o, stride = gridDim.x * NTHR;
    for (int ib = i0; ib < MT * 128; ib += 8 * stride) {
        u32x4 v[8]; f32x4 s0[8], s1[8];
#pragma unroll
        for (int k = 0; k < 8; ++k) { const int i = ib + k * stride; if (i < MT * 128) { const int row = i >> 7, cc = i & 127; v[k] = *(const u32x4*)(y + (size_t)row * DM + 1024 + cc * 8); s0[k] = *(const f32x4*)(ssq + (size_t)row * 8); s1[k] = *(const f32x4*)(ssq + (size_t)row * 8 + 4); } }
#pragma unroll
        for (int k = 0; k < 8; ++k) { const int i = ib + k * stride; if (i < MT * 128) { const int row = i >> 7, cc = i & 127;
            const float r = 1.f / sqrtf((((s0[k][0] + s0[k][1]) + (s0[k][2] + s0[k][3])) + ((s1[k][0] + s1[k][1]) + (s1[k][2] + s1[k][3]))) * (1.f / 1024.f) + EPS); u32x4 w = v[k];
#pragma unroll
            for (int e = 0; e < 4; ++e) { const float lo = __builtin_bit_cast(float, w[e] << 16) * r, hi = __builtin_bit_cast(float, w[e] & 0xffff0000u) * r; w[e] = pk2(lo, hi); }
            *(u32x4*)(y + (size_t)row * DM + 1024 + cc * 8) = w; } }
    }
}
constexpr int KSTR = 400, VSTR = 136, KBYTES = 64 * KSTR, VBYTES = 128 * VSTR, OSTR = 272;
__device__ __forceinline__ void attn_item(const Args& a, LAS unsigned char* lds, int b, int h, int qb, int t0, int t1, int part) {
    int tid_o = threadIdx.x; asm volatile("" : "+v"(tid_o)); const int tid = tid_o, lane = tid & 63, wave = tid >> 6, ql = lane & 31, g = lane >> 5;
    const bf16* Q = (const bf16*)(a.ws + WS_Q); const bf16* KN = (const bf16*)(a.ws + WS_KN); const bf16* KP = (const bf16*)(a.ws + WS_KPE); const bf16* VT = (const bf16*)(a.ws + WS_VT);
    const int tq0 = b * SEQ + qb * 256 + wave * 32, qpos = qb * 256 + wave * 32 + ql;
    bf16x8 qf[12];
    { const bf16* qp = Q + (size_t)(tq0 + ql) * 1536 + h * 192 + 8 * g;
#pragma unroll
      for (int s = 0; s < 12; ++s) qf[s] = *(const bf16x8*)(qp + 16 * s); }
    f32x16 oacc[4] = {Z16, Z16, Z16, Z16}; float mrun = -1e30f, lrun = 0.f;
    const int nt = 4 * (qb + 1);
    int ksrc_off[3]; int kdst[3]; bool kpe_sel[3]; int vsrc_off[2]; int vdst[2];
#pragma unroll
    for (int i = 0; i < 3; ++i) { const int cid = tid + NTHR * i, key = cid / 24, cc = cid % 24; kpe_sel[i] = cc >= 16; kdst[i] = key * KSTR + cc * 16;
        ksrc_off[i] = kpe_sel[i] ? key * 64 + (cc - 16) * 8 : key * 1024 + h * 128 + cc * 8; }
#pragma unroll
    for (int i = 0; i < 2; ++i) { const int cid = tid + NTHR * i, row = cid >> 3, cc = cid & 7; vdst[i] = row * VSTR + cc * 16; vsrc_off[i] = (h * 128 + row) * MT + cc * 8; }
    u32x4 sk[3], sv[2];
#define ATT_GLOAD(t) do { const size_t tk = (size_t)(b * SEQ + (t) * 64); _Pragma("unroll") for (int i = 0; i < 3; ++i) sk[i] = kpe_sel[i] ? *(const u32x4*)(KP + tk * 64 + ksrc_off[i]) : *(const u32x4*)(KN + tk * 1024 + ksrc_off[i]); \
        _Pragma("unroll") for (int i = 0; i < 2; ++i) sv[i] = *(const u32x4*)(VT + (size_t)vsrc_off[i] + tk); } while (0)
#define ATT_LSTORE(kbuf, vbuf) do { LAS unsigned char* kb_ = lds + (kbuf) * KBYTES; LAS unsigned char* vb_ = lds + 2 * KBYTES + (vbuf) * VBYTES; \
        _Pragma("unroll") for (int i = 0; i < 3; ++i) *(LAS u32x4*)(kb_ + kdst[i]) = sk[i]; _Pragma("unroll") for (int i = 0; i < 2; ++i) { *(LAS u32x2*)(vb_ + vdst[i]) = (u32x2){sv[i].x, sv[i].y}; *(LAS u32x2*)(vb_ + vdst[i] + 8) = (u32x2){sv[i].z, sv[i].w}; } } while (0)
#define ATT_QK(kb_) do { const LAS unsigned char* kp = (kb_) + ql * KSTR + 16 * g; p0 = Z16; p1 = Z16; \
        _Pragma("unroll") for (int s = 0; s < 12; ++s) { const bf16x8 k0 = *(const LAS bf16x8*)(kp + 32 * s), k1 = *(const LAS bf16x8*)(kp + 32 * KSTR + 32 * s); p0 = mfma32(k0, qf[s], p0); p1 = mfma32(k1, qf[s], p1); } } while (0)
#define ATT_SM() do { \
        if (t >= nt - 4) { const int kb0 = t * 64 + 4 * g; const float NEG = -__builtin_inff(); \
            _Pragma("unroll") for (int r = 0; r < 16; ++r) { const int kk = kb0 + (r & 3) + 8 * (r >> 2); if (kk > qpos) p0[r] = NEG; if (kk + 32 > qpos) p1[r] = NEG; } } \
        float mx = p0[0]; \
        _Pragma("unroll") for (int r = 1; r < 16; ++r) mx = fmaxf(mx, p0[r]); \
        _Pragma("unroll") for (int r = 0; r < 16; ++r) mx = fmaxf(mx, p1[r]); \
        mx = fmaxf(mx, __shfl_xor(mx, 32)); \
        float mn = mrun; \
        if (__builtin_amdgcn_ballot_w64(mx > mrun + 8.f) != 0ull) { \
            mn = fmaxf(mrun, mx); const float alpha = __builtin_amdgcn_exp2f(mrun - mn); mrun = mn; lrun *= alpha; \
            _Pragma("unroll") for (int db = 0; db < 4; ++db) oacc[db] = oacc[db] * alpha; } \
        float rs = 0.f; \
        _Pragma("unroll") for (int r = 0; r < 16; ++r) { p0[r] = __builtin_amdgcn_exp2f(p0[r] - mn); p1[r] = __builtin_amdgcn_exp2f(p1[r] - mn); rs += p0[r] + p1[r]; } \
        lrun += rs; \
        { u32x4 w; \
          w.x = pk2(p0[0], p0[1]); w.y = pk2(p0[2], p0[3]); w.z = pk2(p0[4], p0[5]); w.w = pk2(p0[6], p0[7]); pf[0] = __builtin_bit_cast(bf16x8, w); \
          w.x = pk2(p0[8], p0[9]); w.y = pk2(p0[10], p0[11]); w.z = pk2(p0[12], p0[13]); w.w = pk2(p0[14], p0[15]); pf[1] = __builtin_bit_cast(bf16x8, w); \
          w.x = pk2(p1[0], p1[1]); w.y = pk2(p1[2], p1[3]); w.z = pk2(p1[4], p1[5]); w.w = pk2(p1[6], p1[7]); pf[2] = __builtin_bit_cast(bf16x8, w); \
          w.x = pk2(p1[8], p1[9]); w.y = pk2(p1[10], p1[11]); w.z = pk2(p1[12], p1[13]); w.w = pk2(p1[14], p1[15]); pf[3] = __builtin_bit_cast(bf16x8, w); } } while (0)
#define ATT_PV(vb_) do { _Pragma("unroll") for (int db = 0; db < 4; ++db) { const LAS unsigned char* vp = (vb_) + (32 * db + ql) * VSTR + 8 * g; \
        _Pragma("unroll") for (int sl = 0; sl < 4; ++sl) { const u32x2 lo = *(const LAS u32x2*)(vp + 32 * sl), hi = *(const LAS u32x2*)(vp + 32 * sl + 16); const u32x4 w = {lo.x, lo.y, hi.x, hi.y}; \
            oacc[db] = mfma32(__builtin_bit_cast(bf16x8, w), pf[sl], oacc[db]); } } } while (0)
    const int wv = __builtin_amdgcn_readfirstlane(tid >> 6);
    f32x16 p0, p1; bf16x8 pf[4];
    __syncthreads();
    ATT_GLOAD(t0); ATT_LSTORE(0, 0);
    __syncthreads();
    const LAS unsigned char* vring = lds + 2 * KBYTES;
    if (wv < 4) {
        int vs = 0;
        for (int t = t0; t < t1; ++t) {
            if (t + 1 < t1) ATT_GLOAD(t + 1);
            const int bsel = (t - t0) & 1; const int vnext = vs == 2 ? 0 : vs + 1;
            ATT_QK(lds + bsel * KBYTES); ATT_SM(); ATT_PV(vring + vs * VBYTES);
            if (t + 1 < t1) ATT_LSTORE(bsel ^ 1, vnext);
            vs = vnext;
            __syncthreads();
        }
    } else {
        int vs = 0;
        for (int t = t0; t < t1; ++t) {
            const int bsel = (t - t0) & 1; const int vprev = vs == 0 ? 2 : vs - 1, vnext = vs == 2 ? 0 : vs + 1;
            if (t > t0) ATT_PV(vring + vprev * VBYTES);
            if (t + 1 < t1) ATT_GLOAD(t + 1);
            ATT_QK(lds + bsel * KBYTES); ATT_SM();
            if (t + 1 < t1) ATT_LSTORE(bsel ^ 1, vnext);
            vs = vnext;
            __syncthreads();
        }
        { const int vlast = vs == 0 ? 2 : vs - 1; ATT_PV(vring + vlast * VBYTES); }
    }
    __syncthreads();
#undef ATT_QK
#undef ATT_SM
#undef ATT_PV
#undef ATT_GLOAD
#undef ATT_LSTORE
    const float lt = lrun + __shfl_xor(lrun, 32), inv = 1.f / lt;
    LAS unsigned char* ob = lds + wave * (32 * OSTR);
#pragma unroll
    for (int db = 0; db < 4; ++db)
#pragma unroll
        for (int rg = 0; rg < 4; ++rg) { const float o0 = oacc[db][4 * rg] * inv, o1 = oacc[db][4 * rg + 1] * inv, o2 = oacc[db][4 * rg + 2] * inv, o3 = oacc[db][4 * rg + 3] * inv;
            u32x2 o; o.x = pk2(o0, o1); o.y = pk2(o2, o3); *(LAS u32x2*)(ob + ql * OSTR + (32 * db + 8 * rg + 4 * g) * 2) = o; }
    LDS_WAIT(); asm volatile("" ::: "memory");
    bf16* dst; int pitch;
    if (part < 0) { dst = (bf16*)(a.ws + WS_Y) + (size_t)tq0 * DM + 1024 + h * 128; pitch = DM; }
    else { const size_t rec = ((size_t)((part * 16 + b * 8 + h) * 8 + (qb - 8)) * 256 + wave * 32); dst = (bf16*)(a.ws + WS_MB) + rec * 128; pitch = 128;
        if (g == 0) { float* ml = (float*)(a.ws + WS_ML) + (rec + ql) * 2; ml[0] = mrun; ml[1] = lt; } }
#pragma unroll
    for (int i = 0; i < 8; ++i) { const int cid = lane + 64 * i, row = cid >> 4, cc = cid & 15; const u32x4 v = *(const LAS u32x4*)(ob + row * OSTR + cc * 16);
        *(u32x4*)(dst + (size_t)row * pitch + cc * 8) = v; }
}
__device__ __forceinline__ void attn_queue(const Args& a, LAS unsigned char* lds, unsigned* ctr) {
    int tid_o = threadIdx.x; asm volatile("" : "+v"(tid_o)); const int tid = tid_o; const int grp = (int)((unsigned)__builtin_amdgcn_s_getreg((3 << 11) | 20) & 7u);
    volatile LAS unsigned* slot = (volatile LAS unsigned*)(lds + 131072 + 160);
    for (;;) {
        if (tid == 0) *slot = __hip_atomic_fetch_add(ctr + grp, 1u, __ATOMIC_RELAXED, __HIP_MEMORY_SCOPE_AGENT);
        __syncthreads();
        const int idx = (int)*slot;
        if (idx >= 48) break;
        const int bh = 2 * grp + (idx >= 24 ? 1 : 0), k = idx >= 24 ? idx - 24 : idx; int qb, part;
        if (k < 20) { const int j = k / 5, r = k % 5; if (r == 0) { qb = 7 - j; part = -1; } else if (r < 3) { qb = 15 - 2 * j; part = r - 1; } else { qb = 14 - 2 * j; part = r - 3; } }
        else { qb = 23 - k; part = -1; }
        const int nt = 4 * (qb + 1);
        attn_item(a, lds, bh >> 3, bh & 7, qb, part == 1 ? nt / 2 : 0, part == 0 ? nt / 2 : nt, part);
    }
}
__device__ __forceinline__ void mla_finish(const Args& a) {
    int tid_o = threadIdx.x; asm volatile("" : "+v"(tid_o)); const int tid = tid_o, lane = tid & 63, wave = tid >> 6; const int gw = blockIdx.x * NWAVES + wave, NGW = gridDim.x * NWAVES;
    bf16* y = (bf16*)(a.ws + WS_Y); const bf16* po = (const bf16*)(a.ws + WS_MB); const float* ml = (const float*)(a.ws + WS_ML);
    for (int row = gw; row < MT; row += NGW) { const int b = row >> 12, pos = row & 4095, qb = pos >> 8, r = pos & 255; float o0[8], o1[8];
        if (qb < 8) {
#pragma unroll
            for (int h = 0; h < 8; ++h) { const unsigned u = *(const unsigned*)(y + (size_t)row * DM + 1024 + h * 128 + 2 * lane); o0[h] = __builtin_bit_cast(float, u << 16); o1[h] = __builtin_bit_cast(float, u & 0xffff0000u); }
        } else {
            unsigned ua[8], ub[8]; float ma[8], la[8], mb_[8], lb_[8];
#pragma unroll
            for (int h = 0; h < 8; ++h) { const size_t ra = (size_t)((0 * 16 + b * 8 + h) * 8 + (qb - 8)) * 256 + r, rb = (size_t)((1 * 16 + b * 8 + h) * 8 + (qb - 8)) * 256 + r;
                ua[h] = *(const unsigned*)(po + ra * 128 + 2 * lane); ub[h] = *(const unsigned*)(po + rb * 128 + 2 * lane);
                ma[h] = ml[ra * 2]; la[h] = ml[ra * 2 + 1]; mb_[h] = ml[rb * 2]; lb_[h] = ml[rb * 2 + 1]; }
#pragma unroll
            for (int h = 0; h < 8; ++h) { const float m = fmaxf(ma[h], mb_[h]); const float wa = la[h] * __builtin_amdgcn_exp2f(ma[h] - m), wb = lb_[h] * __builtin_amdgcn_exp2f(mb_[h] - m), iw = 1.f / (wa + wb);
                o0[h] = (wa * __builtin_bit_cast(float, ua[h] << 16) + wb * __builtin_bit_cast(float, ub[h] << 16)) * iw;
                o1[h] = (wa * __builtin_bit_cast(float, ua[h] & 0xffff0000u) + wb * __builtin_bit_cast(float, ub[h] & 0xffff0000u)) * iw; }
        }
        float ss = 0.f;
#pragma unroll
        for (int h = 0; h < 8; ++h) ss += o0[h] * o0[h] + o1[h] * o1[h];
        ss = wave_sum(ss); const float rs = 1.f / sqrtf(ss * (1.f / 1024.f) + EPS);
#pragma unroll
        for (int h = 0; h < 8; ++h) *(unsigned*)(y + (size_t)row * DM + 1024 + h * 128 + 2 * lane) = pk2(o0[h] * rs, o1[h] * rs);
    }
}
#define XB_TMO      128
#define XB_XCNT(j)  (256  + 64 * (j))
#define XB_XSUB(j)  (1280 + 64 * (j))
#define XB_XGEN(j)  (2304 + 64 * (j))
#define XB_TOP      3328
#define XB_TOPGEN   3392
#define XCD_BAR_WORDS 3456
#define XB_SPIN_CAP (1u << 18)

__device__ __forceinline__ unsigned xb_ld(unsigned* p)              { return __hip_atomic_load(p, __ATOMIC_RELAXED, __HIP_MEMORY_SCOPE_AGENT); }
__device__ __forceinline__ unsigned xb_add(unsigned* p, unsigned v) { return __hip_atomic_fetch_add(p, v, __ATOMIC_RELAXED, __HIP_MEMORY_SCOPE_AGENT); }
__device__ __forceinline__ unsigned xb_xcc_id() { return (unsigned)__builtin_amdgcn_s_getreg((3 << 11) | 20) & 0xFu; }
#define XB_SPIN(cond, bar) do { unsigned _sp = 0; while (cond) { __builtin_amdgcn_s_sleep(1); \
    if ((++_sp & 255u) == 0u) { if (xb_ld(&(bar)[XB_TMO])) break; if (_sp > XB_SPIN_CAP) { atomicAdd(&(bar)[XB_TMO], 1u); break; } } } } while (0)

struct XcdBarrier {
    unsigned* bar; unsigned x;
    volatile LAS unsigned* st;
};

__device__ __forceinline__ XcdBarrier xcd_barrier_post(unsigned* bar, volatile LAS unsigned* st) {
    XcdBarrier b; b.bar = bar; b.x = xb_xcc_id(); b.st = st;
    if (threadIdx.x == 0) (void)xb_add(&bar[XB_XCNT(b.x)], 1u);
    return b;
}
__device__ __forceinline__ void xcd_barrier_complete(unsigned* bar, unsigned x, unsigned& nloc, unsigned& nx) {
    const unsigned G = gridDim.x * gridDim.y * gridDim.z;
    unsigned sum, cnt, mine, sp = 0u;
    for (;;) {
        sum = 0u; cnt = 0u; mine = 0u;
#pragma unroll
        for (unsigned j = 0; j < 16; ++j) { const unsigned c = xb_ld(&bar[XB_XCNT(j)]); sum += c; cnt += (c > 0u) ? 1u : 0u; mine = (j == x) ? c : mine; }
        if (sum == G) break;
        __builtin_amdgcn_s_sleep(1);
        if ((++sp & 255u) == 0u) { if (xb_ld(&bar[XB_TMO])) break; if (sp > XB_SPIN_CAP) { atomicAdd(&bar[XB_TMO], 1u); break; } }
    }
    nloc = mine > 0u ? mine : 1u; nx = cnt > 0u ? cnt : 1u;
}

__device__ __forceinline__ void xcd_barrier(const XcdBarrier& b) {
    asm volatile("s_waitcnt vmcnt(0)" ::: "memory");
    __syncthreads();
    if (threadIdx.x == 0) {
        unsigned* bar = b.bar;
        __builtin_amdgcn_s_waitcnt(0);
        unsigned nloc = b.st[0], nx = b.st[1];
        if (nloc == 0u) { xcd_barrier_complete(bar, b.x, nloc, nx); b.st[0] = nloc; b.st[1] = nx; }
        const unsigned old = xb_add(&bar[XB_XSUB(b.x)], 1u);
        const unsigned gen = old / nloc;
        if (old + 1u == (gen + 1u) * nloc) {
            __builtin_amdgcn_fence(__ATOMIC_RELEASE, "agent");
            asm volatile("s_waitcnt vmcnt(0)" ::: "memory");
            const unsigned og = xb_add(&bar[XB_TOP], 1u);
            const unsigned tg = og / nx;
            if (og + 1u == (tg + 1u) * nx) xb_add(&bar[XB_TOPGEN], 1u);
            else XB_SPIN(xb_ld(&bar[XB_TOPGEN]) == tg, bar);
            __builtin_amdgcn_fence(__ATOMIC_ACQUIRE, "agent");
            xb_add(&bar[XB_XGEN(b.x)], 1u);
            asm volatile("s_waitcnt vmcnt(0)" ::: "memory");
        } else {
            XB_SPIN(xb_ld(&bar[XB_XGEN(b.x)]) == gen, bar);
            __builtin_amdgcn_fence(__ATOMIC_ACQUIRE, "agent");
            asm volatile("s_waitcnt vmcnt(0)" ::: "memory");
        }
    }
    __syncthreads();
}


constexpr int N_PHASES = 1 + 9 * DEPTH;
#ifndef DBG_REP
#define DBG_REP 0
#endif
#define NREP(j) (1 + ((DBG_REP >> (j)) & 1))
#ifndef DBG_MASK
#define DBG_MASK 0x3ff
#endif
#define EN(j) ((DBG_MASK >> (j)) & 1)
__device__ __forceinline__ const Args* args_here() { const Args* p = (const Args*)__builtin_amdgcn_kernarg_segment_ptr(); asm volatile("" : "+s"(p)); return p; }
#define PH_ARGS Args a = a_in; { unsigned char* w_ = a.ws; asm volatile("" : "+s"(w_)); a.ws = w_; } unsigned char* const ws = a.ws; (void)ws
__global__ void __launch_bounds__(NTHR, 2) mega_fwd(Args a_in) {
    extern __shared__ __attribute__((aligned(16))) unsigned char lds_raw[];
    LAS unsigned char* lds = (LAS unsigned char*)lds_raw;
    cg::grid_group grid = cg::this_grid();
    volatile LAS unsigned* bst = (volatile LAS unsigned*)(lds + 131072 + 64);
    if (threadIdx.x < 2) bst[threadIdx.x] = 0u;
    __syncthreads();
    XcdBarrier bar = xcd_barrier_post((unsigned*)(a_in.ws + WS_BAR), bst);
    const int G = gridDim.x, bid = blockIdx.x;
    const int lo = a_in.ph_lo, hi = a_in.ph_hi;
#define IN(k) (lo <= (k) && (k) < hi)
#define SEAM(k) do { if (IN((k) + 1)) { if ((k) == 0) grid.sync(); else { XcdBarrier b2 = bar; asm volatile("" : "+s"(b2.bar)); xcd_barrier(b2); } } } while (0)
    if (IN(0) && EN(0)) for (int rep = 0; rep < NREP(0); ++rep) { PH_ARGS; p0_prologue(a, lds); SEAM(0); }
    for (int l = 0; l < DEPTH; ++l) {
        const int P = 1 + 9 * l;
        if (IN(P) && EN(1)) for (int rep = 0; rep < NREP(1); ++rep) {
            PH_ARGS; const bf16* wl = (const bf16*)(ws + WS_W) + (size_t)l * W_LAYER;
            pg8::Gemm gm{(const bf16*)(ws + WS_XB), wl + W_IN, MT, NIN, DM, DM, DM}; pg8::StaticOrder S; S.init(MT, NIN, G, bid);
            pg8::EpiRow E{(bf16*)(ws + WS_PROJ), NIN, (const float*)(ws + WS_RSTD), 0, 0, 0.f, EPS, (float*)(ws + WS_PS_QKV), 16, 14, 18};
            pg8::gemm_phase<pg8::EpiRow, pg8::StaticOrder, true, true>(lds, gm, S, E); SEAM(P); }
        if (IN(P + 1) && EN(2)) for (int rep = 0; rep < NREP(2); ++rep) {
#define P1_ARGS PH_ARGS; const bf16* wl = (const bf16*)(ws + WS_W) + (size_t)l * W_LAYER; const bf16* proj = (const bf16*)(ws + WS_PROJ); float* ps_qkv = (float*)(ws + WS_PS_QKV); (void)wl; (void)proj; (void)ps_qkv
            { P1_ARGS; pg8::Gemm gm{proj + C_QC, wl + W_Q, MT, 1536, 512, NIN, 512}; pg8::StaticOrder S; S.init(MT, 1536, G, bid);
              pg8::EpiQ E{(bf16*)(ws + WS_Q), ps_qkv, EPS, QSCALE, (const float*)(ws + WS_COS), (const float*)(ws + WS_SIN)};
              pg8::gemm_phase<pg8::EpiQ, pg8::StaticOrder, true, true>(lds, gm, S, E); }
            { P1_ARGS; pg8::Gemm gm{proj + C_KVC, wl + W_K, MT, 1024, 512, NIN, 512}; pg8::StaticOrder S; S.init(MT, 1024, G, (bid + 64) % G);
              pg8::EpiRow E{(bf16*)(ws + WS_KN), 1024, ps_qkv + 8, 16, 8, 1.f / 512.f, EPS, nullptr, 0, 0, 0};
              pg8::gemm_phase<pg8::EpiRow, pg8::StaticOrder, true, true>(lds, gm, S, E); }
            { P1_ARGS; pg8::Gemm gm{wl + W_V, proj + C_KVC, 1024, MT, 512, 512, NIN}; pg8::StaticOrder S; S.init(1024, MT, G, (bid + 192) % G);
              pg8::EpiVT E{(bf16*)(ws + WS_VT), MT, ps_qkv, EPS};
              pg8::gemm_phase<pg8::EpiVT, pg8::StaticOrder, true, true>(lds, gm, S, E); }
            { PH_ARGS; kpe_rope(a); }
            __syncthreads();
            PH_ARGS;
            for (int it = bid; it < 1024; it += G) { if (it < 512) gla_local_item<0>(a, lds, l, it >> 6, it & 63); else gla_local_item<1>(a, lds, l, (it - 512) >> 6, it & 63); }
            SEAM(P + 1); }
        if (IN(P + 2) && EN(3)) for (int rep = 0; rep < NREP(3); ++rep) {
            PH_ARGS;
            for (int it = bid; it < 96; it += G) scan_item(a, it);
            attn_queue(a, lds, (unsigned*)(ws + WS_BAR) + 8 + 8 * l);
            if (l + 1 < DEPTH && rep == 0) conv_layer(a, l + 1, lds, (unsigned*)(ws + WS_BAR) + l);
            SEAM(P + 2); }
        if (IN(P + 3) && EN(4)) for (int rep = 0; rep < NREP(4); ++rep) {
            PH_ARGS;
            for (int it = bid; it < 256; it += G) gla_final_item(a, l, it);
            if (rep + 1 == NREP(4)) mla_finish(a);
            SEAM(P + 3); }
        if (IN(P + 4) && EN(5)) for (int rep = 0; rep < NREP(5); ++rep) {
            PH_ARGS; const bf16* wl = (const bf16*)(ws + WS_W) + (size_t)l * W_LAYER;
            pg8::Gemm gm{(const bf16*)(ws + WS_Y), wl + W_OUT, MT, DM, DM, DM, DM}; pg8::StaticOrder S; S.init(MT, DM, G, bid);
            pg8::EpiRow E{(bf16*)(ws + WS_MB), DM, nullptr, 0, 0, 0.f, EPS, (float*)(ws + WS_PS_M), 32, 0, 8};
            pg8::gemm_phase<pg8::EpiRow, pg8::StaticOrder, true, true>(lds, gm, S, E); SEAM(P + 4); }
        if (IN(P + 5) && EN(6)) { PH_ARGS; rowpass(l == 0 ? a.x : a.out, a.out, (const bf16*)(ws + WS_MB), (const float*)(ws + WS_PS_M), a.attn_post + l * DM, (bf16*)(ws + WS_XB), (float*)(ws + WS_RSTD)); SEAM(P + 5); }
        if (IN(P + 6) && EN(7)) for (int rep = 0; rep < NREP(7); ++rep) {
            PH_ARGS; const bf16* wl = (const bf16*)(ws + WS_W) + (size_t)l * W_LAYER;
            pg8::Gemm gm{(const bf16*)(ws + WS_XB), wl + W_GU, MT, NGU, DM, DM, DM}; pg8::StaticOrder S; S.init(MT, NGU, G, bid);
            pg8::EpiGU E{(bf16*)(ws + WS_HDN), DFF, (const float*)(ws + WS_RSTD)};
            pg8::gemm_phase<pg8::EpiGU, pg8::StaticOrder, true, true>(lds, gm, S, E); SEAM(P + 6); }
        if (IN(P + 7) && EN(8)) for (int rep = 0; rep < NREP(8); ++rep) {
            PH_ARGS; const bf16* wl = (const bf16*)(ws + WS_W) + (size_t)l * W_LAYER;
            pg8::Gemm gm{(const bf16*)(ws + WS_HDN), wl + W_DN, MT, DM, DFF, DFF, DFF}; pg8::StaticOrder S; S.init(MT, DM, G, bid);
            pg8::EpiRow E{(bf16*)(ws + WS_MB), DM, nullptr, 0, 0, 0.f, EPS, (float*)(ws + WS_PS_M), 32, 0, 8};
            pg8::gemm_phase<pg8::EpiRow, pg8::StaticOrder, true, true>(lds, gm, S, E); SEAM(P + 7); }
        if (IN(P + 8) && EN(9)) { PH_ARGS; rowpass(a.out, a.out, (const bf16*)(ws + WS_MB), (const float*)(ws + WS_PS_M), a.ffn_post + l * DM, (bf16*)(ws + WS_XB), (float*)(ws + WS_RSTD)); if (l + 1 < DEPTH) SEAM(P + 8); }
    }
#undef IN
#undef SEAM
}

extern "C" void kernel_launch(void* const* d_in, const int* in_sizes, int n_in, void* d_out, int out_size, void* d_ws, size_t ws_size, hipStream_t stream) {
    static int grid = 0;
    if (grid == 0) {
        if (n_in != 21 || in_sizes[0] != MT * DM || out_size != MT * DM || ws_size < WS_END) { fprintf(stderr, "kernel_launch: unexpected shapes (n_in %d, in0 %d, out %d, ws %zu, need %zu)\n", n_in, n_in > 0 ? in_sizes[0] : -1, out_size, ws_size, (size_t)WS_END); grid = -1; return; }
        int dev = 0, cus = 0, per_cu = 0;
        hipGetDevice(&dev); hipDeviceGetAttribute(&cus, hipDeviceAttributeMultiprocessorCount, dev);
        if (hipFuncSetAttribute((const void*)mega_fwd, hipFuncAttributeMaxDynamicSharedMemorySize, LDS_BYTES) != hipSuccess) { fprintf(stderr, "kernel_launch: hipFuncSetAttribute failed\n"); grid = -1; return; }
        if (hipOccupancyMaxActiveBlocksPerMultiprocessor(&per_cu, (const void*)mega_fwd, NTHR, LDS_BYTES) != hipSuccess || per_cu < 1) { fprintf(stderr, "kernel_launch: occupancy query says %d blocks per CU\n", per_cu); (void)hipGetLastError(); per_cu = 1; }
        grid = cus > 0 ? cus : 256;
    }
    if (grid < 0) return;
    Args a{};
    a.x = (const float*)d_in[0]; a.pos = (const int*)d_in[1]; a.attn_pre = (const float*)d_in[2]; a.w_in = (const float*)d_in[3]; a.gate_w2 = (const float*)d_in[4]; a.gate_b = (const float*)d_in[5];
    a.gla_norm = (const float*)d_in[6]; a.lb_logits = (const float*)d_in[7]; a.hgrn_norm = (const float*)d_in[8]; a.q_norm = (const float*)d_in[9]; a.wq_b = (const float*)d_in[10]; a.kv_norm = (const float*)d_in[11];
    a.wkv_b = (const float*)d_in[12]; a.mla_out_norm = (const float*)d_in[13]; a.w_out = (const float*)d_in[14]; a.attn_post = (const float*)d_in[15]; a.ffn_pre = (const float*)d_in[16];
    a.w_gate = (const float*)d_in[17]; a.w_up = (const float*)d_in[18]; a.w_down = (const float*)d_in[19]; a.ffn_post = (const float*)d_in[20]; a.out = (float*)d_out; a.ws = (unsigned char*)d_ws;
    if (hipMemsetAsync((char*)d_ws + WS_BAR, 0, BAR_BYTES, stream) != hipSuccess) { fprintf(stderr, "kernel_launch: memset failed\n"); return; }
#if MK_PER_PHASE
    for (int p = 0; p < N_PHASES; ++p) { a.ph_lo = p; a.ph_hi = p + 1; hipLaunchKernelGGL(mega_fwd, dim3(grid), dim3(NTHR), LDS_BYTES, stream, a); }
#else
    a.ph_lo = 0; a.ph_hi = N_PHASES; void* args[] = {&a};
    hipError_t e = hipLaunchCooperativeKernel((const void*)mega_fwd, dim3(grid), dim3(NTHR), args, LDS_BYTES, stream);
    if (e != hipSuccess) fprintf(stderr, "kernel_launch: cooperative launch failed: %s (grid %d)\n", hipGetErrorString(e), grid);
#endif
}
```

```cpp
#include <hip/hip_runtime.h>
#include <hip/hip_cooperative_groups.h>
#include <cstdio>
#include <cstdint>
namespace cg = cooperative_groups;
#ifndef MK_PER_PHASE
#define MK_PER_PHASE 0
#endif
namespace pg8 {
#define PG8_LAS __attribute__((address_space(3)))
typedef unsigned short bf16_t;
typedef short bf16x8 __attribute__((ext_vector_type(8)));
typedef float f32x4 __attribute__((ext_vector_type(4)));
typedef unsigned u32x4 __attribute__((ext_vector_type(4)));
constexpr int BM = 256, BK = 64, HALF = 128, HTB = HALF * BK * 2  , STAGE_BYTES = 8 * HTB, NXCD = 8, WGM = 8;

__host__ __device__ __forceinline__ int lds_byte(int r, int c) { const int st = (r >> 4) * 2 + (c >> 5), rr = r & 15, cc = c & 31, ob = rr * 64 + cc * 2; return st * 1024 + (ob ^ (((ob >> 9) & 1) << 5)); }
__host__ __device__ __forceinline__ void stage_rc(int b, int& R, int& C) { const int st = b / 1024, sb = b % 1024, swz = sb ^ (((sb >> 9) & 1) << 5); R = (st >> 1) * 16 + swz / 64; C = (st & 1) * 32 + (swz % 64) / 2; }
__host__ __device__ __forceinline__ int perm32(int rho) { const int n = rho >> 4, i = rho & 15; return 8 * (i >> 2) + 4 * n + (i & 3); }

struct Unit { int pm, pn; };
struct Gemm { const bf16_t* A; const bf16_t* Bt; int M, N, K, lda, ldb; };

struct StaticOrder {
    int nM, nN, nwg, G, c;
    __host__ __device__ void init(int M, int N, int G_, int c_) { nM = M / BM; nN = N / BM; nwg = nM * nN; G = G_; c = c_; }
    __host__ __device__ bool next(int i, Unit& u) const {
        const long L = (long)i * G + c; if (L >= nwg) return false;
        int wgid = (int)L; { const int q = nwg / NXCD, r = nwg % NXCD, xcd = wgid % NXCD, off = wgid / NXCD; wgid = (xcd < r ? xcd * (q + 1) : r * (q + 1) + (xcd - r) * q) + off; }
        const int nig = WGM * nN, gid = wgid / nig, fm = gid * WGM, gsz = (nM - fm) < WGM ? (nM - fm) : WGM;
        u.pm = fm + ((wgid % nig) % gsz); u.pn = (wgid % nig) / gsz; return true;
    }
    __device__ __forceinline__ void a_ready(const Unit&) const {}
    __device__ __forceinline__ void done(const Unit&) const {}
};

__device__ __forceinline__ unsigned cvt_pk_bf16(float lo, float hi) { unsigned r; asm volatile("v_cvt_pk_bf16_f32 %0, %1, %2" : "=v"(r) : "v"(lo), "v"(hi)); return r; }
typedef float f32x2 __attribute__((ext_vector_type(2)));
__device__ __forceinline__ float quad_col_sum(float v) { v += __shfl_xor(v, 16); v += __shfl_xor(v, 32); return v; }
struct EpiRow {
    static constexpr bool PERM = true, AFTER_DRAIN = false;
    bf16_t* O; int ldc; const float* rs; int rs_ld, rs_n; float rs_mul; float eps;
    float* ps; int ps_ld, pn_lo, pn_hi;
    __device__ __forceinline__ void operator()(const f32x4 (&acc)[2][2][4][2], const Unit& u, int wr, int wc, int fr, int fq) const {
        const int row0 = u.pm * BM + wr * 64 + fr, col0 = u.pn * BM + wc * 32 + 8 * fq;
        float* sq = (ps && u.pn >= pn_lo && u.pn < pn_hi) ? ps + (u.pn - pn_lo) * 4 + wc : nullptr;
#pragma unroll
        for (int ai = 0; ai < 2; ++ai)
#pragma unroll
            for (int m = 0; m < 4; ++m) { const int row = row0 + ai * HALF + m * 16; bf16_t* rowp = O + (size_t)row * ldc + col0;
                float sc = 1.f; if (rs) { if (rs_n == 0) sc = rs[row]; else { float t = 0.f; for (int i = 0; i < rs_n; i += 4) { const f32x4 q = *(const f32x4*)(rs + (size_t)row * rs_ld + i); t += (q[0] + q[1]) + (q[2] + q[3]); } sc = __builtin_amdgcn_rsqf(t * rs_mul + eps); } }
                float ss = 0.f;
#pragma unroll
                for (int bj = 0; bj < 2; ++bj) { f32x4 v0 = acc[ai][bj][m][0] * sc, v1 = acc[ai][bj][m][1] * sc;
                    ss += (v0[0] * v0[0] + v0[1] * v0[1]) + (v0[2] * v0[2] + v0[3] * v0[3]) + (v1[0] * v1[0] + v1[1] * v1[1]) + (v1[2] * v1[2] + v1[3] * v1[3]);
                    u32x4 w; w.x = cvt_pk_bf16(v0[0], v0[1]); w.y = cvt_pk_bf16(v0[2], v0[3]); w.z = cvt_pk_bf16(v1[0], v1[1]); w.w = cvt_pk_bf16(v1[2], v1[3]);
                    *(u32x4*)(rowp + bj * HALF) = w; }
                if (sq) { ss = quad_col_sum(ss); if (fq == 0) sq[(size_t)row * ps_ld] = ss; } }
    }
};
struct EpiQ {
    static constexpr bool PERM = true, AFTER_DRAIN = false;
    bf16_t* O; const float* ssq; float eps; float qscale; const float* ctab; const float* stab;
    __device__ __forceinline__ void operator()(const f32x4 (&acc)[2][2][4][2], const Unit& u, int wr, int wc, int fr, int fq) const {
        const int row0 = u.pm * BM + wr * 64 + fr; const bool rope = u.pn >= 4;
#pragma unroll
        for (int ai = 0; ai < 2; ++ai)
#pragma unroll
            for (int m = 0; m < 4; ++m) { const int row = row0 + ai * HALF + m * 16; const f32x4 s0 = *(const f32x4*)(ssq + (size_t)row * 16), s1 = *(const f32x4*)(ssq + (size_t)row * 16 + 4);
                const float sc = __builtin_amdgcn_rsqf((((s0[0] + s0[1]) + (s0[2] + s0[3])) + ((s1[0] + s1[1]) + (s1[2] + s1[3]))) * (1.f / 512.f) + eps) * qscale;
#pragma unroll
                for (int bj = 0; bj < 2; ++bj) { f32x4 v0 = acc[ai][bj][m][0] * sc, v1 = acc[ai][bj][m][1] * sc; int dst;
                    if (!rope) { const int c = u.pn * BM + bj * HALF + wc * 32 + 8 * fq; dst = (c >> 7) * 192 + (c & 127); }
                    else { const int c = (u.pn - 4) * BM + bj * HALF + wc * 32 + 8 * fq; const int hh = c >> 6, j = c & 63; dst = hh * 192 + 128 + j;
                        const f32x4 cs = *(const f32x4*)(ctab + (size_t)row * 32 + (j >> 1)), sn = *(const f32x4*)(stab + (size_t)row * 32 + (j >> 1));
                        f32x4 a0, a1; a0[0] = v0[0] * cs[0] - v0[1] * sn[0]; a0[1] = v0[1] * cs[0] + v0[0] * sn[0]; a0[2] = v0[2] * cs[1] - v0[3] * sn[1]; a0[3] = v0[3] * cs[1] + v0[2] * sn[1];
                        a1[0] = v1[0] * cs[2] - v1[1] * sn[2]; a1[1] = v1[1] * cs[2] + v1[0] * sn[2]; a1[2] = v1[2] * cs[3] - v1[3] * sn[3]; a1[3] = v1[3] * cs[3] + v1[2] * sn[3]; v0 = a0; v1 = a1; }
                    u32x4 w; w.x = cvt_pk_bf16(v0[0], v0[1]); w.y = cvt_pk_bf16(v0[2], v0[3]); w.z = cvt_pk_bf16(v1[0], v1[1]); w.w = cvt_pk_bf16(v1[2], v1[3]);
                    *(u32x4*)(O + (size_t)row * 1536 + dst) = w; } }
    }
};
struct EpiVT {
    static constexpr bool PERM = true, AFTER_DRAIN = false;
    bf16_t* O; int ldc; const float* ssq; float eps;
    __device__ __forceinline__ void operator()(const f32x4 (&acc)[2][2][4][2], const Unit& u, int wr, int wc, int fr, int fq) const {
        const int row0 = u.pm * BM + wr * 64 + fr, col0 = u.pn * BM + wc * 32 + 8 * fq;
        f32x4 s[2][2];
#pragma unroll
        for (int bj = 0; bj < 2; ++bj)
#pragma unroll
            for (int n = 0; n < 2; ++n)
#pragma unroll
                for (int e = 0; e < 4; ++e) { const float* p = ssq + (size_t)(col0 + bj * HALF + 4 * n + e) * 16 + 8; const f32x4 s0 = *(const f32x4*)p, s1 = *(const f32x4*)(p + 4);
                    s[bj][n][e] = __builtin_amdgcn_rsqf((((s0[0] + s0[1]) + (s0[2] + s0[3])) + ((s1[0] + s1[1]) + (s1[2] + s1[3]))) * (1.f / 512.f) + eps); }
#pragma unroll
        for (int ai = 0; ai < 2; ++ai)
#pragma unroll
            for (int m = 0; m < 4; ++m) { bf16_t* rowp = O + (size_t)(row0 + ai * HALF + m * 16) * ldc + col0;
#pragma unroll
                for (int bj = 0; bj < 2; ++bj) { const f32x4 v0 = acc[ai][bj][m][0] * s[bj][0], v1 = acc[ai][bj][m][1] * s[bj][1];
                    u32x4 w; w.x = cvt_pk_bf16(v0[0], v0[1]); w.y = cvt_pk_bf16(v0[2], v0[3]); w.z = cvt_pk_bf16(v1[0], v1[1]); w.w = cvt_pk_bf16(v1[2], v1[3]);
                    *(u32x4*)(rowp + bj * HALF) = w; } }
    }
};
struct EpiGU {
    static constexpr bool PERM = true, AFTER_DRAIN = false;
    bf16_t* O; int ldc; const float* rs;
    __device__ __forceinline__ void operator()(const f32x4 (&acc)[2][2][4][2], const Unit& u, int wr, int wc, int fr, int fq) const {
        const int row0 = u.pm * BM + wr * 64 + fr, col0 = u.pn * HALF + wc * 32 + 8 * fq;
#pragma unroll
        for (int ai = 0; ai < 2; ++ai)
#pragma unroll
            for (int m = 0; m < 4; ++m) { const int row = row0 + ai * HALF + m * 16; const float sc = rs[row]; float o[8];
#pragma unroll
                for (int n = 0; n < 2; ++n)
#pragma unroll
                    for (int e = 0; e < 4; ++e) { const float gv = acc[ai][0][m][n][e] * sc, uv = acc[ai][1][m][n][e] * sc;
                        o[4 * n + e] = gv * __builtin_amdgcn_rcpf(1.f + __expf(-gv)) * uv; }
                u32x4 w; w.x = cvt_pk_bf16(o[0], o[1]); w.y = cvt_pk_bf16(o[2], o[3]); w.z = cvt_pk_bf16(o[4], o[5]); w.w = cvt_pk_bf16(o[6], o[7]);
                *(u32x4*)(O + (size_t)row * ldc + col0) = w; }
    }
};
template <class Epi, class Sched, bool ALIGN_EPI = false, bool SP2 = false>
__device__ __forceinline__ void gemm_phase(PG8_LAS unsigned char* lds, const Gemm g, const Sched& S, const Epi& E) {
    int tid_o = threadIdx.x; asm volatile("" : "+v"(tid_o)); const int tid = tid_o, wid = __builtin_amdgcn_readfirstlane(tid >> 6), lane = tid & 63, wr = wid >> 2, wc = wid & 3, fr = lane & 15, fq = lane >> 4;
    const int K = g.K, nt = K / BK;
    unsigned voffA[2], voffB[2];
#pragma unroll
    for (int i = 0; i < 2; ++i) { int R, C; stage_rc(tid * 16 + i * 8192, R, C); const int Rb = Epi::PERM ? ((R & ~31) + perm32(R & 31)) : R;
        voffA[i] = (unsigned)(R * g.lda + C) * 2u; voffB[i] = (unsigned)(Rb * g.ldb + C) * 2u; }
    const size_t kstep = (size_t)(BK * 2);
    const size_t hstepA = (size_t)HALF * g.lda * 2, hstepB = (size_t)HALF * g.ldb * 2;
    const size_t tstepA = 2 * hstepA, tstepB = 2 * hstepB;
    const unsigned ldsw = (unsigned)wid * 1024u;
    const int aoff = lds_byte(wr * 64 + fr, fq * 8), boff = lds_byte(wc * 32 + fr, fq * 8);
#define PG8_SA(b, h) (((b) * 2 + (h)) * HTB)
#define PG8_SB(b, h) ((4 + (b) * 2 + (h)) * HTB)
#define PG8_STAGE(bufoff, gbase, voff) do { _Pragma("unroll") for (int _i = 0; _i < 2; ++_i) \
        __builtin_amdgcn_global_load_lds((const unsigned*)((const char*)(gbase) + (voff)[_i]), (PG8_LAS unsigned*)(lds + (bufoff) + ldsw + _i * 8192), 16, 0, 0); } while (0)
#define PG8_LDA(dst, b, h) do { _Pragma("unroll") for (int m = 0; m < 4; ++m) _Pragma("unroll") for (int k = 0; k < 2; ++k) dst[m][k] = *(const PG8_LAS bf16x8*)(lds + PG8_SA(b, h) + aoff + m * 2048 + k * 1024); } while (0)
#define PG8_LDB(dst, b, h) do { _Pragma("unroll") for (int n = 0; n < 2; ++n) _Pragma("unroll") for (int k = 0; k < 2; ++k) dst[n][k] = *(const PG8_LAS bf16x8*)(lds + PG8_SB(b, h) + boff + n * 2048 + k * 1024); } while (0)
#define PG8_MMA(ai, bj, At, Bt) do { __builtin_amdgcn_s_setprio(1); _Pragma("unroll") for (int m = 0; m < 4; ++m) _Pragma("unroll") for (int n = 0; n < 2; ++n) _Pragma("unroll") for (int k = 0; k < 2; ++k) \
        acc[ai][bj][m][n] = __builtin_amdgcn_mfma_f32_16x16x32_bf16(Bt[n][k], At[m][k], acc[ai][bj][m][n], 0, 0, 0); __builtin_amdgcn_s_setprio(0); } while (0)
#define PG8_WAIT_V(n) asm volatile("s_waitcnt vmcnt(" #n ")" ::: "memory")
#define PG8_WAIT_L(n) asm volatile("s_waitcnt lgkmcnt(" #n ")" ::: "memory")
#define PG8_BAR __builtin_amdgcn_s_barrier()
#define PG8_SCHED __builtin_amdgcn_sched_barrier(0)
    Unit cur, nxt; int ui = 0;
    if (!S.next(0, cur)) return;
    f32x4 acc[2][2][4][2];
#pragma unroll
    for (int a = 0; a < 2; ++a)
#pragma unroll
        for (int b = 0; b < 2; ++b)
#pragma unroll
            for (int m = 0; m < 4; ++m)
#pragma unroll
                for (int n = 0; n < 2; ++n) acc[a][b][m][n] = (f32x4){0.f, 0.f, 0.f, 0.f};
    bf16x8 At[4][2], B0[2][2], B1[2][2];
    const char* cA = (const char*)g.A + (size_t)cur.pm * tstepA; const char* cB = (const char*)g.Bt + (size_t)cur.pn * tstepB;
    S.a_ready(cur);
    if constexpr (SP2) {
        PG8_STAGE(PG8_SB(0, 0), cB, voffB); PG8_STAGE(PG8_SB(0, 1), cB + hstepB, voffB); PG8_STAGE(PG8_SA(0, 0), cA, voffA); PG8_STAGE(PG8_SA(0, 1), cA + hstepA, voffA);
        if (wr == 1) PG8_BAR;
        PG8_WAIT_V(2); PG8_BAR;
        PG8_STAGE(PG8_SB(1, 0), cB + kstep, voffB); PG8_STAGE(PG8_SA(1, 0), cA + kstep, voffA); PG8_STAGE(PG8_SB(1, 1), cB + hstepB + kstep, voffB);
        PG8_WAIT_V(6); PG8_BAR;
    } else {
        PG8_STAGE(PG8_SB(0, 0), cB, voffB); PG8_STAGE(PG8_SA(0, 0), cA, voffA); PG8_STAGE(PG8_SB(0, 1), cB + hstepB, voffB); PG8_STAGE(PG8_SA(0, 1), cA + hstepA, voffA);
        if (wr == 1) PG8_BAR;
        PG8_WAIT_V(4); PG8_BAR;
        PG8_STAGE(PG8_SB(1, 0), cB + kstep, voffB); PG8_STAGE(PG8_SA(1, 0), cA + kstep, voffA); PG8_STAGE(PG8_SB(1, 1), cB + hstepB + kstep, voffB);
        PG8_WAIT_V(6); PG8_BAR;
    }
    for (;;) {
        const bool has_next = S.next(ui + 1, nxt);
        const char* nA = has_next ? (const char*)g.A + (size_t)nxt.pm * tstepA : cA; const char* nB = has_next ? (const char*)g.Bt + (size_t)nxt.pn * tstepB : cB;
        for (int t = 0; t < nt; t += 2) {
            const bool last = (t == nt - 2);
            const char* a1 = cA + (size_t)(t + 1) * kstep;
            const char* a2 = last ? nA : cA + (size_t)(t + 2) * kstep; const char* b2 = last ? nB : cB + (size_t)(t + 2) * kstep;
            const char* a3 = a2 + kstep; const char* b3 = b2 + kstep;
            if (last && has_next) S.a_ready(nxt);
            if constexpr (SP2) {
            PG8_LDB(B0, 0, 0); PG8_LDB(B1, 0, 1); PG8_SCHED; PG8_LDA(At, 0, 0); PG8_STAGE(PG8_SA(1, 1), a1 + hstepA, voffA);
            PG8_WAIT_V(8); PG8_WAIT_L(0); PG8_BAR; PG8_MMA(0, 0, At, B0); PG8_MMA(0, 1, At, B1); PG8_BAR; PG8_SCHED;
            PG8_LDA(At, 0, 1); PG8_STAGE(PG8_SB(0, 0), b2, voffB); PG8_STAGE(PG8_SB(0, 1), b2 + hstepB, voffB); PG8_STAGE(PG8_SA(0, 0), a2, voffA);
            PG8_WAIT_V(8); PG8_WAIT_L(0); PG8_BAR; PG8_MMA(1, 0, At, B0); PG8_MMA(1, 1, At, B1); PG8_BAR; PG8_SCHED;
            PG8_LDB(B0, 1, 0); PG8_LDB(B1, 1, 1); PG8_SCHED; PG8_LDA(At, 1, 0); PG8_STAGE(PG8_SA(0, 1), a2 + hstepA, voffA);
            PG8_WAIT_V(8); PG8_WAIT_L(0); PG8_BAR; PG8_MMA(0, 0, At, B0); PG8_MMA(0, 1, At, B1); PG8_BAR; PG8_SCHED;
            PG8_LDA(At, 1, 1); PG8_STAGE(PG8_SB(1, 0), b3, voffB); PG8_STAGE(PG8_SB(1, 1), b3 + hstepB, voffB); PG8_STAGE(PG8_SA(1, 0), a3, voffA);
            PG8_WAIT_V(8); PG8_WAIT_L(0); PG8_BAR; PG8_MMA(1, 0, At, B0); PG8_MMA(1, 1, At, B1); PG8_BAR; PG8_SCHED;
            } else {
            PG8_LDB(B0, 0, 0); PG8_SCHED; PG8_LDA(At, 0, 0); PG8_STAGE(PG8_SA(1, 1), a1 + hstepA, voffA);
            PG8_WAIT_L(8); PG8_BAR; PG8_WAIT_L(0); PG8_MMA(0, 0, At, B0); PG8_BAR; PG8_SCHED;
            PG8_LDB(B1, 0, 1); PG8_STAGE(PG8_SB(0, 0), b2, voffB);
            PG8_BAR; PG8_WAIT_L(0); PG8_MMA(0, 1, At, B1); PG8_BAR;
            PG8_LDA(At, 0, 1); PG8_STAGE(PG8_SA(0, 0), a2, voffA);
            PG8_BAR; PG8_WAIT_L(0); PG8_MMA(1, 0, At, B0); PG8_BAR; PG8_SCHED;
            PG8_STAGE(PG8_SB(0, 1), b2 + hstepB, voffB);
            PG8_WAIT_V(6); PG8_BAR; PG8_MMA(1, 1, At, B1); PG8_BAR;
            PG8_LDB(B0, 1, 0); PG8_SCHED; PG8_LDA(At, 1, 0); PG8_STAGE(PG8_SA(0, 1), a2 + hstepA, voffA);
            PG8_WAIT_L(8); PG8_BAR; PG8_WAIT_L(0); PG8_MMA(0, 0, At, B0); PG8_BAR; PG8_SCHED;
            PG8_LDB(B1, 1, 1); PG8_STAGE(PG8_SB(1, 0), b3, voffB);
            PG8_BAR; PG8_WAIT_L(0); PG8_MMA(0, 1, At, B1); PG8_BAR;
            PG8_LDA(At, 1, 1); PG8_STAGE(PG8_SA(1, 0), a3, voffA);
            PG8_BAR; PG8_WAIT_L(0); PG8_MMA(1, 0, At, B0); PG8_BAR; PG8_SCHED;
            PG8_STAGE(PG8_SB(1, 1), b3 + hstepB, voffB);
            PG8_WAIT_V(6); PG8_BAR; PG8_MMA(1, 1, At, B1); PG8_BAR;
            }
        }
        if constexpr (ALIGN_EPI) { if (wr == 0) PG8_BAR; }
        if constexpr (!Epi::AFTER_DRAIN) { E(acc, cur, wr, wc, fr, fq); S.done(cur); }
        if (!has_next) break;
#pragma unroll
        for (int a = 0; a < 2; ++a)
#pragma unroll
            for (int b = 0; b < 2; ++b)
#pragma unroll
                for (int m = 0; m < 4; ++m)
#pragma unroll
                    for (int n = 0; n < 2; ++n) acc[a][b][m][n] = (f32x4){0.f, 0.f, 0.f, 0.f};
        cur = nxt; cA = nA; cB = nB; ++ui;
        if constexpr (ALIGN_EPI) { if (wr == 1) PG8_BAR; }
    }
    PG8_WAIT_V(0);
    if constexpr (!ALIGN_EPI) { if (wr == 0) PG8_BAR; }
    PG8_BAR;
    if constexpr (Epi::AFTER_DRAIN) { E.fused(acc, cur, wr, wc, fr, fq, lds, wid, lane); S.done(cur); }
#undef PG8_SA
#undef PG8_SB
#undef PG8_STAGE
#undef PG8_LDA
#undef PG8_LDB
#undef PG8_MMA
#undef PG8_WAIT_V
#undef PG8_WAIT_L
#undef PG8_BAR
#undef PG8_SCHED
}
}
#define LAS __attribute__((address_space(3)))
typedef unsigned short bf16;
typedef short bf16x8 __attribute__((ext_vector_type(8)));
typedef float f32x4 __attribute__((ext_vector_type(4)));
typedef float f32x16 __attribute__((ext_vector_type(16)));
typedef unsigned u32x4 __attribute__((ext_vector_type(4)));
typedef unsigned u32x2 __attribute__((ext_vector_type(2)));
typedef float f32x2 __attribute__((ext_vector_type(2)));
constexpr int NB = 2, SEQ = 4096, MT = NB * SEQ, DM = 2048, DEPTH = 4, DIN = 4688, NIN = 4864, DFF = 5632, NGU = 2 * DFF;
constexpr int C_GQ = 0, C_GK = 256, C_GV = 512, C_GO = 1024, C_HQ = 1536, C_HF = 2048, C_HI = 2560, C_HO = 3072, C_QC = 3584, C_KVC = 4096, C_KPE = 4608, C_GLOW = 4672;
constexpr float EPS = 1e-6f;
constexpr float QSCALE = 0.07216878364870322f * 1.4426950408889634f;
constexpr int NWAVES = 8, NTHR = 512;
constexpr int LDS_BYTES = 143360;
constexpr size_t W_IN = 0, W_Q = W_IN + (size_t)NIN * DM, W_K = W_Q + 1536 * 512, W_V = W_K + 1024 * 512, W_OUT = W_V + 1024 * 512, W_GU = W_OUT + (size_t)DM * DM,
                 W_DN = W_GU + (size_t)NGU * DM, W_LAYER = W_DN + (size_t)DM * DFF;
constexpr size_t al256(size_t x) { return (x + 255) & ~(size_t)255; }
constexpr size_t WS_PS_QKV = 0, WS_PS_O = WS_PS_QKV + (size_t)MT * 16 * 4, WS_PS_M = WS_PS_O + (size_t)MT * 8 * 4, WS_RSTD = WS_PS_M + (size_t)MT * 32 * 4;
constexpr size_t WS_COS = WS_RSTD + MT * 4, WS_SIN = WS_COS + (size_t)MT * 32 * 4, WS_DL_G = WS_SIN + (size_t)MT * 32 * 4, WS_DL_H = WS_DL_G + 8 * 64 * 64 * 4, WS_KPE = WS_DL_H + 8 * 64 * 128 * 4;
constexpr size_t WS_ML = al256(WS_KPE + (size_t)MT * 64 * 2);
constexpr size_t WS_BAR = al256(WS_ML + (size_t)2 * 16 * 8 * 256 * 2 * 4), BAR_BYTES = 16384;
constexpr size_t WS_W = al256(WS_BAR + BAR_BYTES);
constexpr size_t WS_XB = al256(WS_W + W_LAYER * DEPTH * 2);
constexpr size_t WS_Y = WS_XB + (size_t)MT * DM * 2;
constexpr size_t WS_MB = WS_Y + (size_t)MT * DM * 2;
constexpr size_t WS_VT = WS_MB + (size_t)MT * DM * 2;
constexpr size_t WS_QE_G = WS_VT + (size_t)1024 * MT * 2;
constexpr size_t WS_QE_H = WS_QE_G + (size_t)MT * 256 * 2;
constexpr size_t WS_UT_G = WS_QE_H + (size_t)MT * 512 * 2;
constexpr size_t WS_UT_H = WS_UT_G + (size_t)8 * 64 * 128 * 64 * 4;
constexpr size_t WS_SP_G = WS_UT_H + (size_t)8 * 64 * 128 * 128 * 4;
constexpr size_t WS_SP_H = WS_SP_G + (size_t)8 * 64 * 128 * 64 * 2;
constexpr size_t WS_OI = WS_SP_H + (size_t)8 * 64 * 128 * 128 * 2;
constexpr size_t WS_R1 = WS_OI + (size_t)2 * MT * 512 * 4;
constexpr size_t WS_PROJ = WS_R1, WS_Q = WS_PROJ + (size_t)MT * NIN * 2, WS_KN = WS_Q + (size_t)MT * 1536 * 2, WS_R1_END = WS_KN + (size_t)MT * 1024 * 2;
constexpr size_t WS_HDN = WS_R1;
static_assert(WS_HDN + (size_t)MT * DFF * 2 <= WS_R1_END, "hdn overlay");
constexpr size_t WS_END = WS_R1_END;

struct Args {
    const float* x; const int* pos; const float* attn_pre; const float* w_in; const float* gate_w2; const float* gate_b; const float* gla_norm; const float* lb_logits; const float* hgrn_norm;
    const float* q_norm; const float* wq_b; const float* kv_norm; const float* wkv_b; const float* mla_out_norm; const float* w_out; const float* attn_post; const float* ffn_pre;
    const float* w_gate; const float* w_up; const float* w_down; const float* ffn_post; float* out; unsigned char* ws; int ph_lo, ph_hi;
};

__device__ __forceinline__ unsigned f2bf(float f) { unsigned u = __builtin_bit_cast(unsigned, f); return (u + 0x7fffu + ((u >> 16) & 1u)) >> 16; }
__device__ __forceinline__ float bf2f(bf16 b) { return __builtin_bit_cast(float, (unsigned)b << 16); }
__device__ __forceinline__ unsigned pk2(float lo, float hi) { return pg8::cvt_pk_bf16(lo, hi); }
__device__ __forceinline__ float wave_sum(float v) {
#pragma unroll
    for (int o = 1; o < 64; o <<= 1) v += __shfl_xor(v, o);
    return v;
}
__device__ __forceinline__ int crow(int r, int hi) { return (r & 3) + 8 * (r >> 2) + 4 * hi; }
#define LDS_WAIT() asm volatile("s_waitcnt lgkmcnt(0)" ::: "memory")

__device__ __forceinline__ int w_srccol(int mat, int n) {
    switch (mat) {
    case 0: return n < 1024 ? n : (n < 4672 ? n + 16 : (n < 4688 ? n - 3648 : -1));
    case 1: { if (n < 1024) return (n >> 7) * 192 + (n & 127); const int c = n - 1024, hh = c >> 6, j = c & 63, i = j >> 1; return hh * 192 + 128 + ((j & 1) ? i + 32 : i); }
    case 2: return (n >> 7) * 256 + (n & 127);
    case 3: return (n >> 7) * 256 + 128 + (n & 127);
    case 5: return (n >> 8) * 128 + (n & 127);
    default: return n;
    }
}
struct ConvDesc { const float* src; const float* gain; bf16* dst; int ldsrc, mat, gmin, k0, K, n0; };
constexpr int I_IN = (NIN / 128) * (DM / 128), I_Q = 12 * 4, I_K = 8 * 4, I_V = 8 * 4, I_OUT = 16 * 16, I_GU = (NGU / 128) * 16, I_DN = 16 * (DFF / 128);
constexpr int I_LAYER = I_IN + I_Q + I_K + I_V + I_OUT + I_GU + I_DN;
__device__ __forceinline__ ConvDesc conv_decode(const Args& a, int l, int r) {
    bf16* wl = (bf16*)(a.ws + WS_W) + (size_t)l * W_LAYER; ConvDesc d;
    if (r < I_IN) { const int nb = r % (NIN / 128), kb = r / (NIN / 128); d = ConvDesc{a.w_in + (size_t)l * DM * DIN, a.attn_pre + l * DM, wl + W_IN, DIN, 0, 0, kb * 128, DM, nb * 128}; return d; } r -= I_IN;
    if (r < I_Q) { const int nb = r % 12, kb = r / 12; d = ConvDesc{a.wq_b + (size_t)l * 512 * 1536, a.q_norm + l * 512, wl + W_Q, 1536, 1, 0, kb * 128, 512, nb * 128}; return d; } r -= I_Q;
    if (r < I_K) { const int nb = r % 8, kb = r / 8; d = ConvDesc{a.wkv_b + (size_t)l * 512 * 2048, a.kv_norm + l * 512, wl + W_K, 2048, 2, 0, kb * 128, 512, nb * 128}; return d; } r -= I_K;
    if (r < I_V) { const int nb = r % 8, kb = r / 8; d = ConvDesc{a.wkv_b + (size_t)l * 512 * 2048, a.kv_norm + l * 512, wl + W_V, 2048, 3, 0, kb * 128, 512, nb * 128}; return d; } r -= I_V;
    if (r < I_OUT) { const int nb = r % 16, kb = r / 16; d = ConvDesc{a.w_out + (size_t)l * DM * DM, a.mla_out_norm + l * 1024, wl + W_OUT, DM, 4, 1024, kb * 128, DM, nb * 128}; return d; } r -= I_OUT;
    if (r < I_GU) { const int nb = r % (NGU / 128), kb = r / (NGU / 128); d = ConvDesc{((nb & 1) ? a.w_up : a.w_gate) + (size_t)l * DM * DFF, a.ffn_pre + l * DM, wl + W_GU, DFF, 5, 0, kb * 128, DM, nb * 128}; return d; } r -= I_GU;
    { const int nb = r % 16, kb = r / 16; d = ConvDesc{a.w_down + (size_t)l * DFF * DM, nullptr, wl + W_DN, DM, 6, 0, kb * 128, DFF, nb * 128}; return d; }
}
__device__ __forceinline__ void conv_load(const ConvDesc& d, int tid, f32x4 (&v)[4][2], float (&gn)[4][2]) {
    const int c4 = tid & 31, rp = tid >> 5; int sc[4];
#pragma unroll
    for (int j = 0; j < 4; ++j) sc[j] = w_srccol(d.mat, d.n0 + 4 * c4 + j);
    const bool contig = sc[0] >= 0 && sc[1] == sc[0] + 1 && sc[2] == sc[0] + 2 && sc[3] == sc[0] + 3;
#pragma unroll
    for (int i = 0; i < 4; ++i)
#pragma unroll
        for (int e = 0; e < 2; ++e) { const int k = d.k0 + i * 32 + 2 * rp + e; const float* rowp = d.src + (size_t)k * d.ldsrc;
            if (contig) v[i][e] = *(const f32x4*)(rowp + sc[0]);
            else { v[i][e][0] = sc[0] >= 0 ? rowp[sc[0]] : 0.f; v[i][e][1] = sc[1] >= 0 ? rowp[sc[1]] : 0.f; v[i][e][2] = sc[2] >= 0 ? rowp[sc[2]] : 0.f; v[i][e][3] = sc[3] >= 0 ? rowp[sc[3]] : 0.f; }
            gn[i][e] = (d.gain && k >= d.gmin) ? d.gain[k - d.gmin] : 1.f; }
}
__device__ __forceinline__ void conv_store(const ConvDesc& d, int tid, const f32x4 (&v)[4][2], const float (&gn)[4][2], LAS unsigned* T) {
    constexpr int SD = 65; const int c4 = tid & 31, rp = tid >> 5;
#pragma unroll
    for (int i = 0; i < 4; ++i)
#pragma unroll
        for (int j = 0; j < 4; ++j) T[(c4 + 32 * j) * SD + i * 16 + rp] = pk2(v[i][0][j] * gn[i][0], v[i][1][j] * gn[i][1]);
    __syncthreads();
#pragma unroll
    for (int i = 0; i < 4; ++i) { const int n = i * 32 + (tid >> 4), kc = tid & 15; const LAS unsigned* p = T + n * SD + kc * 4; u32x4 o; o.x = p[0]; o.y = p[1]; o.z = p[2]; o.w = p[3];
        *(u32x4*)(d.dst + (size_t)(d.n0 + 4 * (n & 31) + (n >> 5)) * d.K + d.k0 + kc * 8) = o; }
    __syncthreads();
}
__device__ __forceinline__ void conv_layer(const Args& a, int l, LAS unsigned char* lds, unsigned* ctr) {
    int tid_o = threadIdx.x; asm volatile("" : "+v"(tid_o)); const int tid = tid_o;
    LAS unsigned* T = (LAS unsigned*)lds; volatile LAS unsigned* slot = (volatile LAS unsigned*)(lds + 131072 + 128);
    int stat = (int)blockIdx.x - (int)gridDim.x;
    unsigned pend = 0u;
#define CONV_ISSUE() do { if (ctr && tid == 0) pend = __hip_atomic_fetch_add(ctr, 1u, __ATOMIC_RELAXED, __HIP_MEMORY_SCOPE_AGENT); } while (0)
#define CONV_NEXT(r) do { if (ctr) { sl ^= 1; if (tid == 0) slot[sl] = pend; __syncthreads(); r = (int)slot[sl]; } else { stat += (int)gridDim.x; r = stat; } } while (0)
    int sl = 0;
    __syncthreads();
    f32x4 vA[4][2], vB[4][2], vC[4][2]; float gA[4][2], gB[4][2], gC[4][2]; ConvDesc d0, d1, d2; int r0, r1, r2;
    CONV_ISSUE(); CONV_NEXT(r0); CONV_ISSUE(); if (r0 < I_LAYER) { d0 = conv_decode(a, l, r0); conv_load(d0, tid, vA, gA); }
    CONV_NEXT(r1); CONV_ISSUE(); if (r1 < I_LAYER) { d1 = conv_decode(a, l, r1); conv_load(d1, tid, vB, gB); }
    for (;;) {
        if (r0 >= I_LAYER) break;
        CONV_NEXT(r2); CONV_ISSUE(); if (r2 < I_LAYER) { d2 = conv_decode(a, l, r2); conv_load(d2, tid, vC, gC); }
        conv_store(d0, tid, vA, gA, T);
        if (r1 >= I_LAYER) break;
        CONV_NEXT(r0); CONV_ISSUE(); if (r0 < I_LAYER) { d0 = conv_decode(a, l, r0); conv_load(d0, tid, vA, gA); }
        conv_store(d1, tid, vB, gB, T);
        if (r2 >= I_LAYER) break;
        CONV_NEXT(r1); CONV_ISSUE(); if (r1 < I_LAYER) { d1 = conv_decode(a, l, r1); conv_load(d1, tid, vB, gB); }
        conv_store(d2, tid, vC, gC, T);
    }
#undef CONV_NEXT
#undef CONV_ISSUE
}
__device__ __forceinline__ void p0_prologue(const Args& a, LAS unsigned char* lds) {
    int tid_o = threadIdx.x; asm volatile("" : "+v"(tid_o)); const int tid = tid_o, lane = tid & 63, wave = tid >> 6, G = gridDim.x;
    const int gw = blockIdx.x * NWAVES + wave, NGW = G * NWAVES;
    conv_layer(a, 0, lds, nullptr);
    float* ct = (float*)(a.ws + WS_COS); float* st = (float*)(a.ws + WS_SIN);
    for (int i = blockIdx.x * NTHR + tid; i < MT * 32; i += G * NTHR) { const int row = i >> 5, j = i & 31;
        const float inv = (float)exp(-((double)(2 * j) / 64.0) * 9.210340371976184);
        const float ang = (float)a.pos[row] * inv;
        double rev = (double)ang * 0.15915494309189535; rev -= rint(rev); const float rf = (float)rev;
        ct[i] = __builtin_amdgcn_cosf(rf); st[i] = __builtin_amdgcn_sinf(rf); }
    bf16* xb = (bf16*)(a.ws + WS_XB); float* rstd = (float*)(a.ws + WS_RSTD);
    for (int row = gw; row < MT; row += NGW) { const f32x4* xr = (const f32x4*)(a.x + (size_t)row * DM); u32x2* ob = (u32x2*)(xb + (size_t)row * DM); float ss = 0.f;
#pragma unroll
        for (int j = 0; j < 8; ++j) { const f32x4 v = xr[j * 64 + lane]; ss += (v[0] * v[0] + v[1] * v[1]) + (v[2] * v[2] + v[3] * v[3]); u32x2 o; o.x = pk2(v[0], v[1]); o.y = pk2(v[2], v[3]); ob[j * 64 + lane] = o; }
        ss = wave_sum(ss);
        if (lane == 0) rstd[row] = 1.f / sqrtf(ss * (1.f / DM) + EPS); }
}
__device__ __forceinline__ void rowpass(const float* xin, float* xout, const bf16* mb, const float* ps, const float* gain, bf16* xb, float* rstd) {
    int tid_o = threadIdx.x; asm volatile("" : "+v"(tid_o)); const int tid = tid_o, lane = tid & 63, wave = tid >> 6; const int gw = blockIdx.x * NWAVES + wave, NGW = gridDim.x * NWAVES;
    for (int row = gw; row < MT; row += NGW) { const f32x4* xr = (const f32x4*)(xin + (size_t)row * DM); f32x4* xo = (f32x4*)(xout + (size_t)row * DM);
        const u32x2* mr = (const u32x2*)(mb + (size_t)row * DM); u32x2* ob = (u32x2*)(xb + (size_t)row * DM); const f32x4* gr = (const f32x4*)gain;
        f32x4 xv[8]; u32x2 mv[8];
#pragma unroll
        for (int j = 0; j < 8; ++j) { xv[j] = xr[j * 64 + lane]; mv[j] = mr[j * 64 + lane]; }
        const float r = 1.f / sqrtf(wave_sum(lane < 32 ? ps[(size_t)row * 32 + lane] : 0.f) * (1.f / DM) + EPS); float ss = 0.f;
#pragma unroll
        for (int j = 0; j < 8; ++j) { const int i = j * 64 + lane; f32x4 v = xv[j]; const u32x2 mm = mv[j]; const f32x4 g = gr[i];
            v[0] += __builtin_bit_cast(float, mm.x << 16) * r * g[0]; v[1] += __builtin_bit_cast(float, mm.x & 0xffff0000u) * r * g[1];
            v[2] += __builtin_bit_cast(float, mm.y << 16) * r * g[2]; v[3] += __builtin_bit_cast(float, mm.y & 0xffff0000u) * r * g[3];
            xv[j] = v; ss += (v[0] * v[0] + v[1] * v[1]) + (v[2] * v[2] + v[3] * v[3]); }
#pragma unroll
        for (int j = 0; j < 8; ++j) { const int i = j * 64 + lane; xo[i] = xv[j]; u32x2 o; o.x = pk2(xv[j][0], xv[j][1]); o.y = pk2(xv[j][2], xv[j][3]); ob[i] = o; }
        ss = wave_sum(ss);
        if (lane == 0) rstd[row] = 1.f / sqrtf(ss * (1.f / DM) + EPS); }
}
__device__ __forceinline__ f32x16 mfma32(bf16x8 a, bf16x8 b, f32x16 c) { return __builtin_amdgcn_mfma_f32_32x32x16_bf16(a, b, c, 0, 0, 0); }
template <int KD> __device__ __forceinline__ f32x16 mm32(const LAS bf16* A, int lda, const LAS bf16* B, int ldb, int ql, int g, f32x16 acc) {
#pragma unroll
    for (int s = 0; s < KD / 16; ++s) { const bf16x8 a = *(const LAS bf16x8*)(A + ql * lda + 16 * s + 8 * g), b = *(const LAS bf16x8*)(B + ql * ldb + 16 * s + 8 * g); acc = mfma32(a, b, acc); }
    return acc;
}
constexpr f32x16 Z16 = {0.f, 0.f, 0.f, 0.f, 0.f, 0.f, 0.f, 0.f, 0.f, 0.f, 0.f, 0.f, 0.f, 0.f, 0.f, 0.f};
template <int TYPE> __device__ __forceinline__ void gla_local_item(const Args& a, LAS unsigned char* lds, int layer, int bh, int c) {
    constexpr int DK = TYPE ? 128 : 64, QS = DK + 8, TS = 72, NTG = NTHR / DK, RPT = 64 / NTG;
    LAS bf16* qh = (LAS bf16*)lds; LAS bf16* kh = qh + 64 * QS; LAS bf16* ktT = kh + 64 * QS; LAS bf16* vT = ktT + DK * TS; LAS bf16* Ab = vT + 128 * TS; LAS float* bc = (LAS float*)(Ab + 64 * TS);
    int tid_o = threadIdx.x; asm volatile("" : "+v"(tid_o)); const int tid = tid_o, lane = tid & 63, wave = tid >> 6, ql = lane & 31, g = lane >> 5;
    const int b = bh >> 2, h = bh & 3, t0 = b * SEQ + c * 64;
    const bf16* prow = (const bf16*)(a.ws + WS_PROJ) + (size_t)t0 * NIN;
    const int d = tid % DK, tg = tid / DK;
    float lbv = 0.f;
    bf16 rq[RPT], rk[RPT], rv[16];
#pragma unroll
    for (int tt = 0; tt < RPT; ++tt) { const int t = tg * RPT + tt; rq[tt] = prow[(size_t)t * NIN + (TYPE ? C_HQ : C_GQ) + h * DK + d]; rk[tt] = prow[(size_t)t * NIN + (TYPE ? C_HF : C_GK) + h * DK + d]; }
    { const int e = tid & 127, tq = tid >> 7; const int vcol = (TYPE ? C_HI : C_GV) + h * 128 + e;
#pragma unroll
      for (int i = 0; i < 16; ++i) rv[i] = prow[(size_t)(tq * 16 + i) * NIN + vcol]; }
    {
        float run = 0.f;
        if (TYPE == 0) {
            float w2c[16]; const float* w2 = a.gate_w2 + (size_t)layer * 16 * 256 + h * 64 + d;
#pragma unroll
            for (int r = 0; r < 16; ++r) w2c[r] = w2[r * 256];
            const float bias = a.gate_b[layer * 256 + h * 64 + d];
            bf16x8 rg0[RPT], rg1[RPT];
#pragma unroll
            for (int tt = 0; tt < RPT; ++tt) { const bf16x8* gl = (const bf16x8*)(prow + (size_t)(tg * RPT + tt) * NIN + C_GLOW); rg0[tt] = gl[0]; rg1[tt] = gl[1]; }
#pragma unroll
            for (int tt = 0; tt < RPT; ++tt) { const int t = tg * RPT + tt; const bf16x8 g0 = rg0[tt], g1 = rg1[tt]; float z = bias;
#pragma unroll
                for (int r = 0; r < 8; ++r) { z += bf2f((bf16)g0[r]) * w2c[r]; z += bf2f((bf16)g1[r]) * w2c[8 + r]; }
                const float lg = (fminf(z, 0.f) - __logf(1.f + __expf(-fabsf(z)))) * (1.f / 16.f);
                run += lg; bc[t * DK + d] = run; }
        } else {
            const float* lg4 = a.lb_logits + h * 128 + d; const float l0 = lg4[0], l1 = lg4[512], l2 = lg4[1024], l3 = lg4[1536];
            const float mx = fmaxf(fmaxf(l0, l1), fmaxf(l2, l3)); const float e0 = __expf(l0 - mx), e1 = __expf(l1 - mx), e2 = __expf(l2 - mx), e3 = __expf(l3 - mx); const float inv = 1.f / (e0 + e1 + e2 + e3);
            lbv = (layer >= 1 ? e1 : 0.f) + (layer >= 2 ? e2 : 0.f) + (layer >= 3 ? e3 : 0.f); lbv *= inv;
#pragma unroll
            for (int tt = 0; tt < RPT; ++tt) { const int t = tg * RPT + tt; const float hf = bf2f(rk[tt]);
                const float sg = 1.f / (1.f + __expf(-hf)); const float f = lbv + (1.f - lbv) * sg;
                run += __logf(f); bc[t * DK + d] = run; }
        }
    }
    __syncthreads();
    { float off = 0.f; for (int s = 0; s < tg; ++s) off += bc[(s * RPT + RPT - 1) * DK + d];
      __syncthreads();
      if (tg > 0) for (int tt = 0; tt < RPT; ++tt) bc[(tg * RPT + tt) * DK + d] += off; }
    __syncthreads();
    {
        const float bmid = bc[32 * DK + d], blast = bc[63 * DK + d]; const float scale = TYPE ? 1.f : 0.125f;
        bf16* qe = (bf16*)(a.ws + (TYPE ? WS_QE_H : WS_QE_G));
#pragma unroll
        for (int tt = 0; tt < RPT; ++tt) { const int t = tg * RPT + tt; const float bb = bc[t * DK + d]; float q = bf2f(rq[tt]), k = bf2f(rk[tt]);
            if (TYPE == 1) { const float hq = q, hf = k; q = hq / (1.f + __expf(-hq)); k = (1.f - lbv) / (1.f + __expf(hf)); }
            q *= scale;
            qh[t * QS + d] = (bf16)f2bf(q * __expf(bb - bmid)); kh[t * QS + d] = (bf16)f2bf(k * __expf(bmid - bb));
            ktT[d * TS + t] = (bf16)f2bf(k * __expf(blast - bb));
            qe[(size_t)(t0 + t) * (4 * DK) + h * DK + d] = (bf16)f2bf(q * __expf(bb)); }
        if (tg == 0) ((float*)(a.ws + (TYPE ? WS_DL_H : WS_DL_G)))[(bh * 64 + c) * DK + d] = __expf(blast);
        const int e = tid & 127, tq = tid >> 7;
#pragma unroll
        for (int i = 0; i < 16; ++i) vT[e * TS + tq * 16 + i] = rv[i];
    }
    __syncthreads();
    if (wave < 4) {
        const int jb = wave & 1, ib = wave >> 1; f32x16 acc = Z16;
        if (!(jb == 1 && ib == 0)) acc = mm32<DK>(kh + 32 * jb * QS, QS, qh + 32 * ib * QS, QS, ql, g, acc);
        const int i = 32 * ib + ql;
#pragma unroll
        for (int rg = 0; rg < 4; ++rg) { const int j0 = 32 * jb + 8 * rg + 4 * g; float v[4];
#pragma unroll
            for (int e = 0; e < 4; ++e) v[e] = (j0 + e <= i) ? acc[4 * rg + e] : 0.f;
            u32x2 o; o.x = pk2(v[0], v[1]); o.y = pk2(v[2], v[3]); *(LAS u32x2*)(Ab + i * TS + j0) = o; }
    }
    __syncthreads();
    {
        const int eb = wave & 3, ib = wave >> 2; f32x16 acc = mm32<64>(vT + 32 * eb * TS, TS, Ab + 32 * ib * TS, TS, ql, g, Z16);
        float* oi = (float*)(a.ws + WS_OI) + (size_t)TYPE * MT * 512 + (size_t)(t0 + 32 * ib + ql) * 512 + h * 128 + 32 * eb + 4 * g;
#pragma unroll
        for (int rg = 0; rg < 4; ++rg) { f32x4 o = {acc[4 * rg], acc[4 * rg + 1], acc[4 * rg + 2], acc[4 * rg + 3]}; *(f32x4*)(oi + 8 * rg) = o; }
    }
    {
        float* ut = (float*)(a.ws + (TYPE ? WS_UT_H : WS_UT_G)) + (size_t)(bh * 64 + c) * 128 * DK;
#pragma unroll
        for (int bi = 0; bi < DK / 64; ++bi) { const int blk = wave + 8 * bi, eb = blk & 3, db = blk >> 2;
            f32x16 acc = mm32<64>(ktT + 32 * db * TS, TS, vT + 32 * eb * TS, TS, ql, g, Z16);
            float* up = ut + (size_t)(32 * eb + ql) * DK + 32 * db + 4 * g;
#pragma unroll
            for (int rg = 0; rg < 4; ++rg) { f32x4 o = {acc[4 * rg], acc[4 * rg + 1], acc[4 * rg + 2], acc[4 * rg + 3]}; *(f32x4*)(up + 8 * rg) = o; } }
    }
    __syncthreads();
}
__device__ __forceinline__ void scan_item(const Args& a, int si) {
    int tid_o = threadIdx.x; asm volatile("" : "+v"(tid_o)); const int tid = tid_o; const bool hg = si >= 32; const int DK = hg ? 128 : 64; const int idx = (hg ? si - 32 : si) * NTHR + tid;
    const int per_bh = 128 * DK / 4; const int bh = idx / per_bh, rem = idx % per_bh, e = rem / (DK / 4), d = 4 * (rem % (DK / 4));
    const float* ut = (const float*)(a.ws + (hg ? WS_UT_H : WS_UT_G)) + (size_t)bh * 64 * 128 * DK + (size_t)e * DK + d;
    bf16* sp = (bf16*)(a.ws + (hg ? WS_SP_H : WS_SP_G)) + (size_t)bh * 64 * 128 * DK + (size_t)e * DK + d;
    const float* dl = (const float*)(a.ws + (hg ? WS_DL_H : WS_DL_G)) + (size_t)bh * 64 * DK + d;
    f32x4 S = {0.f, 0.f, 0.f, 0.f}; const size_t cs = (size_t)128 * DK;
    for (int cb = 0; cb < 64; cb += 16) {
        f32x4 u[16], dd[16];
#pragma unroll
        for (int i = 0; i < 16; ++i) { u[i] = __builtin_nontemporal_load((const f32x4*)(ut + (size_t)(cb + i) * cs)); dd[i] = *(const f32x4*)(dl + (cb + i) * DK); }
#pragma unroll
        for (int i = 0; i < 16; ++i) { u32x2 o; o.x = pk2(S[0], S[1]); o.y = pk2(S[2], S[3]); *(u32x2*)(sp + (size_t)(cb + i) * cs) = o; S = dd[i] * S + u[i]; }
    }
}
__device__ __forceinline__ void gla_final_item(const Args& a, int layer, int item) {
    const int type = item >> 7, bh = (item >> 4) & 7, cg4 = item & 15; const int DK = type ? 128 : 64;
    int tid_o = threadIdx.x; asm volatile("" : "+v"(tid_o)); const int tid = tid_o, lane = tid & 63, wave = tid >> 6, ql = lane & 31, g = lane >> 5;
    const int b = bh >> 2, h = bh & 3, c = cg4 * 4 + (wave >> 1), t = b * SEQ + c * 64 + (wave & 1) * 32 + ql;
    const float* oi = (const float*)(a.ws + WS_OI) + (size_t)type * MT * 512 + (size_t)t * 512 + h * 128 + 4 * g;
    f32x16 acc[4];
#pragma unroll
    for (int eb = 0; eb < 4; ++eb)
#pragma unroll
        for (int rg = 0; rg < 4; ++rg) { const f32x4 v = *(const f32x4*)(oi + 32 * eb + 8 * rg); acc[eb][4 * rg] = v[0]; acc[eb][4 * rg + 1] = v[1]; acc[eb][4 * rg + 2] = v[2]; acc[eb][4 * rg + 3] = v[3]; }
    const bf16* qe = (const bf16*)(a.ws + (type ? WS_QE_H : WS_QE_G)) + (size_t)t * (4 * DK) + h * DK + 8 * g;
    const bf16* sp = (const bf16*)(a.ws + (type ? WS_SP_H : WS_SP_G)) + ((size_t)(bh * 64 + c) * 128 + ql) * DK + 8 * g;
    for (int s = 0; s < DK / 16; ++s) { const bf16x8 bq = *(const bf16x8*)(qe + 16 * s);
#pragma unroll
        for (int eb = 0; eb < 4; ++eb) { const bf16x8 as = *(const bf16x8*)(sp + (size_t)32 * eb * DK + 16 * s); acc[eb] = mfma32(as, bq, acc[eb]); } }
    float ss = 0.f;
#pragma unroll
    for (int eb = 0; eb < 4; ++eb)
#pragma unroll
        for (int r = 0; r < 16; ++r) ss += acc[eb][r] * acc[eb][r];
    ss += __shfl_xor(ss, 32);
    const float rstd = 1.f / sqrtf(ss * (1.f / 128.f) + EPS);
    const float* gn = (type ? a.hgrn_norm : a.gla_norm) + layer * 128 + 4 * g;
    const bf16* gt = (const bf16*)(a.ws + WS_PROJ) + (size_t)t * NIN + (type ? C_HO : C_GO) + h * 128 + 4 * g;
    bf16* y = (bf16*)(a.ws + WS_Y) + (size_t)t * DM + type * 512 + h * 128 + 4 * g;
    u32x2 gbv[16]; f32x4 gvv[16];
#pragma unroll
    for (int i = 0; i < 16; ++i) { const int eo = 32 * (i >> 2) + 8 * (i & 3); gbv[i] = *(const u32x2*)(gt + eo); gvv[i] = *(const f32x4*)(gn + eo); }
#pragma unroll
    for (int eb = 0; eb < 4; ++eb)
#pragma unroll
        for (int rg = 0; rg < 4; ++rg) { const int eo = 32 * eb + 8 * rg; const f32x4 gv = gvv[4 * eb + rg]; const u32x2 gb = gbv[4 * eb + rg];
            const float g0 = __builtin_bit_cast(float, gb.x << 16), g1 = __builtin_bit_cast(float, gb.x & 0xffff0000u), g2 = __builtin_bit_cast(float, gb.y << 16), g3 = __builtin_bit_cast(float, gb.y & 0xffff0000u);
            const float o0 = acc[eb][4 * rg] * rstd * gv[0] * g0 / (1.f + __expf(-g0)), o1 = acc[eb][4 * rg + 1] * rstd * gv[1] * g1 / (1.f + __expf(-g1));
            const float o2 = acc[eb][4 * rg + 2] * rstd * gv[2] * g2 / (1.f + __expf(-g2)), o3 = acc[eb][4 * rg + 3] * rstd * gv[3] * g3 / (1.f + __expf(-g3));
            u32x2 o; o.x = pk2(o0, o1); o.y = pk2(o2, o3); *(u32x2*)(y + eo) = o; }
}
__device__ __forceinline__ void kpe_rope(const Args& a) {
    const bf16* proj = (const bf16*)(a.ws + WS_PROJ); bf16* kpe = (bf16*)(a.ws + WS_KPE); const float* ct = (const float*)(a.ws + WS_COS); const float* st = (const float*)(a.ws + WS_SIN);
    int tid_o = threadIdx.x; asm volatile("" : "+v"(tid_o));
    for (int i = blockIdx.x * NTHR + tid_o; i < MT * 32; i += gridDim.x * NTHR) { const int row = i >> 5, j = i & 31;
        const float x1 = bf2f(proj[(size_t)row * NIN + C_KPE + j]), x2 = bf2f(proj[(size_t)row * NIN + C_KPE + 32 + j]); const float c = ct[i], s = st[i];
        *(unsigned*)(kpe + (size_t)row * 64 + 2 * j) = pk2(x1 * c - x2 * s, x2 * c + x1 * s); }
}
__device__ __forceinline__ void mla_out_norm(const Args& a) {
    bf16* y = (bf16*)(a.ws + WS_Y); const float* ssq = (const float*)(a.ws + WS_PS_O);
    int tid_o = threadIdx.x; asm volatile("" : "+v"(tid_o));
    const int i0 = blockIdx.x * NTHR + tid_o, stride = gridDim.x * NTHR;
    for (int ib = i0; ib < MT * 128; ib += 8 * stride) {
        u32x4 v[8]; f32x4 s0[8], s1[8];
#pragma unroll
        for (int k = 0; k < 8; ++k) { const int i = ib + k * stride; if (i < MT * 128) { const int row = i >> 7, cc = i & 127; v[k] = *(const u32x4*)(y + (size_t)row * DM + 1024 + cc * 8); s0[k] = *(const f32x4*)(ssq + (size_t)row * 8); s1[k] = *(const f32x4*)(ssq + (size_t)row * 8 + 4); } }
#pragma unroll
        for (int k = 0; k < 8; ++k) { const int i = ib + k * stride; if (i < MT * 128) { const int row = i >> 7, cc = i & 127;
            const float r = 1.f / sqrtf((((s0[k][0] + s0[k][1]) + (s0[k][2] + s0[k][3])) + ((s1[k][0] + s1[k][1]) + (s1[k][2] + s1[k][3]))) * (1.f / 1024.f) + EPS); u32x4 w = v[k];
#pragma unroll
            for (int e = 0; e < 4; ++e) { const float lo = __builtin_bit_cast(float, w[e] << 16) * r, hi = __builtin_bit_cast(float, w[e] & 0xffff0000u) * r; w[e] = pk2(lo, hi); }
            *(u32x4*)(y + (size_t)row * DM + 1024 + cc * 8) = w; } }
    }
}
constexpr int KSTR = 400, VSTR = 136, KBYTES = 64 * KSTR, VBYTES = 128 * VSTR, OSTR = 272;
__device__ __forceinline__ void attn_item(const Args& a, LAS unsigned char* lds, int b, int h, int qb, int t0, int t1, int part) {
    int tid_o = threadIdx.x; asm volatile("" : "+v"(tid_o)); const int tid = tid_o, lane = tid & 63, wave = tid >> 6, ql = lane & 31, g = lane >> 5;
    const bf16* Q = (const bf16*)(a.ws + WS_Q); const bf16* KN = (const bf16*)(a.ws + WS_KN); const bf16* KP = (const bf16*)(a.ws + WS_KPE); const bf16* VT = (const bf16*)(a.ws + WS_VT);
    const int tq0 = b * SEQ + qb * 256 + wave * 32, qpos = qb * 256 + wave * 32 + ql;
    bf16x8 qf[12];
    { const bf16* qp = Q + (size_t)(tq0 + ql) * 1536 + h * 192 + 8 * g;
#pragma unroll
      for (int s = 0; s < 12; ++s) qf[s] = *(const bf16x8*)(qp + 16 * s); }
    f32x16 oacc[4] = {Z16, Z16, Z16, Z16}; float mrun = 0.f, lrun = 0.f;
    const int nt = 4 * (qb + 1);
    int ksrc_off[3]; int kdst[3]; bool kpe_sel[3]; int vsrc_off[2]; int vdst[2];
#pragma unroll
    for (int i = 0; i < 3; ++i) { const int cid = tid + NTHR * i, key = cid / 24, cc = cid % 24; kpe_sel[i] = cc >= 16; kdst[i] = key * KSTR + cc * 16;
        ksrc_off[i] = kpe_sel[i] ? key * 64 + (cc - 16) * 8 : key * 1024 + h * 128 + cc * 8; }
#pragma unroll
    for (int i = 0; i < 2; ++i) { const int cid = tid + NTHR * i, row = cid >> 3, cc = cid & 7; vdst[i] = row * VSTR + cc * 16; vsrc_off[i] = (h * 128 + row) * MT + cc * 8; }
    u32x4 sk[3], sv[2];
#define ATT_GLOAD(t) do { const size_t tk = (size_t)(b * SEQ + (t) * 64); _Pragma("unroll") for (int i = 0; i < 3; ++i) sk[i] = kpe_sel[i] ? *(const u32x4*)(KP + tk * 64 + ksrc_off[i]) : *(const u32x4*)(KN + tk * 1024 + ksrc_off[i]); \
        _Pragma("unroll") for (int i = 0; i < 2; ++i) sv[i] = *(const u32x4*)(VT + (size_t)vsrc_off[i] + tk); } while (0)
#define ATT_LSTORE(kbuf, vbuf) do { LAS unsigned char* kb_ = lds + (kbuf) * KBYTES; LAS unsigned char* vb_ = lds + 2 * KBYTES + (vbuf) * VBYTES; \
        _Pragma("unroll") for (int i = 0; i < 3; ++i) *(LAS u32x4*)(kb_ + kdst[i]) = sk[i]; _Pragma("unroll") for (int i = 0; i < 2; ++i) { *(LAS u32x2*)(vb_ + vdst[i]) = (u32x2){sv[i].x, sv[i].y}; *(LAS u32x2*)(vb_ + vdst[i] + 8) = (u32x2){sv[i].z, sv[i].w}; } } while (0)
#define ATT_QK(kb_) do { const LAS unsigned char* kp = (kb_) + ql * KSTR + 16 * g; { const float ci = -mrun; _Pragma("unroll") for (int r = 0; r < 16; ++r) { p0[r] = ci; p1[r] = ci; } } \
        _Pragma("unroll") for (int s = 0; s < 12; ++s) { const bf16x8 k0 = *(const LAS bf16x8*)(kp + 32 * s), k1 = *(const LAS bf16x8*)(kp + 32 * KSTR + 32 * s); p0 = mfma32(k0, qf[s], p0); p1 = mfma32(k1, qf[s], p1); } } while (0)
#define ATT_SM() do { \
        if (t >= nt - 4) { const int kb0 = t * 64 + 4 * g; const float NEG = -__builtin_inff(); \
            _Pragma("unroll") for (int r = 0; r < 16; ++r) { const int kk = kb0 + (r & 3) + 8 * (r >> 2); if (kk > qpos) p0[r] = NEG; if (kk + 32 > qpos) p1[r] = NEG; } } \
        float mx = fmaxf(fmaxf(p0[0], p0[1]), p0[2]); \
        _Pragma("unroll") for (int r = 3; r < 15; r += 2) mx = fmaxf(fmaxf(mx, p0[r]), p0[r + 1]); \
        mx = fmaxf(fmaxf(mx, p0[15]), p1[0]); \
        _Pragma("unroll") for (int r = 1; r < 15; r += 2) mx = fmaxf(fmaxf(mx, p1[r]), p1[r + 1]); \
        mx = fmaxf(mx, p1[15]); \
        mx = fmaxf(mx, __shfl_xor(mx, 32)); \
          \
        { const bool first = (t == t0); \
          if (first || __builtin_amdgcn_ballot_w64(mx > 8.f) != 0ull) { \
            const float d = first ? mx : fmaxf(mx, 0.f); mrun += d; \
            _Pragma("unroll") for (int r = 0; r < 16; ++r) { p0[r] -= d; p1[r] -= d; } \
            if (!first) { const float alpha = __builtin_amdgcn_exp2f(-d); lrun *= alpha; \
                _Pragma("unroll") for (int db = 0; db < 4; ++db) oacc[db] = oacc[db] * alpha; } } } \
        float rs = 0.f; \
        _Pragma("unroll") for (int r = 0; r < 16; ++r) { p0[r] = __builtin_amdgcn_exp2f(p0[r]); p1[r] = __builtin_amdgcn_exp2f(p1[r]); rs += p0[r] + p1[r]; } \
        lrun += rs; \
        { u32x4 w; \
          w.x = pk2(p0[0], p0[1]); w.y = pk2(p0[2], p0[3]); w.z = pk2(p0[4], p0[5]); w.w = pk2(p0[6], p0[7]); pf[0] = __builtin_bit_cast(bf16x8, w); \
          w.x = pk2(p0[8], p0[9]); w.y = pk2(p0[10], p0[11]); w.z = pk2(p0[12], p0[13]); w.w = pk2(p0[14], p0[15]); pf[1] = __builtin_bit_cast(bf16x8, w); \
          w.x = pk2(p1[0], p1[1]); w.y = pk2(p1[2], p1[3]); w.z = pk2(p1[4], p1[5]); w.w = pk2(p1[6], p1[7]); pf[2] = __builtin_bit_cast(bf16x8, w); \
          w.x = pk2(p1[8], p1[9]); w.y = pk2(p1[10], p1[11]); w.z = pk2(p1[12], p1[13]); w.w = pk2(p1[14], p1[15]); pf[3] = __builtin_bit_cast(bf16x8, w); } } while (0)
#define ATT_PV(vb_) do { _Pragma("unroll") for (int db = 0; db < 4; ++db) { const LAS unsigned char* vp = (vb_) + (32 * db + ql) * VSTR + 8 * g; \
        _Pragma("unroll") for (int sl = 0; sl < 4; ++sl) { const u32x2 lo = *(const LAS u32x2*)(vp + 32 * sl), hi = *(const LAS u32x2*)(vp + 32 * sl + 16); const u32x4 w = {lo.x, lo.y, hi.x, hi.y}; \
            oacc[db] = mfma32(__builtin_bit_cast(bf16x8, w), pf[sl], oacc[db]); } } } while (0)
    const int wv = __builtin_amdgcn_readfirstlane(tid >> 6);
    f32x16 p0, p1; bf16x8 pf[4];
    __syncthreads();
    ATT_GLOAD(t0); ATT_LSTORE(0, 0);
    __syncthreads();
    const LAS unsigned char* vring = lds + 2 * KBYTES;
    if (wv < 4) {
        int vs = 0;
        for (int t = t0; t < t1; ++t) {
            if (t + 1 < t1) ATT_GLOAD(t + 1);
            const int bsel = (t - t0) & 1; const int vnext = vs == 2 ? 0 : vs + 1;
            ATT_QK(lds + bsel * KBYTES); ATT_SM(); ATT_PV(vring + vs * VBYTES);
            if (t + 1 < t1) ATT_LSTORE(bsel ^ 1, vnext);
            vs = vnext;
            __syncthreads();
        }
    } else {
        int vs = 0;
        for (int t = t0; t < t1; ++t) {
            const int bsel = (t - t0) & 1; const int vprev = vs == 0 ? 2 : vs - 1, vnext = vs == 2 ? 0 : vs + 1;
            if (t > t0) ATT_PV(vring + vprev * VBYTES);
            if (t + 1 < t1) ATT_GLOAD(t + 1);
            ATT_QK(lds + bsel * KBYTES); ATT_SM();
            if (t + 1 < t1) ATT_LSTORE(bsel ^ 1, vnext);
            vs = vnext;
            __syncthreads();
        }
        { const int vlast = vs == 0 ? 2 : vs - 1; ATT_PV(vring + vlast * VBYTES); }
    }
    __syncthreads();
#undef ATT_QK
#undef ATT_SM
#undef ATT_PV
#undef ATT_GLOAD
#undef ATT_LSTORE
    const float lt = lrun + __shfl_xor(lrun, 32), inv = 1.f / lt;
    LAS unsigned char* ob = lds + wave * (32 * OSTR);
#pragma unroll
    for (int db = 0; db < 4; ++db)
#pragma unroll
        for (int rg = 0; rg < 4; ++rg) { const float o0 = oacc[db][4 * rg] * inv, o1 = oacc[db][4 * rg + 1] * inv, o2 = oacc[db][4 * rg + 2] * inv, o3 = oacc[db][4 * rg + 3] * inv;
            u32x2 o; o.x = pk2(o0, o1); o.y = pk2(o2, o3); *(LAS u32x2*)(ob + ql * OSTR + (32 * db + 8 * rg + 4 * g) * 2) = o; }
    LDS_WAIT(); asm volatile("" ::: "memory");
    bf16* dst; int pitch;
    if (part < 0) { dst = (bf16*)(a.ws + WS_Y) + (size_t)tq0 * DM + 1024 + h * 128; pitch = DM; }
    else { const size_t rec = ((size_t)((part * 16 + b * 8 + h) * 8 + (qb - 8)) * 256 + wave * 32); dst = (bf16*)(a.ws + WS_MB) + rec * 128; pitch = 128;
        if (g == 0) { float* ml = (float*)(a.ws + WS_ML) + (rec + ql) * 2; ml[0] = mrun; ml[1] = lt; } }
#pragma unroll
    for (int i = 0; i < 8; ++i) { const int cid = lane + 64 * i, row = cid >> 4, cc = cid & 15; const u32x4 v = *(const LAS u32x4*)(ob + row * OSTR + cc * 16);
        *(u32x4*)(dst + (size_t)row * pitch + cc * 8) = v; }
}
__device__ __forceinline__ void attn_queue(const Args& a, LAS unsigned char* lds, unsigned* ctr) {
    int tid_o = threadIdx.x; asm volatile("" : "+v"(tid_o)); const int tid = tid_o; const int grp = (int)((unsigned)__builtin_amdgcn_s_getreg((3 << 11) | 20) & 7u);
    volatile LAS unsigned* slot = (volatile LAS unsigned*)(lds + 131072 + 160);
    for (;;) {
        if (tid == 0) *slot = __hip_atomic_fetch_add(ctr + grp, 1u, __ATOMIC_RELAXED, __HIP_MEMORY_SCOPE_AGENT);
        __syncthreads();
        const int idx = (int)*slot;
        if (idx >= 48) break;
        const int bh = 2 * grp + (idx >= 24 ? 1 : 0), k = idx >= 24 ? idx - 24 : idx; int qb, part;
        if (k < 20) { const int j = k / 5, r = k % 5; if (r == 0) { qb = 7 - j; part = -1; } else if (r < 3) { qb = 15 - 2 * j; part = r - 1; } else { qb = 14 - 2 * j; part = r - 3; } }
        else { qb = 23 - k; part = -1; }
        const int nt = 4 * (qb + 1);
        attn_item(a, lds, bh >> 3, bh & 7, qb, part == 1 ? nt / 2 : 0, part == 0 ? nt / 2 : nt, part);
    }
}
__device__ __forceinline__ void mla_finish(const Args& a) {
    int tid_o = threadIdx.x; asm volatile("" : "+v"(tid_o)); const int tid = tid_o, lane = tid & 63, wave = tid >> 6; const int gw = blockIdx.x * NWAVES + wave, NGW = gridDim.x * NWAVES;
    bf16* y = (bf16*)(a.ws + WS_Y); const bf16* po = (const bf16*)(a.ws + WS_MB); const float* ml = (const float*)(a.ws + WS_ML);
    for (int row = gw; row < MT; row += NGW) { const int b = row >> 12, pos = row & 4095, qb = pos >> 8, r = pos & 255; float o0[8], o1[8];
        if (qb < 8) {
#pragma unroll
            for (int h = 0; h < 8; ++h) { const unsigned u = *(const unsigned*)(y + (size_t)row * DM + 1024 + h * 128 + 2 * lane); o0[h] = __builtin_bit_cast(float, u << 16); o1[h] = __builtin_bit_cast(float, u & 0xffff0000u); }
        } else {
            unsigned ua[8], ub[8]; float ma[8], la[8], mb_[8], lb_[8];
#pragma unroll
            for (int h = 0; h < 8; ++h) { const size_t ra = (size_t)((0 * 16 + b * 8 + h) * 8 + (qb - 8)) * 256 + r, rb = (size_t)((1 * 16 + b * 8 + h) * 8 + (qb - 8)) * 256 + r;
                ua[h] = *(const unsigned*)(po + ra * 128 + 2 * lane); ub[h] = *(const unsigned*)(po + rb * 128 + 2 * lane);
                ma[h] = ml[ra * 2]; la[h] = ml[ra * 2 + 1]; mb_[h] = ml[rb * 2]; lb_[h] = ml[rb * 2 + 1]; }
#pragma unroll
            for (int h = 0; h < 8; ++h) { const float m = fmaxf(ma[h], mb_[h]); const float wa = la[h] * __builtin_amdgcn_exp2f(ma[h] - m), wb = lb_[h] * __builtin_amdgcn_exp2f(mb_[h] - m), iw = 1.f / (wa + wb);
                o0[h] = (wa * __builtin_bit_cast(float, ua[h] << 16) + wb * __builtin_bit_cast(float, ub[h] << 16)) * iw;
                o1[h] = (wa * __builtin_bit_cast(float, ua[h] & 0xffff0000u) + wb * __builtin_bit_cast(float, ub[h] & 0xffff0000u)) * iw; }
        }
        float ss = 0.f;
#pragma unroll
        for (int h = 0; h < 8; ++h) ss += o0[h] * o0[h] + o1[h] * o1[h];
        ss = wave_sum(ss); const float rs = 1.f / sqrtf(ss * (1.f / 1024.f) + EPS);
#pragma unroll
        for (int h = 0; h < 8; ++h) *(unsigned*)(y + (size_t)row * DM + 1024 + h * 128 + 2 * lane) = pk2(o0[h] * rs, o1[h] * rs);
    }
}
#define XB_TMO      128
#define XB_XCNT(j)  (256  + 64 * (j))
#define XB_XSUB(j)  (1280 + 64 * (j))
#define XB_XGEN(j)  (2304 + 64 * (j))
#define XB_TOP      3328
#define XB_TOPGEN   3392
#define XCD_BAR_WORDS 3456
#define XB_SPIN_CAP (1u << 18)

__device__ __forceinline__ unsigned xb_ld(unsigned* p)              { return __hip_atomic_load(p, __ATOMIC_RELAXED, __HIP_MEMORY_SCOPE_AGENT); }
__device__ __forceinline__ unsigned xb_add(unsigned* p, unsigned v) { return __hip_atomic_fetch_add(p, v, __ATOMIC_RELAXED, __HIP_MEMORY_SCOPE_AGENT); }
__device__ __forceinline__ unsigned xb_xcc_id() { return (unsigned)__builtin_amdgcn_s_getreg((3 << 11) | 20) & 0xFu; }
#define XB_SPIN(cond, bar) do { unsigned _sp = 0; while (cond) { __builtin_amdgcn_s_sleep(1); \
    if ((++_sp & 255u) == 0u) { if (xb_ld(&(bar)[XB_TMO])) break; if (_sp > XB_SPIN_CAP) { atomicAdd(&(bar)[XB_TMO], 1u); break; } } } } while (0)

struct XcdBarrier {
    unsigned* bar; unsigned x;
    volatile LAS unsigned* st;
};

__device__ __forceinline__ XcdBarrier xcd_barrier_post(unsigned* bar, volatile LAS unsigned* st) {
    XcdBarrier b; b.bar = bar; b.x = xb_xcc_id(); b.st = st;
    if (threadIdx.x == 0) (void)xb_add(&bar[XB_XCNT(b.x)], 1u);
    return b;
}
__device__ __forceinline__ void xcd_barrier_complete(unsigned* bar, unsigned x, unsigned& nloc, unsigned& nx) {
    const unsigned G = gridDim.x * gridDim.y * gridDim.z;
    unsigned sum, cnt, mine, sp = 0u;
    for (;;) {
        sum = 0u; cnt = 0u; mine = 0u;
#pragma unroll
        for (unsigned j = 0; j < 16; ++j) { const unsigned c = xb_ld(&bar[XB_XCNT(j)]); sum += c; cnt += (c > 0u) ? 1u : 0u; mine = (j == x) ? c : mine; }
        if (sum == G) break;
        __builtin_amdgcn_s_sleep(1);
        if ((++sp & 255u) == 0u) { if (xb_ld(&bar[XB_TMO])) break; if (sp > XB_SPIN_CAP) { atomicAdd(&bar[XB_TMO], 1u); break; } }
    }
    nloc = mine > 0u ? mine : 1u; nx = cnt > 0u ? cnt : 1u;
}

__device__ __forceinline__ void xcd_barrier(const XcdBarrier& b) {
    asm volatile("s_waitcnt vmcnt(0)" ::: "memory");
    __syncthreads();
    if (threadIdx.x == 0) {
        unsigned* bar = b.bar;
        __builtin_amdgcn_s_waitcnt(0);
        unsigned nloc = b.st[0], nx = b.st[1];
        if (nloc == 0u) { xcd_barrier_complete(bar, b.x, nloc, nx); b.st[0] = nloc; b.st[1] = nx; }
        const unsigned old = xb_add(&bar[XB_XSUB(b.x)], 1u);
        const unsigned gen = old / nloc;
        if (old + 1u == (gen + 1u) * nloc) {
            __builtin_amdgcn_fence(__ATOMIC_RELEASE, "agent");
            asm volatile("s_waitcnt vmcnt(0)" ::: "memory");
            const unsigned og = xb_add(&bar[XB_TOP], 1u);
            const unsigned tg = og / nx;
            if (og + 1u == (tg + 1u) * nx) xb_add(&bar[XB_TOPGEN], 1u);
            else XB_SPIN(xb_ld(&bar[XB_TOPGEN]) == tg, bar);
            __builtin_amdgcn_fence(__ATOMIC_ACQUIRE, "agent");
            xb_add(&bar[XB_XGEN(b.x)], 1u);
            asm volatile("s_waitcnt vmcnt(0)" ::: "memory");
        } else {
            XB_SPIN(xb_ld(&bar[XB_XGEN(b.x)]) == gen, bar);
            __builtin_amdgcn_fence(__ATOMIC_ACQUIRE, "agent");
            asm volatile("s_waitcnt vmcnt(0)" ::: "memory");
        }
    }
    __syncthreads();
}


constexpr int N_PHASES = 1 + 9 * DEPTH;
#ifndef DBG_REP
#define DBG_REP 0
#endif
#define NREP(j) (1 + ((DBG_REP >> (j)) & 1))
#ifndef DBG_MASK
#define DBG_MASK 0x3ff
#endif
#define EN(j) ((DBG_MASK >> (j)) & 1)
__device__ __forceinline__ const Args* args_here() { const Args* p = (const Args*)__builtin_amdgcn_kernarg_segment_ptr(); asm volatile("" : "+s"(p)); return p; }
#define PH_ARGS Args a = a_in; { unsigned char* w_ = a.ws; asm volatile("" : "+s"(w_)); a.ws = w_; } unsigned char* const ws = a.ws; (void)ws
__global__ void __launch_bounds__(NTHR, 2) mega_fwd(Args a_in) {
    extern __shared__ __attribute__((aligned(16))) unsigned char lds_raw[];
    LAS unsigned char* lds = (LAS unsigned char*)lds_raw;
    cg::grid_group grid = cg::this_grid();
    volatile LAS unsigned* bst = (volatile LAS unsigned*)(lds + 131072 + 64);
    if (threadIdx.x < 2) bst[threadIdx.x] = 0u;
    __syncthreads();
    XcdBarrier bar = xcd_barrier_post((unsigned*)(a_in.ws + WS_BAR), bst);
    const int G = gridDim.x, bid = blockIdx.x;
    const int lo = a_in.ph_lo, hi = a_in.ph_hi;
#define IN(k) (lo <= (k) && (k) < hi)
#define SEAM(k) do { if (IN((k) + 1)) { if ((k) == 0) grid.sync(); else { XcdBarrier b2 = bar; asm volatile("" : "+s"(b2.bar)); xcd_barrier(b2); } } } while (0)
    if (IN(0) && EN(0)) for (int rep = 0; rep < NREP(0); ++rep) { PH_ARGS; p0_prologue(a, lds); SEAM(0); }
    for (int l = 0; l < DEPTH; ++l) {
        const int P = 1 + 9 * l;
        if (IN(P) && EN(1)) for (int rep = 0; rep < NREP(1); ++rep) {
            PH_ARGS; const bf16* wl = (const bf16*)(ws + WS_W) + (size_t)l * W_LAYER;
            pg8::Gemm gm{(const bf16*)(ws + WS_XB), wl + W_IN, MT, NIN, DM, DM, DM}; pg8::StaticOrder S; S.init(MT, NIN, G, bid);
            pg8::EpiRow E{(bf16*)(ws + WS_PROJ), NIN, (const float*)(ws + WS_RSTD), 0, 0, 0.f, EPS, (float*)(ws + WS_PS_QKV), 16, 14, 18};
            pg8::gemm_phase<pg8::EpiRow, pg8::StaticOrder, true, true>(lds, gm, S, E); SEAM(P); }
        if (IN(P + 1) && EN(2)) for (int rep = 0; rep < NREP(2); ++rep) {
#define P1_ARGS PH_ARGS; const bf16* wl = (const bf16*)(ws + WS_W) + (size_t)l * W_LAYER; const bf16* proj = (const bf16*)(ws + WS_PROJ); float* ps_qkv = (float*)(ws + WS_PS_QKV); (void)wl; (void)proj; (void)ps_qkv
            { P1_ARGS; pg8::Gemm gm{proj + C_QC, wl + W_Q, MT, 1536, 512, NIN, 512}; pg8::StaticOrder S; S.init(MT, 1536, G, bid);
              pg8::EpiQ E{(bf16*)(ws + WS_Q), ps_qkv, EPS, QSCALE, (const float*)(ws + WS_COS), (const float*)(ws + WS_SIN)};
              pg8::gemm_phase<pg8::EpiQ, pg8::StaticOrder, true, true>(lds, gm, S, E); }
            { P1_ARGS; pg8::Gemm gm{proj + C_KVC, wl + W_K, MT, 1024, 512, NIN, 512}; pg8::StaticOrder S; S.init(MT, 1024, G, (bid + 64) % G);
              pg8::EpiRow E{(bf16*)(ws + WS_KN), 1024, ps_qkv + 8, 16, 8, 1.f / 512.f, EPS, nullptr, 0, 0, 0};
              pg8::gemm_phase<pg8::EpiRow, pg8::StaticOrder, true, true>(lds, gm, S, E); }
            { P1_ARGS; pg8::Gemm gm{wl + W_V, proj + C_KVC, 1024, MT, 512, 512, NIN}; pg8::StaticOrder S; S.init(1024, MT, G, (bid + 192) % G);
              pg8::EpiVT E{(bf16*)(ws + WS_VT), MT, ps_qkv, EPS};
              pg8::gemm_phase<pg8::EpiVT, pg8::StaticOrder, true, true>(lds, gm, S, E); }
            { PH_ARGS; kpe_rope(a); }
            __syncthreads();
            PH_ARGS;
            for (int it = bid; it < 1024; it += G) { if (it < 512) gla_local_item<0>(a, lds, l, it >> 6, it & 63); else gla_local_item<1>(a, lds, l, (it - 512) >> 6, it & 63); }
            SEAM(P + 1); }
        if (IN(P + 2) && EN(3)) for (int rep = 0; rep < NREP(3); ++rep) {
            PH_ARGS;
            for (int it = bid; it < 96; it += G) scan_item(a, it);
            attn_queue(a, lds, (unsigned*)(ws + WS_BAR) + 8 + 8 * l);
            if (l + 1 < DEPTH && rep == 0) conv_layer(a, l + 1, lds, (unsigned*)(ws + WS_BAR) + l);
            SEAM(P + 2); }
        if (IN(P + 3) && EN(4)) for (int rep = 0; rep < NREP(4); ++rep) {
            PH_ARGS;
            for (int it = bid; it < 256; it += G) gla_final_item(a, l, it);
            if (rep + 1 == NREP(4)) mla_finish(a);
            SEAM(P + 3); }
        if (IN(P + 4) && EN(5)) for (int rep = 0; rep < NREP(5); ++rep) {
            PH_ARGS; const bf16* wl = (const bf16*)(ws + WS_W) + (size_t)l * W_LAYER;
            pg8::Gemm gm{(const bf16*)(ws + WS_Y), wl + W_OUT, MT, DM, DM, DM, DM}; pg8::StaticOrder S; S.init(MT, DM, G, bid);
            pg8::EpiRow E{(bf16*)(ws + WS_MB), DM, nullptr, 0, 0, 0.f, EPS, (float*)(ws + WS_PS_M), 32, 0, 8};
            pg8::gemm_phase<pg8::EpiRow, pg8::StaticOrder, true, true>(lds, gm, S, E); SEAM(P + 4); }
        if (IN(P + 5) && EN(6)) { PH_ARGS; rowpass(l == 0 ? a.x : a.out, a.out, (const bf16*)(ws + WS_MB), (const float*)(ws + WS_PS_M), a.attn_post + l * DM, (bf16*)(ws + WS_XB), (float*)(ws + WS_RSTD)); SEAM(P + 5); }
        if (IN(P + 6) && EN(7)) for (int rep = 0; rep < NREP(7); ++rep) {
            PH_ARGS; const bf16* wl = (const bf16*)(ws + WS_W) + (size_t)l * W_LAYER;
            pg8::Gemm gm{(const bf16*)(ws + WS_XB), wl + W_GU, MT, NGU, DM, DM, DM}; pg8::StaticOrder S; S.init(MT, NGU, G, bid);
            pg8::EpiGU E{(bf16*)(ws + WS_HDN), DFF, (const float*)(ws + WS_RSTD)};
            pg8::gemm_phase<pg8::EpiGU, pg8::StaticOrder, true, true>(lds, gm, S, E); SEAM(P + 6); }
        if (IN(P + 7) && EN(8)) for (int rep = 0; rep < NREP(8); ++rep) {
            PH_ARGS; const bf16* wl = (const bf16*)(ws + WS_W) + (size_t)l * W_LAYER;
            pg8::Gemm gm{(const bf16*)(ws + WS_HDN), wl + W_DN, MT, DM, DFF, DFF, DFF}; pg8::StaticOrder S; S.init(MT, DM, G, bid);
            pg8::EpiRow E{(bf16*)(ws + WS_MB), DM, nullptr, 0, 0, 0.f, EPS, (float*)(ws + WS_PS_M), 32, 0, 8};
            pg8::gemm_phase<pg8::EpiRow, pg8::StaticOrder, true, true>(lds, gm, S, E); SEAM(P + 7); }
        if (IN(P + 8) && EN(9)) { PH_ARGS; rowpass(a.out, a.out, (const bf16*)(ws + WS_MB), (const float*)(ws + WS_PS_M), a.ffn_post + l * DM, (bf16*)(ws + WS_XB), (float*)(ws + WS_RSTD)); if (l + 1 < DEPTH) SEAM(P + 8); }
    }
#undef IN
#undef SEAM
}

extern "C" void kernel_launch(void* const* d_in, const int* in_sizes, int n_in, void* d_out, int out_size, void* d_ws, size_t ws_size, hipStream_t stream) {
    static int grid = 0;
    if (grid == 0) {
        if (n_in != 21 || in_sizes[0] != MT * DM || out_size != MT * DM || ws_size < WS_END) { fprintf(stderr, "kernel_launch: unexpected shapes (n_in %d, in0 %d, out %d, ws %zu, need %zu)\n", n_in, n_in > 0 ? in_sizes[0] : -1, out_size, ws_size, (size_t)WS_END); grid = -1; return; }
        int dev = 0, cus = 0, per_cu = 0;
        hipGetDevice(&dev); hipDeviceGetAttribute(&cus, hipDeviceAttributeMultiprocessorCount, dev);
        if (hipFuncSetAttribute((const void*)mega_fwd, hipFuncAttributeMaxDynamicSharedMemorySize, LDS_BYTES) != hipSuccess) { fprintf(stderr, "kernel_launch: hipFuncSetAttribute failed\n"); grid = -1; return; }
        if (hipOccupancyMaxActiveBlocksPerMultiprocessor(&per_cu, (const void*)mega_fwd, NTHR, LDS_BYTES) != hipSuccess || per_cu < 1) { fprintf(stderr, "kernel_launch: occupancy query says %d blocks per CU\n", per_cu); (void)hipGetLastError(); per_cu = 1; }
        grid = cus > 0 ? cus : 256;
    }
    if (grid < 0) return;
    Args a{};
    a.x = (const float*)d_in[0]; a.pos = (const int*)d_in[1]; a.attn_pre = (const float*)d_in[2]; a.w_in = (const float*)d_in[3]; a.gate_w2 = (const float*)d_in[4]; a.gate_b = (const float*)d_in[5];
    a.gla_norm = (const float*)d_in[6]; a.lb_logits = (const float*)d_in[7]; a.hgrn_norm = (const float*)d_in[8]; a.q_norm = (const float*)d_in[9]; a.wq_b = (const float*)d_in[10]; a.kv_norm = (const float*)d_in[11];
    a.wkv_b = (const float*)d_in[12]; a.mla_out_norm = (const float*)d_in[13]; a.w_out = (const float*)d_in[14]; a.attn_post = (const float*)d_in[15]; a.ffn_pre = (const float*)d_in[16];
    a.w_gate = (const float*)d_in[17]; a.w_up = (const float*)d_in[18]; a.w_down = (const float*)d_in[19]; a.ffn_post = (const float*)d_in[20]; a.out = (float*)d_out; a.ws = (unsigned char*)d_ws;
    if (hipMemsetAsync((char*)d_ws + WS_BAR, 0, BAR_BYTES, stream) != hipSuccess) { fprintf(stderr, "kernel_launch: memset failed\n"); return; }
#if MK_PER_PHASE
    for (int p = 0; p < N_PHASES; ++p) { a.ph_lo = p; a.ph_hi = p + 1; hipLaunchKernelGGL(mega_fwd, dim3(grid), dim3(NTHR), LDS_BYTES, stream, a); }
#else
    a.ph_lo = 0; a.ph_hi = N_PHASES; void* args[] = {&a};
    hipError_t e = hipLaunchCooperativeKernel((const void*)mega_fwd, dim3(grid), dim3(NTHR), args, LDS_BYTES, stream);
    if (e != hipSuccess) fprintf(stderr, "kernel_launch: cooperative launch failed: %s (grid %d)\n", hipGetErrorString(e), grid);
#endif
}
```

```cpp
#include <hip/hip_runtime.h>
#include <hip/hip_cooperative_groups.h>
#include <cstdio>
#include <cstdint>
namespace cg = cooperative_groups;
#ifndef MK_PER_PHASE
#define MK_PER_PHASE 0
#endif
namespace pg8 {
#define PG8_LAS __attribute__((address_space(3)))
typedef unsigned short bf16_t;
typedef short bf16x8 __attribute__((ext_vector_type(8)));
typedef float f32x4 __attribute__((ext_vector_type(4)));
typedef unsigned u32x4 __attribute__((ext_vector_type(4)));
constexpr int BM = 256, BK = 64, HALF = 128, HTB = HALF * BK * 2  , STAGE_BYTES = 8 * HTB, NXCD = 8, WGM = 8;

__host__ __device__ __forceinline__ int lds_byte(int r, int c) { const int st = (r >> 4) * 2 + (c >> 5), rr = r & 15, cc = c & 31, ob = rr * 64 + cc * 2; return st * 1024 + (ob ^ (((ob >> 9) & 1) << 5)); }
__host__ __device__ __forceinline__ void stage_rc(int b, int& R, int& C) { const int st = b / 1024, sb = b % 1024, swz = sb ^ (((sb >> 9) & 1) << 5); R = (st >> 1) * 16 + swz / 64; C = (st & 1) * 32 + (swz % 64) / 2; }
__host__ __device__ __forceinline__ int perm32(int rho) { const int n = rho >> 4, i = rho & 15; return 8 * (i >> 2) + 4 * n + (i & 3); }

struct Unit { int pm, pn; };
struct Gemm { const bf16_t* A; const bf16_t* Bt; int M, N, K, lda, ldb; };

struct StaticOrder {
    int nM, nN, nwg, G, c;
    __host__ __device__ void init(int M, int N, int G_, int c_) { nM = M / BM; nN = N / BM; nwg = nM * nN; G = G_; c = c_; }
    __host__ __device__ bool next(int i, Unit& u) const {
        const long L = (long)i * G + c; if (L >= nwg) return false;
        int wgid = (int)L; { const int q = nwg / NXCD, r = nwg % NXCD, xcd = wgid % NXCD, off = wgid / NXCD; wgid = (xcd < r ? xcd * (q + 1) : r * (q + 1) + (xcd - r) * q) + off; }
        const int nig = WGM * nN, gid = wgid / nig, fm = gid * WGM, gsz = (nM - fm) < WGM ? (nM - fm) : WGM;
        u.pm = fm + ((wgid % nig) % gsz); u.pn = (wgid % nig) / gsz; return true;
    }
    __device__ __forceinline__ void a_ready(const Unit&) const {}
    __device__ __forceinline__ void done(const Unit&) const {}
};

__device__ __forceinline__ unsigned cvt_pk_bf16(float lo, float hi) { unsigned r; asm volatile("v_cvt_pk_bf16_f32 %0, %1, %2" : "=v"(r) : "v"(lo), "v"(hi)); return r; }
typedef float f32x2 __attribute__((ext_vector_type(2)));
#define PG8_GAS __attribute__((address_space(1)))
__device__ __forceinline__ float quad_col_sum(float v) { v += __shfl_xor(v, 16); v += __shfl_xor(v, 32); return v; }
struct EpiRow {
    static constexpr bool PERM = true, AFTER_DRAIN = false;
    bf16_t* O; int ldc; const float* rs; int rs_ld, rs_n; float rs_mul; float eps;
    float* ps; int ps_ld, pn_lo, pn_hi;
    __device__ __forceinline__ void operator()(const f32x4 (&acc)[2][2][4][2], const Unit& u, int wr, int wc, int fr, int fq) const {
        const int row0 = u.pm * BM + wr * 64 + fr, col0 = u.pn * BM + wc * 32 + 8 * fq;
        float* sq = (ps && u.pn >= pn_lo && u.pn < pn_hi) ? ps + (u.pn - pn_lo) * 4 + wc : nullptr;
        float scv[2][4];
#pragma unroll
        for (int ai = 0; ai < 2; ++ai)
#pragma unroll
            for (int m = 0; m < 4; ++m) { const int row = row0 + ai * HALF + m * 16;
                float sc = 1.f; if (rs) { if (rs_n == 0) sc = *(const PG8_GAS float*)(rs + row); else { float t = 0.f; for (int i = 0; i < rs_n; i += 4) { const f32x4 q = *(const PG8_GAS f32x4*)(rs + (size_t)row * rs_ld + i); t += (q[0] + q[1]) + (q[2] + q[3]); } sc = __builtin_amdgcn_rsqf(t * rs_mul + eps); } }
                scv[ai][m] = sc; }
#pragma unroll
        for (int ai = 0; ai < 2; ++ai)
#pragma unroll
            for (int m = 0; m < 4; ++m) { const int row = row0 + ai * HALF + m * 16; bf16_t* rowp = O + (size_t)row * ldc + col0;
                const float sc = scv[ai][m];
                float ss = 0.f;
#pragma unroll
                for (int bj = 0; bj < 2; ++bj) { f32x4 v0 = acc[ai][bj][m][0] * sc, v1 = acc[ai][bj][m][1] * sc;
                    ss += (v0[0] * v0[0] + v0[1] * v0[1]) + (v0[2] * v0[2] + v0[3] * v0[3]) + (v1[0] * v1[0] + v1[1] * v1[1]) + (v1[2] * v1[2] + v1[3] * v1[3]);
                    u32x4 w; w.x = cvt_pk_bf16(v0[0], v0[1]); w.y = cvt_pk_bf16(v0[2], v0[3]); w.z = cvt_pk_bf16(v1[0], v1[1]); w.w = cvt_pk_bf16(v1[2], v1[3]);
                    *(PG8_GAS u32x4*)(rowp + bj * HALF) = w; }
                if (sq) { ss = quad_col_sum(ss); if (fq == 0) *(PG8_GAS float*)(sq + (size_t)row * ps_ld) = ss; } }
    }
};
struct EpiQ {
    static constexpr bool PERM = true, AFTER_DRAIN = false;
    bf16_t* O; const float* ssq; float eps; float qscale; const float* ctab; const float* stab;
    __device__ __forceinline__ void operator()(const f32x4 (&acc)[2][2][4][2], const Unit& u, int wr, int wc, int fr, int fq) const {
        const int row0 = u.pm * BM + wr * 64 + fr; const bool rope = u.pn >= 4;
        float scv[2][4];
#pragma unroll
        for (int ai = 0; ai < 2; ++ai)
#pragma unroll
            for (int m = 0; m < 4; ++m) { const int row = row0 + ai * HALF + m * 16; const f32x4 s0 = *(const PG8_GAS f32x4*)(ssq + (size_t)row * 16), s1 = *(const PG8_GAS f32x4*)(ssq + (size_t)row * 16 + 4);
                scv[ai][m] = __builtin_amdgcn_rsqf((((s0[0] + s0[1]) + (s0[2] + s0[3])) + ((s1[0] + s1[1]) + (s1[2] + s1[3]))) * (1.f / 512.f) + eps) * qscale; }
#pragma unroll
        for (int ai = 0; ai < 2; ++ai)
#pragma unroll
            for (int m = 0; m < 4; ++m) { const int row = row0 + ai * HALF + m * 16; const float sc = scv[ai][m];
#pragma unroll
                for (int bj = 0; bj < 2; ++bj) { f32x4 v0 = acc[ai][bj][m][0] * sc, v1 = acc[ai][bj][m][1] * sc; int dst;
                    if (!rope) { const int c = u.pn * BM + bj * HALF + wc * 32 + 8 * fq; dst = (c >> 7) * 192 + (c & 127); }
                    else { const int c = (u.pn - 4) * BM + bj * HALF + wc * 32 + 8 * fq; const int hh = c >> 6, j = c & 63; dst = hh * 192 + 128 + j;
                        const f32x4 cs = *(const PG8_GAS f32x4*)(ctab + (size_t)row * 32 + (j >> 1)), sn = *(const PG8_GAS f32x4*)(stab + (size_t)row * 32 + (j >> 1));
                        f32x4 a0, a1; a0[0] = v0[0] * cs[0] - v0[1] * sn[0]; a0[1] = v0[1] * cs[0] + v0[0] * sn[0]; a0[2] = v0[2] * cs[1] - v0[3] * sn[1]; a0[3] = v0[3] * cs[1] + v0[2] * sn[1];
                        a1[0] = v1[0] * cs[2] - v1[1] * sn[2]; a1[1] = v1[1] * cs[2] + v1[0] * sn[2]; a1[2] = v1[2] * cs[3] - v1[3] * sn[3]; a1[3] = v1[3] * cs[3] + v1[2] * sn[3]; v0 = a0; v1 = a1; }
                    u32x4 w; w.x = cvt_pk_bf16(v0[0], v0[1]); w.y = cvt_pk_bf16(v0[2], v0[3]); w.z = cvt_pk_bf16(v1[0], v1[1]); w.w = cvt_pk_bf16(v1[2], v1[3]);
                    *(PG8_GAS u32x4*)(O + (size_t)row * 1536 + dst) = w; } }
    }
};
struct EpiVT {
    static constexpr bool PERM = true, AFTER_DRAIN = false;
    bf16_t* O; int ldc; const float* ssq; float eps;
    __device__ __forceinline__ void operator()(const f32x4 (&acc)[2][2][4][2], const Unit& u, int wr, int wc, int fr, int fq) const {
        const int row0 = u.pm * BM + wr * 64 + fr, col0 = u.pn * BM + wc * 32 + 8 * fq;
        f32x4 s[2][2];
#pragma unroll
        for (int bj = 0; bj < 2; ++bj)
#pragma unroll
            for (int n = 0; n < 2; ++n)
#pragma unroll
                for (int e = 0; e < 4; ++e) { const float* p = ssq + (size_t)(col0 + bj * HALF + 4 * n + e) * 16 + 8; const f32x4 s0 = *(const PG8_GAS f32x4*)p, s1 = *(const PG8_GAS f32x4*)(p + 4);
                    s[bj][n][e] = __builtin_amdgcn_rsqf((((s0[0] + s0[1]) + (s0[2] + s0[3])) + ((s1[0] + s1[1]) + (s1[2] + s1[3]))) * (1.f / 512.f) + eps); }
#pragma unroll
        for (int ai = 0; ai < 2; ++ai)
#pragma unroll
            for (int m = 0; m < 4; ++m) { bf16_t* rowp = O + (size_t)(row0 + ai * HALF + m * 16) * ldc + col0;
#pragma unroll
                for (int bj = 0; bj < 2; ++bj) { const f32x4 v0 = acc[ai][bj][m][0] * s[bj][0], v1 = acc[ai][bj][m][1] * s[bj][1];
                    u32x4 w; w.x = cvt_pk_bf16(v0[0], v0[1]); w.y = cvt_pk_bf16(v0[2], v0[3]); w.z = cvt_pk_bf16(v1[0], v1[1]); w.w = cvt_pk_bf16(v1[2], v1[3]);
                    *(PG8_GAS u32x4*)(rowp + bj * HALF) = w; } }
    }
};
struct EpiGU {
    static constexpr bool PERM = true, AFTER_DRAIN = false;
    bf16_t* O; int ldc; const float* rs;
    __device__ __forceinline__ void operator()(const f32x4 (&acc)[2][2][4][2], const Unit& u, int wr, int wc, int fr, int fq) const {
        const int row0 = u.pm * BM + wr * 64 + fr, col0 = u.pn * HALF + wc * 32 + 8 * fq;
        float scv[2][4];
#pragma unroll
        for (int ai = 0; ai < 2; ++ai)
#pragma unroll
            for (int m = 0; m < 4; ++m) scv[ai][m] = *(const PG8_GAS float*)(rs + row0 + ai * HALF + m * 16);
#pragma unroll
        for (int ai = 0; ai < 2; ++ai)
#pragma unroll
            for (int m = 0; m < 4; ++m) { const int row = row0 + ai * HALF + m * 16; const float sc = scv[ai][m]; float o[8];
#pragma unroll
                for (int n = 0; n < 2; ++n)
#pragma unroll
                    for (int e = 0; e < 4; ++e) { const float gv = acc[ai][0][m][n][e] * sc, uv = acc[ai][1][m][n][e] * sc;
                        o[4 * n + e] = gv * __builtin_amdgcn_rcpf(1.f + __expf(-gv)) * uv; }
                u32x4 w; w.x = cvt_pk_bf16(o[0], o[1]); w.y = cvt_pk_bf16(o[2], o[3]); w.z = cvt_pk_bf16(o[4], o[5]); w.w = cvt_pk_bf16(o[6], o[7]);
                *(PG8_GAS u32x4*)(O + (size_t)row * ldc + col0) = w; }
    }
};
template <class Epi, class Sched, bool ALIGN_EPI = false, bool SP2 = false>
__device__ __forceinline__ void gemm_phase(PG8_LAS unsigned char* lds, const Gemm g, const Sched& S, const Epi& E) {
    int tid_o = threadIdx.x; asm volatile("" : "+v"(tid_o)); const int tid = tid_o, wid = __builtin_amdgcn_readfirstlane(tid >> 6), lane = tid & 63, wr = wid >> 2, wc = wid & 3, fr = lane & 15, fq = lane >> 4;
    const int K = g.K, nt = K / BK;
    unsigned voffA[2], voffB[2];
#pragma unroll
    for (int i = 0; i < 2; ++i) { int R, C; stage_rc(tid * 16 + i * 8192, R, C); const int Rb = Epi::PERM ? ((R & ~31) + perm32(R & 31)) : R;
        voffA[i] = (unsigned)(R * g.lda + C) * 2u; voffB[i] = (unsigned)(Rb * g.ldb + C) * 2u; }
    const size_t kstep = (size_t)(BK * 2);
    const size_t hstepA = (size_t)HALF * g.lda * 2, hstepB = (size_t)HALF * g.ldb * 2;
    const size_t tstepA = 2 * hstepA, tstepB = 2 * hstepB;
    const unsigned ldsw = (unsigned)wid * 1024u;
    const int aoff = lds_byte(wr * 64 + fr, fq * 8), boff = lds_byte(wc * 32 + fr, fq * 8);
#define PG8_SA(b, h) (((b) * 2 + (h)) * HTB)
#define PG8_SB(b, h) ((4 + (b) * 2 + (h)) * HTB)
#define PG8_STAGE(bufoff, gbase, voff) do { _Pragma("unroll") for (int _i = 0; _i < 2; ++_i) \
        __builtin_amdgcn_global_load_lds((const unsigned*)((const char*)(gbase) + (voff)[_i]), (PG8_LAS unsigned*)(lds + (bufoff) + ldsw + _i * 8192), 16, 0, 0); } while (0)
#define PG8_LDA(dst, b, h) do { _Pragma("unroll") for (int m = 0; m < 4; ++m) _Pragma("unroll") for (int k = 0; k < 2; ++k) dst[m][k] = *(const PG8_LAS bf16x8*)(lds + PG8_SA(b, h) + aoff + m * 2048 + k * 1024); } while (0)
#define PG8_LDB(dst, b, h) do { _Pragma("unroll") for (int n = 0; n < 2; ++n) _Pragma("unroll") for (int k = 0; k < 2; ++k) dst[n][k] = *(const PG8_LAS bf16x8*)(lds + PG8_SB(b, h) + boff + n * 2048 + k * 1024); } while (0)
#define PG8_MMA(ai, bj, At, Bt) do { __builtin_amdgcn_s_setprio(1); _Pragma("unroll") for (int m = 0; m < 4; ++m) _Pragma("unroll") for (int n = 0; n < 2; ++n) _Pragma("unroll") for (int k = 0; k < 2; ++k) \
        acc[ai][bj][m][n] = __builtin_amdgcn_mfma_f32_16x16x32_bf16(Bt[n][k], At[m][k], acc[ai][bj][m][n], 0, 0, 0); __builtin_amdgcn_s_setprio(0); } while (0)
#define PG8_WAIT_V(n) asm volatile("s_waitcnt vmcnt(" #n ")" ::: "memory")
#define PG8_WAIT_L(n) asm volatile("s_waitcnt lgkmcnt(" #n ")" ::: "memory")
#define PG8_BAR __builtin_amdgcn_s_barrier()
#define PG8_SCHED __builtin_amdgcn_sched_barrier(0)
    Unit cur, nxt; int ui = 0;
    if (!S.next(0, cur)) return;
    f32x4 acc[2][2][4][2];
#pragma unroll
    for (int a = 0; a < 2; ++a)
#pragma unroll
        for (int b = 0; b < 2; ++b)
#pragma unroll
            for (int m = 0; m < 4; ++m)
#pragma unroll
                for (int n = 0; n < 2; ++n) acc[a][b][m][n] = (f32x4){0.f, 0.f, 0.f, 0.f};
    bf16x8 At[4][2], B0[2][2], B1[2][2];
    const char* cA = (const char*)g.A + (size_t)cur.pm * tstepA; const char* cB = (const char*)g.Bt + (size_t)cur.pn * tstepB;
    S.a_ready(cur);
    if constexpr (SP2) {
        PG8_STAGE(PG8_SB(0, 0), cB, voffB); PG8_STAGE(PG8_SB(0, 1), cB + hstepB, voffB); PG8_STAGE(PG8_SA(0, 0), cA, voffA); PG8_STAGE(PG8_SA(0, 1), cA + hstepA, voffA);
        if (wr == 1) PG8_BAR;
        PG8_WAIT_V(2); PG8_BAR;
        PG8_STAGE(PG8_SB(1, 0), cB + kstep, voffB); PG8_STAGE(PG8_SA(1, 0), cA + kstep, voffA); PG8_STAGE(PG8_SB(1, 1), cB + hstepB + kstep, voffB);
        PG8_WAIT_V(6); PG8_BAR;
    } else {
        PG8_STAGE(PG8_SB(0, 0), cB, voffB); PG8_STAGE(PG8_SA(0, 0), cA, voffA); PG8_STAGE(PG8_SB(0, 1), cB + hstepB, voffB); PG8_STAGE(PG8_SA(0, 1), cA + hstepA, voffA);
        if (wr == 1) PG8_BAR;
        PG8_WAIT_V(4); PG8_BAR;
        PG8_STAGE(PG8_SB(1, 0), cB + kstep, voffB); PG8_STAGE(PG8_SA(1, 0), cA + kstep, voffA); PG8_STAGE(PG8_SB(1, 1), cB + hstepB + kstep, voffB);
        PG8_WAIT_V(6); PG8_BAR;
    }
    for (;;) {
        const bool has_next = S.next(ui + 1, nxt);
        const char* nA = has_next ? (const char*)g.A + (size_t)nxt.pm * tstepA : cA; const char* nB = has_next ? (const char*)g.Bt + (size_t)nxt.pn * tstepB : cB;
        for (int t = 0; t < nt; t += 2) {
            const bool last = (t == nt - 2);
            const char* a1 = cA + (size_t)(t + 1) * kstep;
            const char* a2 = last ? nA : cA + (size_t)(t + 2) * kstep; const char* b2 = last ? nB : cB + (size_t)(t + 2) * kstep;
            const char* a3 = a2 + kstep; const char* b3 = b2 + kstep;
            if (last && has_next) S.a_ready(nxt);
            if constexpr (SP2) {
            PG8_LDB(B0, 0, 0); PG8_LDB(B1, 0, 1); PG8_SCHED; PG8_LDA(At, 0, 0); PG8_STAGE(PG8_SA(1, 1), a1 + hstepA, voffA);
            PG8_WAIT_V(8); PG8_WAIT_L(0); PG8_BAR; PG8_MMA(0, 0, At, B0); PG8_MMA(0, 1, At, B1); PG8_BAR; PG8_SCHED;
            PG8_LDA(At, 0, 1); PG8_STAGE(PG8_SB(0, 0), b2, voffB); PG8_STAGE(PG8_SB(0, 1), b2 + hstepB, voffB); PG8_STAGE(PG8_SA(0, 0), a2, voffA);
            PG8_WAIT_V(8); PG8_WAIT_L(0); PG8_BAR; PG8_MMA(1, 0, At, B0); PG8_MMA(1, 1, At, B1); PG8_BAR; PG8_SCHED;
            PG8_LDB(B0, 1, 0); PG8_LDB(B1, 1, 1); PG8_SCHED; PG8_LDA(At, 1, 0); PG8_STAGE(PG8_SA(0, 1), a2 + hstepA, voffA);
            PG8_WAIT_V(8); PG8_WAIT_L(0); PG8_BAR; PG8_MMA(0, 0, At, B0); PG8_MMA(0, 1, At, B1); PG8_BAR; PG8_SCHED;
            PG8_LDA(At, 1, 1); PG8_STAGE(PG8_SB(1, 0), b3, voffB); PG8_STAGE(PG8_SB(1, 1), b3 + hstepB, voffB); PG8_STAGE(PG8_SA(1, 0), a3, voffA);
            PG8_WAIT_V(8); PG8_WAIT_L(0); PG8_BAR; PG8_MMA(1, 0, At, B0); PG8_MMA(1, 1, At, B1); PG8_BAR; PG8_SCHED;
            } else {
            PG8_LDB(B0, 0, 0); PG8_SCHED; PG8_LDA(At, 0, 0); PG8_STAGE(PG8_SA(1, 1), a1 + hstepA, voffA);
            PG8_WAIT_L(8); PG8_BAR; PG8_WAIT_L(0); PG8_MMA(0, 0, At, B0); PG8_BAR; PG8_SCHED;
            PG8_LDB(B1, 0, 1); PG8_STAGE(PG8_SB(0, 0), b2, voffB);
            PG8_BAR; PG8_WAIT_L(0); PG8_MMA(0, 1, At, B1); PG8_BAR;
            PG8_LDA(At, 0, 1); PG8_STAGE(PG8_SA(0, 0), a2, voffA);
            PG8_BAR; PG8_WAIT_L(0); PG8_MMA(1, 0, At, B0); PG8_BAR; PG8_SCHED;
            PG8_STAGE(PG8_SB(0, 1), b2 + hstepB, voffB);
            PG8_WAIT_V(6); PG8_BAR; PG8_MMA(1, 1, At, B1); PG8_BAR;
            PG8_LDB(B0, 1, 0); PG8_SCHED; PG8_LDA(At, 1, 0); PG8_STAGE(PG8_SA(0, 1), a2 + hstepA, voffA);
            PG8_WAIT_L(8); PG8_BAR; PG8_WAIT_L(0); PG8_MMA(0, 0, At, B0); PG8_BAR; PG8_SCHED;
            PG8_LDB(B1, 1, 1); PG8_STAGE(PG8_SB(1, 0), b3, voffB);
            PG8_BAR; PG8_WAIT_L(0); PG8_MMA(0, 1, At, B1); PG8_BAR;
            PG8_LDA(At, 1, 1); PG8_STAGE(PG8_SA(1, 0), a3, voffA);
            PG8_BAR; PG8_WAIT_L(0); PG8_MMA(1, 0, At, B0); PG8_BAR; PG8_SCHED;
            PG8_STAGE(PG8_SB(1, 1), b3 + hstepB, voffB);
            PG8_WAIT_V(6); PG8_BAR; PG8_MMA(1, 1, At, B1); PG8_BAR;
            }
        }
        if constexpr (ALIGN_EPI) { if (wr == 0) PG8_BAR; }
        if constexpr (!Epi::AFTER_DRAIN) { E(acc, cur, wr, wc, fr, fq); S.done(cur); }
        if (!has_next) break;
#pragma unroll
        for (int a = 0; a < 2; ++a)
#pragma unroll
            for (int b = 0; b < 2; ++b)
#pragma unroll
                for (int m = 0; m < 4; ++m)
#pragma unroll
                    for (int n = 0; n < 2; ++n) acc[a][b][m][n] = (f32x4){0.f, 0.f, 0.f, 0.f};
        cur = nxt; cA = nA; cB = nB; ++ui;
        if constexpr (ALIGN_EPI) { if (wr == 1) PG8_BAR; }
    }
    PG8_WAIT_V(0);
    if constexpr (!ALIGN_EPI) { if (wr == 0) PG8_BAR; }
    PG8_BAR;
    if constexpr (Epi::AFTER_DRAIN) { E.fused(acc, cur, wr, wc, fr, fq, lds, wid, lane); S.done(cur); }
#undef PG8_SA
#undef PG8_SB
#undef PG8_STAGE
#undef PG8_LDA
#undef PG8_LDB
#undef PG8_MMA
#undef PG8_WAIT_V
#undef PG8_WAIT_L
#undef PG8_BAR
#undef PG8_SCHED
}
}
#define LAS __attribute__((address_space(3)))
typedef unsigned short bf16;
typedef short bf16x8 __attribute__((ext_vector_type(8)));
typedef float f32x4 __attribute__((ext_vector_type(4)));
typedef float f32x16 __attribute__((ext_vector_type(16)));
typedef unsigned u32x4 __attribute__((ext_vector_type(4)));
typedef unsigned u32x2 __attribute__((ext_vector_type(2)));
typedef float f32x2 __attribute__((ext_vector_type(2)));
constexpr int NB = 2, SEQ = 4096, MT = NB * SEQ, DM = 2048, DEPTH = 4, DIN = 4688, NIN = 4864, DFF = 5632, NGU = 2 * DFF;
constexpr int C_GQ = 0, C_GK = 256, C_GV = 512, C_GO = 1024, C_HQ = 1536, C_HF = 2048, C_HI = 2560, C_HO = 3072, C_QC = 3584, C_KVC = 4096, C_KPE = 4608, C_GLOW = 4672;
constexpr float EPS = 1e-6f;
constexpr float QSCALE = 0.07216878364870322f * 1.4426950408889634f;
constexpr int NWAVES = 8, NTHR = 512;
constexpr int LDS_BYTES = 143360;
constexpr size_t W_IN = 0, W_Q = W_IN + (size_t)NIN * DM, W_K = W_Q + 1536 * 512, W_V = W_K + 1024 * 512, W_OUT = W_V + 1024 * 512, W_GU = W_OUT + (size_t)DM * DM,
                 W_DN = W_GU + (size_t)NGU * DM, W_LAYER = W_DN + (size_t)DM * DFF;
constexpr size_t al256(size_t x) { return (x + 255) & ~(size_t)255; }
constexpr size_t WS_PS_QKV = 0, WS_PS_O = WS_PS_QKV + (size_t)MT * 16 * 4, WS_PS_M = WS_PS_O + (size_t)MT * 8 * 4, WS_RSTD = WS_PS_M + (size_t)MT * 32 * 4;
constexpr size_t WS_COS = WS_RSTD + MT * 4, WS_SIN = WS_COS + (size_t)MT * 32 * 4, WS_DL_G = WS_SIN + (size_t)MT * 32 * 4, WS_DL_H = WS_DL_G + 8 * 64 * 64 * 4, WS_KPE = WS_DL_H + 8 * 64 * 128 * 4;
constexpr size_t WS_ML = al256(WS_KPE + (size_t)MT * 64 * 2);
constexpr size_t WS_BAR = al256(WS_ML + (size_t)2 * 16 * 8 * 256 * 2 * 4), BAR_BYTES = 16384;
constexpr size_t WS_W = al256(WS_BAR + BAR_BYTES);
constexpr size_t WS_XB = al256(WS_W + W_LAYER * DEPTH * 2);
constexpr size_t WS_Y = WS_XB + (size_t)MT * DM * 2;
constexpr size_t WS_MB = WS_Y + (size_t)MT * DM * 2;
constexpr size_t WS_VT = WS_MB + (size_t)MT * DM * 2;
constexpr size_t WS_QE_G = WS_VT + (size_t)1024 * MT * 2;
constexpr size_t WS_QE_H = WS_QE_G + (size_t)MT * 256 * 2;
constexpr size_t WS_UT_G = WS_QE_H + (size_t)MT * 512 * 2;
constexpr size_t WS_UT_H = WS_UT_G + (size_t)8 * 64 * 128 * 64 * 4;
constexpr size_t WS_SP_G = WS_UT_H + (size_t)8 * 64 * 128 * 128 * 4;
constexpr size_t WS_SP_H = WS_SP_G + (size_t)8 * 64 * 128 * 64 * 2;
constexpr size_t WS_OI = WS_SP_H + (size_t)8 * 64 * 128 * 128 * 2;
constexpr size_t WS_R1 = WS_OI + (size_t)2 * MT * 512 * 4;
constexpr size_t WS_PROJ = WS_R1, WS_Q = WS_PROJ + (size_t)MT * NIN * 2, WS_KN = WS_Q + (size_t)MT * 1536 * 2, WS_R1_END = WS_KN + (size_t)MT * 1024 * 2;
constexpr size_t WS_HDN = WS_R1;
static_assert(WS_HDN + (size_t)MT * DFF * 2 <= WS_R1_END, "hdn overlay");
constexpr size_t WS_END = WS_R1_END;

struct Args {
    const float* x; const int* pos; const float* attn_pre; const float* w_in; const float* gate_w2; const float* gate_b; const float* gla_norm; const float* lb_logits; const float* hgrn_norm;
    const float* q_norm; const float* wq_b; const float* kv_norm; const float* wkv_b; const float* mla_out_norm; const float* w_out; const float* attn_post; const float* ffn_pre;
    const float* w_gate; const float* w_up; const float* w_down; const float* ffn_post; float* out; unsigned char* ws; int ph_lo, ph_hi;
};

__device__ __forceinline__ unsigned f2bf(float f) { unsigned u = __builtin_bit_cast(unsigned, f); return (u + 0x7fffu + ((u >> 16) & 1u)) >> 16; }
__device__ __forceinline__ float bf2f(bf16 b) { return __builtin_bit_cast(float, (unsigned)b << 16); }
__device__ __forceinline__ unsigned pk2(float lo, float hi) { return pg8::cvt_pk_bf16(lo, hi); }
__device__ __forceinline__ float wave_sum(float v) {
#pragma unroll
    for (int o = 1; o < 64; o <<= 1) v += __shfl_xor(v, o);
    return v;
}
__device__ __forceinline__ int crow(int r, int hi) { return (r & 3) + 8 * (r >> 2) + 4 * hi; }
#define LDS_WAIT() asm volatile("s_waitcnt lgkmcnt(0)" ::: "memory")

__device__ __forceinline__ int w_srccol(int mat, int n) {
    switch (mat) {
    case 0: return n < 1024 ? n : (n < 4672 ? n + 16 : (n < 4688 ? n - 3648 : -1));
    case 1: { if (n < 1024) return (n >> 7) * 192 + (n & 127); const int c = n - 1024, hh = c >> 6, j = c & 63, i = j >> 1; return hh * 192 + 128 + ((j & 1) ? i + 32 : i); }
    case 2: return (n >> 7) * 256 + (n & 127);
    case 3: return (n >> 7) * 256 + 128 + (n & 127);
    case 5: return (n >> 8) * 128 + (n & 127);
    default: return n;
    }
}
struct ConvDesc { const float* src; const float* gain; bf16* dst; int ldsrc, mat, gmin, k0, K, n0; };
constexpr int I_IN = (NIN / 128) * (DM / 128), I_Q = 12 * 4, I_K = 8 * 4, I_V = 8 * 4, I_OUT = 16 * 16, I_GU = (NGU / 128) * 16, I_DN = 16 * (DFF / 128);
constexpr int I_LAYER = I_IN + I_Q + I_K + I_V + I_OUT + I_GU + I_DN;
__device__ __forceinline__ ConvDesc conv_decode(const Args& a, int l, int r) {
    bf16* wl = (bf16*)(a.ws + WS_W) + (size_t)l * W_LAYER; ConvDesc d;
    if (r < I_IN) { const int nb = r % (NIN / 128), kb = r / (NIN / 128); d = ConvDesc{a.w_in + (size_t)l * DM * DIN, a.attn_pre + l * DM, wl + W_IN, DIN, 0, 0, kb * 128, DM, nb * 128}; return d; } r -= I_IN;
    if (r < I_Q) { const int nb = r % 12, kb = r / 12; d = ConvDesc{a.wq_b + (size_t)l * 512 * 1536, a.q_norm + l * 512, wl + W_Q, 1536, 1, 0, kb * 128, 512, nb * 128}; return d; } r -= I_Q;
    if (r < I_K) { const int nb = r % 8, kb = r / 8; d = ConvDesc{a.wkv_b + (size_t)l * 512 * 2048, a.kv_norm + l * 512, wl + W_K, 2048, 2, 0, kb * 128, 512, nb * 128}; return d; } r -= I_K;
    if (r < I_V) { const int nb = r % 8, kb = r / 8; d = ConvDesc{a.wkv_b + (size_t)l * 512 * 2048, a.kv_norm + l * 512, wl + W_V, 2048, 3, 0, kb * 128, 512, nb * 128}; return d; } r -= I_V;
    if (r < I_OUT) { const int nb = r % 16, kb = r / 16; d = ConvDesc{a.w_out + (size_t)l * DM * DM, a.mla_out_norm + l * 1024, wl + W_OUT, DM, 4, 1024, kb * 128, DM, nb * 128}; return d; } r -= I_OUT;
    if (r < I_GU) { const int nb = r % (NGU / 128), kb = r / (NGU / 128); d = ConvDesc{((nb & 1) ? a.w_up : a.w_gate) + (size_t)l * DM * DFF, a.ffn_pre + l * DM, wl + W_GU, DFF, 5, 0, kb * 128, DM, nb * 128}; return d; } r -= I_GU;
    { const int nb = r % 16, kb = r / 16; d = ConvDesc{a.w_down + (size_t)l * DFF * DM, nullptr, wl + W_DN, DM, 6, 0, kb * 128, DFF, nb * 128}; return d; }
}
__device__ __forceinline__ void conv_load(const ConvDesc& d, int tid, f32x4 (&v)[4][2], float (&gn)[4][2]) {
    const int c4 = tid & 31, rp = tid >> 5; int sc[4];
#pragma unroll
    for (int j = 0; j < 4; ++j) sc[j] = w_srccol(d.mat, d.n0 + 4 * c4 + j);
    const bool contig = sc[0] >= 0 && sc[1] == sc[0] + 1 && sc[2] == sc[0] + 2 && sc[3] == sc[0] + 3;
#pragma unroll
    for (int i = 0; i < 4; ++i)
#pragma unroll
        for (int e = 0; e < 2; ++e) { const int k = d.k0 + i * 32 + 2 * rp + e; const float* rowp = d.src + (size_t)k * d.ldsrc;
            if (contig) v[i][e] = *(const f32x4*)(rowp + sc[0]);
            else { v[i][e][0] = sc[0] >= 0 ? rowp[sc[0]] : 0.f; v[i][e][1] = sc[1] >= 0 ? rowp[sc[1]] : 0.f; v[i][e][2] = sc[2] >= 0 ? rowp[sc[2]] : 0.f; v[i][e][3] = sc[3] >= 0 ? rowp[sc[3]] : 0.f; }
            gn[i][e] = (d.gain && k >= d.gmin) ? d.gain[k - d.gmin] : 1.f; }
}
__device__ __forceinline__ void conv_store(const ConvDesc& d, int tid, const f32x4 (&v)[4][2], const float (&gn)[4][2], LAS unsigned* T) {
    constexpr int SD = 65; const int c4 = tid & 31, rp = tid >> 5;
#pragma unroll
    for (int i = 0; i < 4; ++i)
#pragma unroll
        for (int j = 0; j < 4; ++j) T[(c4 + 32 * j) * SD + i * 16 + rp] = pk2(v[i][0][j] * gn[i][0], v[i][1][j] * gn[i][1]);
    __syncthreads();
#pragma unroll
    for (int i = 0; i < 4; ++i) { const int n = i * 32 + (tid >> 4), kc = tid & 15; const LAS unsigned* p = T + n * SD + kc * 4; u32x4 o; o.x = p[0]; o.y = p[1]; o.z = p[2]; o.w = p[3];
        *(u32x4*)(d.dst + (size_t)(d.n0 + 4 * (n & 31) + (n >> 5)) * d.K + d.k0 + kc * 8) = o; }
    __syncthreads();
}
__device__ __forceinline__ void conv_layer(const Args& a, int l, LAS unsigned char* lds, unsigned* ctr) {
    int tid_o = threadIdx.x; asm volatile("" : "+v"(tid_o)); const int tid = tid_o;
    LAS unsigned* T = (LAS unsigned*)lds; volatile LAS unsigned* slot = (volatile LAS unsigned*)(lds + 131072 + 128);
    int stat = (int)blockIdx.x - (int)gridDim.x;
    unsigned pend = 0u;
#define CONV_ISSUE() do { if (ctr && tid == 0) pend = __hip_atomic_fetch_add(ctr, 1u, __ATOMIC_RELAXED, __HIP_MEMORY_SCOPE_AGENT); } while (0)
#define CONV_NEXT(r) do { if (ctr) { sl ^= 1; if (tid == 0) slot[sl] = pend; __syncthreads(); r = (int)slot[sl]; } else { stat += (int)gridDim.x; r = stat; } } while (0)
    int sl = 0;
    __syncthreads();
    f32x4 vA[4][2], vB[4][2], vC[4][2]; float gA[4][2], gB[4][2], gC[4][2]; ConvDesc d0, d1, d2; int r0, r1, r2;
    CONV_ISSUE(); CONV_NEXT(r0); CONV_ISSUE(); if (r0 < I_LAYER) { d0 = conv_decode(a, l, r0); conv_load(d0, tid, vA, gA); }
    CONV_NEXT(r1); CONV_ISSUE(); if (r1 < I_LAYER) { d1 = conv_decode(a, l, r1); conv_load(d1, tid, vB, gB); }
    for (;;) {
        if (r0 >= I_LAYER) break;
        CONV_NEXT(r2); CONV_ISSUE(); if (r2 < I_LAYER) { d2 = conv_decode(a, l, r2); conv_load(d2, tid, vC, gC); }
        conv_store(d0, tid, vA, gA, T);
        if (r1 >= I_LAYER) break;
        CONV_NEXT(r0); CONV_ISSUE(); if (r0 < I_LAYER) { d0 = conv_decode(a, l, r0); conv_load(d0, tid, vA, gA); }
        conv_store(d1, tid, vB, gB, T);
        if (r2 >= I_LAYER) break;
        CONV_NEXT(r1); CONV_ISSUE(); if (r1 < I_LAYER) { d1 = conv_decode(a, l, r1); conv_load(d1, tid, vB, gB); }
        conv_store(d2, tid, vC, gC, T);
    }
#undef CONV_NEXT
#undef CONV_ISSUE
}
__device__ __forceinline__ void p0_prologue(const Args& a, LAS unsigned char* lds) {
    int tid_o = threadIdx.x; asm volatile("" : "+v"(tid_o)); const int tid = tid_o, lane = tid & 63, wave = tid >> 6, G = gridDim.x;
    const int gw = blockIdx.x * NWAVES + wave, NGW = G * NWAVES;
    conv_layer(a, 0, lds, nullptr);
    float* ct = (float*)(a.ws + WS_COS); float* st = (float*)(a.ws + WS_SIN);
    for (int i = blockIdx.x * NTHR + tid; i < MT * 32; i += G * NTHR) { const int row = i >> 5, j = i & 31;
        const float inv = (float)exp(-((double)(2 * j) / 64.0) * 9.210340371976184);
        const float ang = (float)a.pos[row] * inv;
        double rev = (double)ang * 0.15915494309189535; rev -= rint(rev); const float rf = (float)rev;
        ct[i] = __builtin_amdgcn_cosf(rf); st[i] = __builtin_amdgcn_sinf(rf); }
    bf16* xb = (bf16*)(a.ws + WS_XB); float* rstd = (float*)(a.ws + WS_RSTD);
    for (int row = gw; row < MT; row += NGW) { const f32x4* xr = (const f32x4*)(a.x + (size_t)row * DM); u32x2* ob = (u32x2*)(xb + (size_t)row * DM); float ss = 0.f;
#pragma unroll
        for (int j = 0; j < 8; ++j) { const f32x4 v = xr[j * 64 + lane]; ss += (v[0] * v[0] + v[1] * v[1]) + (v[2] * v[2] + v[3] * v[3]); u32x2 o; o.x = pk2(v[0], v[1]); o.y = pk2(v[2], v[3]); ob[j * 64 + lane] = o; }
        ss = wave_sum(ss);
        if (lane == 0) rstd[row] = 1.f / sqrtf(ss * (1.f / DM) + EPS); }
}
__device__ __forceinline__ void rowpass(const float* xin, float* xout, const bf16* mb, const float* ps, const float* gain, bf16* xb, float* rstd) {
    int tid_o = threadIdx.x; asm volatile("" : "+v"(tid_o)); const int tid = tid_o, lane = tid & 63, wave = tid >> 6; const int gw = blockIdx.x * NWAVES + wave, NGW = gridDim.x * NWAVES;
    for (int row = gw; row < MT; row += NGW) { const f32x4* xr = (const f32x4*)(xin + (size_t)row * DM); f32x4* xo = (f32x4*)(xout + (size_t)row * DM);
        const u32x2* mr = (const u32x2*)(mb + (size_t)row * DM); u32x2* ob = (u32x2*)(xb + (size_t)row * DM); const f32x4* gr = (const f32x4*)gain;
        f32x4 xv[8]; u32x2 mv[8];
#pragma unroll
        for (int j = 0; j < 8; ++j) { xv[j] = xr[j * 64 + lane]; mv[j] = mr[j * 64 + lane]; }
        const float r = 1.f / sqrtf(wave_sum(lane < 32 ? ps[(size_t)row * 32 + lane] : 0.f) * (1.f / DM) + EPS); float ss = 0.f;
#pragma unroll
        for (int j = 0; j < 8; ++j) { const int i = j * 64 + lane; f32x4 v = xv[j]; const u32x2 mm = mv[j]; const f32x4 g = gr[i];
            v[0] += __builtin_bit_cast(float, mm.x << 16) * r * g[0]; v[1] += __builtin_bit_cast(float, mm.x & 0xffff0000u) * r * g[1];
            v[2] += __builtin_bit_cast(float, mm.y << 16) * r * g[2]; v[3] += __builtin_bit_cast(float, mm.y & 0xffff0000u) * r * g[3];
            xv[j] = v; ss += (v[0] * v[0] + v[1] * v[1]) + (v[2] * v[2] + v[3] * v[3]); }
#pragma unroll
        for (int j = 0; j < 8; ++j) { const int i = j * 64 + lane; xo[i] = xv[j]; u32x2 o; o.x = pk2(xv[j][0], xv[j][1]); o.y = pk2(xv[j][2], xv[j][3]); ob[i] = o; }
        ss = wave_sum(ss);
        if (lane == 0) rstd[row] = 1.f / sqrtf(ss * (1.f / DM) + EPS); }
}
__device__ __forceinline__ f32x16 mfma32(bf16x8 a, bf16x8 b, f32x16 c) { return __builtin_amdgcn_mfma_f32_32x32x16_bf16(a, b, c, 0, 0, 0); }
template <int KD> __device__ __forceinline__ f32x16 mm32(const LAS bf16* A, int lda, const LAS bf16* B, int ldb, int ql, int g, f32x16 acc) {
#pragma unroll
    for (int s = 0; s < KD / 16; ++s) { const bf16x8 a = *(const LAS bf16x8*)(A + ql * lda + 16 * s + 8 * g), b = *(const LAS bf16x8*)(B + ql * ldb + 16 * s + 8 * g); acc = mfma32(a, b, acc); }
    return acc;
}
constexpr f32x16 Z16 = {0.f, 0.f, 0.f, 0.f, 0.f, 0.f, 0.f, 0.f, 0.f, 0.f, 0.f, 0.f, 0.f, 0.f, 0.f, 0.f};
template <int TYPE> __device__ __forceinline__ void gla_local_item(const Args& a, LAS unsigned char* lds, int layer, int bh, int c) {
    constexpr int DK = TYPE ? 128 : 64, QS = DK + 8, TS = 72, NTG = NTHR / DK, RPT = 64 / NTG;
    LAS bf16* qh = (LAS bf16*)lds; LAS bf16* kh = qh + 64 * QS; LAS bf16* ktT = kh + 64 * QS; LAS bf16* vT = ktT + DK * TS; LAS bf16* Ab = vT + 128 * TS; LAS float* bc = (LAS float*)(Ab + 64 * TS);
    int tid_o = threadIdx.x; asm volatile("" : "+v"(tid_o)); const int tid = tid_o, lane = tid & 63, wave = tid >> 6, ql = lane & 31, g = lane >> 5;
    const int b = bh >> 2, h = bh & 3, t0 = b * SEQ + c * 64;
    const bf16* prow = (const bf16*)(a.ws + WS_PROJ) + (size_t)t0 * NIN;
    const int d = tid % DK, tg = tid / DK;
    float lbv = 0.f;
    bf16 rq[RPT], rk[RPT], rv[16];
#pragma unroll
    for (int tt = 0; tt < RPT; ++tt) { const int t = tg * RPT + tt; rq[tt] = prow[(size_t)t * NIN + (TYPE ? C_HQ : C_GQ) + h * DK + d]; rk[tt] = prow[(size_t)t * NIN + (TYPE ? C_HF : C_GK) + h * DK + d]; }
    { const int e = tid & 127, tq = tid >> 7; const int vcol = (TYPE ? C_HI : C_GV) + h * 128 + e;
#pragma unroll
      for (int i = 0; i < 16; ++i) rv[i] = prow[(size_t)(tq * 16 + i) * NIN + vcol]; }
    {
        float run = 0.f;
        if (TYPE == 0) {
            float w2c[16]; const float* w2 = a.gate_w2 + (size_t)layer * 16 * 256 + h * 64 + d;
#pragma unroll
            for (int r = 0; r < 16; ++r) w2c[r] = w2[r * 256];
            const float bias = a.gate_b[layer * 256 + h * 64 + d];
            bf16x8 rg0[RPT], rg1[RPT];
#pragma unroll
            for (int tt = 0; tt < RPT; ++tt) { const bf16x8* gl = (const bf16x8*)(prow + (size_t)(tg * RPT + tt) * NIN + C_GLOW); rg0[tt] = gl[0]; rg1[tt] = gl[1]; }
#pragma unroll
            for (int tt = 0; tt < RPT; ++tt) { const int t = tg * RPT + tt; const bf16x8 g0 = rg0[tt], g1 = rg1[tt]; float z = bias;
#pragma unroll
                for (int r = 0; r < 8; ++r) { z += bf2f((bf16)g0[r]) * w2c[r]; z += bf2f((bf16)g1[r]) * w2c[8 + r]; }
                const float lg = (fminf(z, 0.f) - __logf(1.f + __expf(-fabsf(z)))) * (1.f / 16.f);
                run += lg; bc[t * DK + d] = run; }
        } else {
            const float* lg4 = a.lb_logits + h * 128 + d; const float l0 = lg4[0], l1 = lg4[512], l2 = lg4[1024], l3 = lg4[1536];
            const float mx = fmaxf(fmaxf(l0, l1), fmaxf(l2, l3)); const float e0 = __expf(l0 - mx), e1 = __expf(l1 - mx), e2 = __expf(l2 - mx), e3 = __expf(l3 - mx); const float inv = 1.f / (e0 + e1 + e2 + e3);
            lbv = (layer >= 1 ? e1 : 0.f) + (layer >= 2 ? e2 : 0.f) + (layer >= 3 ? e3 : 0.f); lbv *= inv;
#pragma unroll
            for (int tt = 0; tt < RPT; ++tt) { const int t = tg * RPT + tt; const float hf = bf2f(rk[tt]);
                const float sg = 1.f / (1.f + __expf(-hf)); const float f = lbv + (1.f - lbv) * sg;
                run += __logf(f); bc[t * DK + d] = run; }
        }
    }
    __syncthreads();
    { float off = 0.f; for (int s = 0; s < tg; ++s) off += bc[(s * RPT + RPT - 1) * DK + d];
      __syncthreads();
      if (tg > 0) for (int tt = 0; tt < RPT; ++tt) bc[(tg * RPT + tt) * DK + d] += off; }
    __syncthreads();
    {
        const float bmid = bc[32 * DK + d], blast = bc[63 * DK + d]; const float scale = TYPE ? 1.f : 0.125f;
        bf16* qe = (bf16*)(a.ws + (TYPE ? WS_QE_H : WS_QE_G));
#pragma unroll
        for (int tt = 0; tt < RPT; ++tt) { const int t = tg * RPT + tt; const float bb = bc[t * DK + d]; float q = bf2f(rq[tt]), k = bf2f(rk[tt]);
            if (TYPE == 1) { const float hq = q, hf = k; q = hq / (1.f + __expf(-hq)); k = (1.f - lbv) / (1.f + __expf(hf)); }
            q *= scale;
            qh[t * QS + d] = (bf16)f2bf(q * __expf(bb - bmid)); kh[t * QS + d] = (bf16)f2bf(k * __expf(bmid - bb));
            ktT[d * TS + t] = (bf16)f2bf(k * __expf(blast - bb));
            qe[(size_t)(t0 + t) * (4 * DK) + h * DK + d] = (bf16)f2bf(q * __expf(bb)); }
        if (tg == 0) ((float*)(a.ws + (TYPE ? WS_DL_H : WS_DL_G)))[(bh * 64 + c) * DK + d] = __expf(blast);
        const int e = tid & 127, tq = tid >> 7;
#pragma unroll
        for (int i = 0; i < 16; ++i) vT[e * TS + tq * 16 + i] = rv[i];
    }
    __syncthreads();
    if (wave < 4) {
        const int jb = wave & 1, ib = wave >> 1; f32x16 acc = Z16;
        if (!(jb == 1 && ib == 0)) acc = mm32<DK>(kh + 32 * jb * QS, QS, qh + 32 * ib * QS, QS, ql, g, acc);
        const int i = 32 * ib + ql;
#pragma unroll
        for (int rg = 0; rg < 4; ++rg) { const int j0 = 32 * jb + 8 * rg + 4 * g; float v[4];
#pragma unroll
            for (int e = 0; e < 4; ++e) v[e] = (j0 + e <= i) ? acc[4 * rg + e] : 0.f;
            u32x2 o; o.x = pk2(v[0], v[1]); o.y = pk2(v[2], v[3]); *(LAS u32x2*)(Ab + i * TS + j0) = o; }
    }
    __syncthreads();
    {
        const int eb = wave & 3, ib = wave >> 2; f32x16 acc = mm32<64>(vT + 32 * eb * TS, TS, Ab + 32 * ib * TS, TS, ql, g, Z16);
        float* oi = (float*)(a.ws + WS_OI) + (size_t)TYPE * MT * 512 + (size_t)(t0 + 32 * ib + ql) * 512 + h * 128 + 32 * eb + 4 * g;
#pragma unroll
        for (int rg = 0; rg < 4; ++rg) { f32x4 o = {acc[4 * rg], acc[4 * rg + 1], acc[4 * rg + 2], acc[4 * rg + 3]}; *(f32x4*)(oi + 8 * rg) = o; }
    }
    {
        float* ut = (float*)(a.ws + (TYPE ? WS_UT_H : WS_UT_G)) + (size_t)(bh * 64 + c) * 128 * DK;
#pragma unroll
        for (int bi = 0; bi < DK / 64; ++bi) { const int blk = wave + 8 * bi, eb = blk & 3, db = blk >> 2;
            f32x16 acc = mm32<64>(ktT + 32 * db * TS, TS, vT + 32 * eb * TS, TS, ql, g, Z16);
            float* up = ut + (size_t)(32 * eb + ql) * DK + 32 * db + 4 * g;
#pragma unroll
            for (int rg = 0; rg < 4; ++rg) { f32x4 o = {acc[4 * rg], acc[4 * rg + 1], acc[4 * rg + 2], acc[4 * rg + 3]}; *(f32x4*)(up + 8 * rg) = o; } }
    }
    __syncthreads();
}
__device__ __forceinline__ void scan_item(const Args& a, int si) {
    int tid_o = threadIdx.x; asm volatile("" : "+v"(tid_o)); const int tid = tid_o; const bool hg = si >= 32; const int DK = hg ? 128 : 64; const int idx = (hg ? si - 32 : si) * NTHR + tid;
    const int per_bh = 128 * DK / 4; const int bh = idx / per_bh, rem = idx % per_bh, e = rem / (DK / 4), d = 4 * (rem % (DK / 4));
    const float* ut = (const float*)(a.ws + (hg ? WS_UT_H : WS_UT_G)) + (size_t)bh * 64 * 128 * DK + (size_t)e * DK + d;
    bf16* sp = (bf16*)(a.ws + (hg ? WS_SP_H : WS_SP_G)) + (size_t)bh * 64 * 128 * DK + (size_t)e * DK + d;
    const float* dl = (const float*)(a.ws + (hg ? WS_DL_H : WS_DL_G)) + (size_t)bh * 64 * DK + d;
    f32x4 S = {0.f, 0.f, 0.f, 0.f}; const size_t cs = (size_t)128 * DK;
    for (int cb = 0; cb < 64; cb += 16) {
        f32x4 u[16], dd[16];
#pragma unroll
        for (int i = 0; i < 16; ++i) { u[i] = __builtin_nontemporal_load((const f32x4*)(ut + (size_t)(cb + i) * cs)); dd[i] = *(const f32x4*)(dl + (cb + i) * DK); }
#pragma unroll
        for (int i = 0; i < 16; ++i) { u32x2 o; o.x = pk2(S[0], S[1]); o.y = pk2(S[2], S[3]); *(u32x2*)(sp + (size_t)(cb + i) * cs) = o; S = dd[i] * S + u[i]; }
    }
}
__device__ __forceinline__ void gla_final_item(const Args& a, int layer, int item) {
    const int type = item >> 7, bh = (item >> 4) & 7, cg4 = item & 15; const int DK = type ? 128 : 64;
    int tid_o = threadIdx.x; asm volatile("" : "+v"(tid_o)); const int tid = tid_o, lane = tid & 63, wave = tid >> 6, ql = lane & 31, g = lane >> 5;
    const int b = bh >> 2, h = bh & 3, c = cg4 * 4 + (wave >> 1), t = b * SEQ + c * 64 + (wave & 1) * 32 + ql;
    const float* oi = (const float*)(a.ws + WS_OI) + (size_t)type * MT * 512 + (size_t)t * 512 + h * 128 + 4 * g;
    f32x16 acc[4];
#pragma unroll
    for (int eb = 0; eb < 4; ++eb)
#pragma unroll
        for (int rg = 0; rg < 4; ++rg) { const f32x4 v = *(const f32x4*)(oi + 32 * eb + 8 * rg); acc[eb][4 * rg] = v[0]; acc[eb][4 * rg + 1] = v[1]; acc[eb][4 * rg + 2] = v[2]; acc[eb][4 * rg + 3] = v[3]; }
    const bf16* qe = (const bf16*)(a.ws + (type ? WS_QE_H : WS_QE_G)) + (size_t)t * (4 * DK) + h * DK + 8 * g;
    const bf16* sp = (const bf16*)(a.ws + (type ? WS_SP_H : WS_SP_G)) + ((size_t)(bh * 64 + c) * 128 + ql) * DK + 8 * g;
    for (int s = 0; s < DK / 16; ++s) { const bf16x8 bq = *(const bf16x8*)(qe + 16 * s);
#pragma unroll
        for (int eb = 0; eb < 4; ++eb) { const bf16x8 as = *(const bf16x8*)(sp + (size_t)32 * eb * DK + 16 * s); acc[eb] = mfma32(as, bq, acc[eb]); } }
    float ss = 0.f;
#pragma unroll
    for (int eb = 0; eb < 4; ++eb)
#pragma unroll
        for (int r = 0; r < 16; ++r) ss += acc[eb][r] * acc[eb][r];
    ss += __shfl_xor(ss, 32);
    const float rstd = 1.f / sqrtf(ss * (1.f / 128.f) + EPS);
    const float* gn = (type ? a.hgrn_norm : a.gla_norm) + layer * 128 + 4 * g;
    const bf16* gt = (const bf16*)(a.ws + WS_PROJ) + (size_t)t * NIN + (type ? C_HO : C_GO) + h * 128 + 4 * g;
    bf16* y = (bf16*)(a.ws + WS_Y) + (size_t)t * DM + type * 512 + h * 128 + 4 * g;
    u32x2 gbv[16]; f32x4 gvv[16];
#pragma unroll
    for (int i = 0; i < 16; ++i) { const int eo = 32 * (i >> 2) + 8 * (i & 3); gbv[i] = *(const u32x2*)(gt + eo); gvv[i] = *(const f32x4*)(gn + eo); }
#pragma unroll
    for (int eb = 0; eb < 4; ++eb)
#pragma unroll
        for (int rg = 0; rg < 4; ++rg) { const int eo = 32 * eb + 8 * rg; const f32x4 gv = gvv[4 * eb + rg]; const u32x2 gb = gbv[4 * eb + rg];
            const float g0 = __builtin_bit_cast(float, gb.x << 16), g1 = __builtin_bit_cast(float, gb.x & 0xffff0000u), g2 = __builtin_bit_cast(float, gb.y << 16), g3 = __builtin_bit_cast(float, gb.y & 0xffff0000u);
            const float o0 = acc[eb][4 * rg] * rstd * gv[0] * g0 / (1.f + __expf(-g0)), o1 = acc[eb][4 * rg + 1] * rstd * gv[1] * g1 / (1.f + __expf(-g1));
            const float o2 = acc[eb][4 * rg + 2] * rstd * gv[2] * g2 / (1.f + __expf(-g2)), o3 = acc[eb][4 * rg + 3] * rstd * gv[3] * g3 / (1.f + __expf(-g3));
            u32x2 o; o.x = pk2(o0, o1); o.y = pk2(o2, o3); *(u32x2*)(y + eo) = o; }
}
__device__ __forceinline__ void kpe_rope(const Args& a) {
    const bf16* proj = (const bf16*)(a.ws + WS_PROJ); bf16* kpe = (bf16*)(a.ws + WS_KPE); const float* ct = (const float*)(a.ws + WS_COS); const float* st = (const float*)(a.ws + WS_SIN);
    int tid_o = threadIdx.x; asm volatile("" : "+v"(tid_o));
    for (int i = blockIdx.x * NTHR + tid_o; i < MT * 32; i += gridDim.x * NTHR) { const int row = i >> 5, j = i & 31;
        const float x1 = bf2f(proj[(size_t)row * NIN + C_KPE + j]), x2 = bf2f(proj[(size_t)row * NIN + C_KPE + 32 + j]); const float c = ct[i], s = st[i];
        *(unsigned*)(kpe + (size_t)row * 64 + 2 * j) = pk2(x1 * c - x2 * s, x2 * c + x1 * s); }
}
__device__ __forceinline__ void mla_out_norm(const Args& a) {
    bf16* y = (bf16*)(a.ws + WS_Y); const float* ssq = (const float*)(a.ws + WS_PS_O);
    int tid_o = threadIdx.x; asm volatile("" : "+v"(tid_o));
    const int i0 = blockIdx.x * NTHR + tid_o, stride = gridDim.x * NTHR;
    for (int ib = i0; ib < MT * 128; ib += 8 * stride) {
        u32x4 v[8]; f32x4 s0[8], s1[8];
#pragma unroll
        for (int k = 0; k < 8; ++k) { const int i = ib + k * stride; if (i < MT * 128) { const int row = i >> 7, cc = i & 127; v[k] = *(const u32x4*)(y + (size_t)row * DM + 1024 + cc * 8); s0[k] = *(const f32x4*)(ssq + (size_t)row * 8); s1[k] = *(const f32x4*)(ssq + (size_t)row * 8 + 4); } }
#pragma unroll
        for (int k = 0; k < 8; ++k) { const int i = ib + k * stride; if (i < MT * 128) { const int row = i >> 7, cc = i & 127;
            const float r = 1.f / sqrtf((((s0[k][0] + s0[k][1]) + (s0[k][2] + s0[k][3])) + ((s1[k][0] + s1[k][1]) + (s1[k][2] + s1[k][3]))) * (1.f / 1024.f) + EPS); u32x4 w = v[k];
#pragma unroll
            for (int e = 0; e < 4; ++e) { const float lo = __builtin_bit_cast(float, w[e] << 16) * r, hi = __builtin_bit_cast(float, w[e] & 0xffff0000u) * r; w[e] = pk2(lo, hi); }
            *(u32x4*)(y + (size_t)row * DM + 1024 + cc * 8) = w; } }
    }
}
constexpr int KSTR = 400, VSTR = 136, KBYTES = 64 * KSTR, VBYTES = 128 * VSTR, OSTR = 272;
__device__ __forceinline__ void attn_item(const Args& a, LAS unsigned char* lds, int b, int h, int qb, int t0, int t1, int part) {
    int tid_o = threadIdx.x; asm volatile("" : "+v"(tid_o)); const int tid = tid_o, lane = tid & 63, wave = tid >> 6, ql = lane & 31, g = lane >> 5;
    const bf16* Q = (const bf16*)(a.ws + WS_Q); const bf16* KN = (const bf16*)(a.ws + WS_KN); const bf16* KP = (const bf16*)(a.ws + WS_KPE); const bf16* VT = (const bf16*)(a.ws + WS_VT);
    const int tq0 = b * SEQ + qb * 256 + wave * 32, qpos = qb * 256 + wave * 32 + ql;
    bf16x8 qf[12];
    { const bf16* qp = Q + (size_t)(tq0 + ql) * 1536 + h * 192 + 8 * g;
#pragma unroll
      for (int s = 0; s < 12; ++s) qf[s] = *(const bf16x8*)(qp + 16 * s); }
    f32x16 oacc[4] = {Z16, Z16, Z16, Z16}; float mrun = 0.f, lrun = 0.f;
    const int nt = 4 * (qb + 1);
    int ksrc_off[3]; int kdst[3]; bool kpe_sel[3]; int vsrc_off[2]; int vdst[2];
#pragma unroll
    for (int i = 0; i < 3; ++i) { const int cid = tid + NTHR * i, key = cid / 24, cc = cid % 24; kpe_sel[i] = cc >= 16; kdst[i] = key * KSTR + cc * 16;
        ksrc_off[i] = kpe_sel[i] ? key * 64 + (cc - 16) * 8 : key * 1024 + h * 128 + cc * 8; }
#pragma unroll
    for (int i = 0; i < 2; ++i) { const int cid = tid + NTHR * i, row = cid >> 3, cc = cid & 7; vdst[i] = row * VSTR + cc * 16; vsrc_off[i] = (h * 128 + row) * MT + cc * 8; }
    u32x4 sk[3], sv[2];
#define ATT_GLOAD(t) do { const size_t tk = (size_t)(b * SEQ + (t) * 64); _Pragma("unroll") for (int i = 0; i < 3; ++i) sk[i] = kpe_sel[i] ? *(const u32x4*)(KP + tk * 64 + ksrc_off[i]) : *(const u32x4*)(KN + tk * 1024 + ksrc_off[i]); \
        _Pragma("unroll") for (int i = 0; i < 2; ++i) sv[i] = *(const u32x4*)(VT + (size_t)vsrc_off[i] + tk); } while (0)
#define ATT_LSTORE(kbuf, vbuf) do { LAS unsigned char* kb_ = lds + (kbuf) * KBYTES; LAS unsigned char* vb_ = lds + 2 * KBYTES + (vbuf) * VBYTES; \
        _Pragma("unroll") for (int i = 0; i < 3; ++i) *(LAS u32x4*)(kb_ + kdst[i]) = sk[i]; _Pragma("unroll") for (int i = 0; i < 2; ++i) { *(LAS u32x2*)(vb_ + vdst[i]) = (u32x2){sv[i].x, sv[i].y}; *(LAS u32x2*)(vb_ + vdst[i] + 8) = (u32x2){sv[i].z, sv[i].w}; } } while (0)
#define ATT_KLD(s_) (*(const LAS bf16x8*)(kp + 32 * (s_)))
#define ATT_KLD1(s_) (*(const LAS bf16x8*)(kp + 32 * KSTR + 32 * (s_)))
#define ATT_QK(kb_) do { const LAS unsigned char* kp = (kb_) + ql * KSTR + 16 * g; { const float ci = -mrun; _Pragma("unroll") for (int r = 0; r < 16; ++r) { p0[r] = ci; p1[r] = ci; } } \
        bf16x8 ka0 = ATT_KLD(0), ka1 = ATT_KLD1(0), kb0, kb1; \
        _Pragma("unroll") for (int s = 0; s < 12; s += 2) { \
            kb0 = ATT_KLD(s + 1); kb1 = ATT_KLD1(s + 1); __builtin_amdgcn_sched_barrier(0); \
            p0 = mfma32(ka0, qf[s], p0); p1 = mfma32(ka1, qf[s], p1); \
            if (s + 2 < 12) { ka0 = ATT_KLD(s + 2); ka1 = ATT_KLD1(s + 2); } __builtin_amdgcn_sched_barrier(0); \
            p0 = mfma32(kb0, qf[s + 1], p0); p1 = mfma32(kb1, qf[s + 1], p1); } } while (0)
#define ATT_SM() do { \
        if (t >= nt - 4) { const int kb0 = t * 64 + 4 * g; const float NEG = -__builtin_inff(); \
            _Pragma("unroll") for (int r = 0; r < 16; ++r) { const int kk = kb0 + (r & 3) + 8 * (r >> 2); if (kk > qpos) p0[r] = NEG; if (kk + 32 > qpos) p1[r] = NEG; } } \
        float mx = fmaxf(fmaxf(p0[0], p0[1]), p0[2]); \
        _Pragma("unroll") for (int r = 3; r < 15; r += 2) mx = fmaxf(fmaxf(mx, p0[r]), p0[r + 1]); \
        mx = fmaxf(fmaxf(mx, p0[15]), p1[0]); \
        _Pragma("unroll") for (int r = 1; r < 15; r += 2) mx = fmaxf(fmaxf(mx, p1[r]), p1[r + 1]); \
        mx = fmaxf(mx, p1[15]); \
        mx = fmaxf(mx, __shfl_xor(mx, 32)); \
          \
        { const bool first = (t == t0); \
          if (first || __builtin_amdgcn_ballot_w64(mx > 8.f) != 0ull) { \
            const float d = first ? mx : fmaxf(mx, 0.f); mrun += d; \
            _Pragma("unroll") for (int r = 0; r < 16; ++r) { p0[r] -= d; p1[r] -= d; } \
            if (!first) { const float alpha = __builtin_amdgcn_exp2f(-d); lrun *= alpha; \
                _Pragma("unroll") for (int db = 0; db < 4; ++db) oacc[db] = oacc[db] * alpha; } } } \
        float rs = 0.f; \
        _Pragma("unroll") for (int r = 0; r < 16; ++r) { p0[r] = __builtin_amdgcn_exp2f(p0[r]); p1[r] = __builtin_amdgcn_exp2f(p1[r]); rs += p0[r] + p1[r]; } \
        lrun += rs; \
        { u32x4 w; \
          w.x = pk2(p0[0], p0[1]); w.y = pk2(p0[2], p0[3]); w.z = pk2(p0[4], p0[5]); w.w = pk2(p0[6], p0[7]); pf[0] = __builtin_bit_cast(bf16x8, w); \
          w.x = pk2(p0[8], p0[9]); w.y = pk2(p0[10], p0[11]); w.z = pk2(p0[12], p0[13]); w.w = pk2(p0[14], p0[15]); pf[1] = __builtin_bit_cast(bf16x8, w); \
          w.x = pk2(p1[0], p1[1]); w.y = pk2(p1[2], p1[3]); w.z = pk2(p1[4], p1[5]); w.w = pk2(p1[6], p1[7]); pf[2] = __builtin_bit_cast(bf16x8, w); \
          w.x = pk2(p1[8], p1[9]); w.y = pk2(p1[10], p1[11]); w.z = pk2(p1[12], p1[13]); w.w = pk2(p1[14], p1[15]); pf[3] = __builtin_bit_cast(bf16x8, w); } } while (0)
#define ATT_VLD(i_) ({ const LAS unsigned char* vp_ = vbase + (32 * ((i_) & 3)) * VSTR + 32 * ((i_) >> 2); const u32x2 lo_ = *(const LAS u32x2*)vp_, hi_ = *(const LAS u32x2*)(vp_ + 16); (u32x4){lo_.x, lo_.y, hi_.x, hi_.y}; })
#define ATT_PV(vb_) do { const LAS unsigned char* vbase = (vb_) + ql * VSTR + 8 * g; u32x4 va = ATT_VLD(0), vb; \
        _Pragma("unroll") for (int i = 0; i < 16; i += 2) { \
            vb = ATT_VLD(i + 1); __builtin_amdgcn_sched_barrier(0); \
            oacc[i & 3] = mfma32(__builtin_bit_cast(bf16x8, va), pf[i >> 2], oacc[i & 3]); \
            if (i + 2 < 16) va = ATT_VLD(i + 2); __builtin_amdgcn_sched_barrier(0); \
            oacc[(i + 1) & 3] = mfma32(__builtin_bit_cast(bf16x8, vb), pf[(i + 1) >> 2], oacc[(i + 1) & 3]); } } while (0)
    const int wv = __builtin_amdgcn_readfirstlane(tid >> 6);
    f32x16 p0, p1; bf16x8 pf[4];
    __syncthreads();
    ATT_GLOAD(t0); ATT_LSTORE(0, 0);
    __syncthreads();
    const LAS unsigned char* vring = lds + 2 * KBYTES;
    if (wv < 4) {
        int vs = 0;
        for (int t = t0; t < t1; ++t) {
            if (t + 1 < t1) ATT_GLOAD(t + 1);
            const int bsel = (t - t0) & 1; const int vnext = vs == 2 ? 0 : vs + 1;
            ATT_QK(lds + bsel * KBYTES); ATT_SM(); ATT_PV(vring + vs * VBYTES);
            if (t + 1 < t1) ATT_LSTORE(bsel ^ 1, vnext);
            vs = vnext;
            __syncthreads();
        }
    } else {
        int vs = 0;
        for (int t = t0; t < t1; ++t) {
            const int bsel = (t - t0) & 1; const int vprev = vs == 0 ? 2 : vs - 1, vnext = vs == 2 ? 0 : vs + 1;
            if (t > t0) ATT_PV(vring + vprev * VBYTES);
            if (t + 1 < t1) ATT_GLOAD(t + 1);
            ATT_QK(lds + bsel * KBYTES); ATT_SM();
            if (t + 1 < t1) ATT_LSTORE(bsel ^ 1, vnext);
            vs = vnext;
            __syncthreads();
        }
        { const int vlast = vs == 0 ? 2 : vs - 1; ATT_PV(vring + vlast * VBYTES); }
    }
    __syncthreads();
#undef ATT_QK
#undef ATT_KLD
#undef ATT_KLD1
#undef ATT_SM
#undef ATT_PV
#undef ATT_VLD
#undef ATT_GLOAD
#undef ATT_LSTORE
    const float lt = lrun + __shfl_xor(lrun, 32), inv = 1.f / lt;
    LAS unsigned char* ob = lds + wave * (32 * OSTR);
#pragma unroll
    for (int db = 0; db < 4; ++db)
#pragma unroll
        for (int rg = 0; rg < 4; ++rg) { const float o0 = oacc[db][4 * rg] * inv, o1 = oacc[db][4 * rg + 1] * inv, o2 = oacc[db][4 * rg + 2] * inv, o3 = oacc[db][4 * rg + 3] * inv;
            u32x2 o; o.x = pk2(o0, o1); o.y = pk2(o2, o3); *(LAS u32x2*)(ob + ql * OSTR + (32 * db + 8 * rg + 4 * g) * 2) = o; }
    LDS_WAIT(); asm volatile("" ::: "memory");
    bf16* dst; int pitch;
    if (part < 0) { dst = (bf16*)(a.ws + WS_Y) + (size_t)tq0 * DM + 1024 + h * 128; pitch = DM; }
    else { const size_t rec = ((size_t)((part * 16 + b * 8 + h) * 8 + (qb - 8)) * 256 + wave * 32); dst = (bf16*)(a.ws + WS_MB) + rec * 128; pitch = 128;
        if (g == 0) { float* ml = (float*)(a.ws + WS_ML) + (rec + ql) * 2; ml[0] = mrun; ml[1] = lt; } }
#pragma unroll
    for (int i = 0; i < 8; ++i) { const int cid = lane + 64 * i, row = cid >> 4, cc = cid & 15; const u32x4 v = *(const LAS u32x4*)(ob + row * OSTR + cc * 16);
        *(u32x4*)(dst + (size_t)row * pitch + cc * 8) = v; }
}
__device__ __forceinline__ void attn_queue(const Args& a, LAS unsigned char* lds, unsigned* ctr) {
    int tid_o = threadIdx.x; asm volatile("" : "+v"(tid_o)); const int tid = tid_o; const int grp = (int)((unsigned)__builtin_amdgcn_s_getreg((3 << 11) | 20) & 7u);
    volatile LAS unsigned* slot = (volatile LAS unsigned*)(lds + 131072 + 160);
    for (;;) {
        if (tid == 0) *slot = __hip_atomic_fetch_add(ctr + grp, 1u, __ATOMIC_RELAXED, __HIP_MEMORY_SCOPE_AGENT);
        __syncthreads();
        const int idx = (int)*slot;
        if (idx >= 48) break;
        const int bh = 2 * grp + (idx >= 24 ? 1 : 0), k = idx >= 24 ? idx - 24 : idx; int qb, part;
        if (k < 20) { const int j = k / 5, r = k % 5; if (r == 0) { qb = 7 - j; part = -1; } else if (r < 3) { qb = 15 - 2 * j; part = r - 1; } else { qb = 14 - 2 * j; part = r - 3; } }
        else { qb = 23 - k; part = -1; }
        const int nt = 4 * (qb + 1);
        attn_item(a, lds, bh >> 3, bh & 7, qb, part == 1 ? nt / 2 : 0, part == 0 ? nt / 2 : nt, part);
    }
}
__device__ __forceinline__ void mla_finish(const Args& a) {
    int tid_o = threadIdx.x; asm volatile("" : "+v"(tid_o)); const int tid = tid_o, lane = tid & 63, wave = tid >> 6; const int gw = blockIdx.x * NWAVES + wave, NGW = gridDim.x * NWAVES;
    bf16* y = (bf16*)(a.ws + WS_Y); const bf16* po = (const bf16*)(a.ws + WS_MB); const float* ml = (const float*)(a.ws + WS_ML);
    for (int row = gw; row < MT; row += NGW) { const int b = row >> 12, pos = row & 4095, qb = pos >> 8, r = pos & 255; float o0[8], o1[8];
        if (qb < 8) {
#pragma unroll
            for (int h = 0; h < 8; ++h) { const unsigned u = *(const unsigned*)(y + (size_t)row * DM + 1024 + h * 128 + 2 * lane); o0[h] = __builtin_bit_cast(float, u << 16); o1[h] = __builtin_bit_cast(float, u & 0xffff0000u); }
        } else {
            unsigned ua[8], ub[8]; float ma[8], la[8], mb_[8], lb_[8];
#pragma unroll
            for (int h = 0; h < 8; ++h) { const size_t ra = (size_t)((0 * 16 + b * 8 + h) * 8 + (qb - 8)) * 256 + r, rb = (size_t)((1 * 16 + b * 8 + h) * 8 + (qb - 8)) * 256 + r;
                ua[h] = *(const unsigned*)(po + ra * 128 + 2 * lane); ub[h] = *(const unsigned*)(po + rb * 128 + 2 * lane);
                ma[h] = ml[ra * 2]; la[h] = ml[ra * 2 + 1]; mb_[h] = ml[rb * 2]; lb_[h] = ml[rb * 2 + 1]; }
#pragma unroll
            for (int h = 0; h < 8; ++h) { const float m = fmaxf(ma[h], mb_[h]); const float wa = la[h] * __builtin_amdgcn_exp2f(ma[h] - m), wb = lb_[h] * __builtin_amdgcn_exp2f(mb_[h] - m), iw = 1.f / (wa + wb);
                o0[h] = (wa * __builtin_bit_cast(float, ua[h] << 16) + wb * __builtin_bit_cast(float, ub[h] << 16)) * iw;
                o1[h] = (wa * __builtin_bit_cast(float, ua[h] & 0xffff0000u) + wb * __builtin_bit_cast(float, ub[h] & 0xffff0000u)) * iw; }
        }
        float ss = 0.f;
#pragma unroll
        for (int h = 0; h < 8; ++h) ss += o0[h] * o0[h] + o1[h] * o1[h];
        ss = wave_sum(ss); const float rs = 1.f / sqrtf(ss * (1.f / 1024.f) + EPS);
#pragma unroll
        for (int h = 0; h < 8; ++h) *(unsigned*)(y + (size_t)row * DM + 1024 + h * 128 + 2 * lane) = pk2(o0[h] * rs, o1[h] * rs);
    }
}
#define XB_TMO      128
#define XB_XCNT(j)  (256  + 64 * (j))
#define XB_XSUB(j)  (1280 + 64 * (j))
#define XB_XGEN(j)  (2304 + 64 * (j))
#define XB_TOP      3328
#define XB_TOPGEN   3392
#define XCD_BAR_WORDS 3456
#define XB_SPIN_CAP (1u << 18)

__device__ __forceinline__ unsigned xb_ld(unsigned* p)              { return __hip_atomic_load(p, __ATOMIC_RELAXED, __HIP_MEMORY_SCOPE_AGENT); }
__device__ __forceinline__ unsigned xb_add(unsigned* p, unsigned v) { return __hip_atomic_fetch_add(p, v, __ATOMIC_RELAXED, __HIP_MEMORY_SCOPE_AGENT); }
__device__ __forceinline__ unsigned xb_xcc_id() { return (unsigned)__builtin_amdgcn_s_getreg((3 << 11) | 20) & 0xFu; }
#define XB_SPIN(cond, bar) do { unsigned _sp = 0; while (cond) { __builtin_amdgcn_s_sleep(1); \
    if ((++_sp & 255u) == 0u) { if (xb_ld(&(bar)[XB_TMO])) break; if (_sp > XB_SPIN_CAP) { atomicAdd(&(bar)[XB_TMO], 1u); break; } } } } while (0)

struct XcdBarrier {
    unsigned* bar; unsigned x;
    volatile LAS unsigned* st;
};

__device__ __forceinline__ XcdBarrier xcd_barrier_post(unsigned* bar, volatile LAS unsigned* st) {
    XcdBarrier b; b.bar = bar; b.x = xb_xcc_id(); b.st = st;
    if (threadIdx.x == 0) (void)xb_add(&bar[XB_XCNT(b.x)], 1u);
    return b;
}
__device__ __forceinline__ void xcd_barrier_complete(unsigned* bar, unsigned x, unsigned& nloc, unsigned& nx) {
    const unsigned G = gridDim.x * gridDim.y * gridDim.z;
    unsigned sum, cnt, mine, sp = 0u;
    for (;;) {
        sum = 0u; cnt = 0u; mine = 0u;
#pragma unroll
        for (unsigned j = 0; j < 16; ++j) { const unsigned c = xb_ld(&bar[XB_XCNT(j)]); sum += c; cnt += (c > 0u) ? 1u : 0u; mine = (j == x) ? c : mine; }
        if (sum == G) break;
        __builtin_amdgcn_s_sleep(1);
        if ((++sp & 255u) == 0u) { if (xb_ld(&bar[XB_TMO])) break; if (sp > XB_SPIN_CAP) { atomicAdd(&bar[XB_TMO], 1u); break; } }
    }
    nloc = mine > 0u ? mine : 1u; nx = cnt > 0u ? cnt : 1u;
}

__device__ __forceinline__ void xcd_barrier(const XcdBarrier& b) {
    asm volatile("s_waitcnt vmcnt(0)" ::: "memory");
    __syncthreads();
    if (threadIdx.x == 0) {
        unsigned* bar = b.bar;
        __builtin_amdgcn_s_waitcnt(0);
        unsigned nloc = b.st[0], nx = b.st[1];
        if (nloc == 0u) { xcd_barrier_complete(bar, b.x, nloc, nx); b.st[0] = nloc; b.st[1] = nx; }
        const unsigned old = xb_add(&bar[XB_XSUB(b.x)], 1u);
        const unsigned gen = old / nloc;
        if (old + 1u == (gen + 1u) * nloc) {
            __builtin_amdgcn_fence(__ATOMIC_RELEASE, "agent");
            asm volatile("s_waitcnt vmcnt(0)" ::: "memory");
            const unsigned og = xb_add(&bar[XB_TOP], 1u);
            const unsigned tg = og / nx;
            if (og + 1u == (tg + 1u) * nx) xb_add(&bar[XB_TOPGEN], 1u);
            else XB_SPIN(xb_ld(&bar[XB_TOPGEN]) == tg, bar);
            __builtin_amdgcn_fence(__ATOMIC_ACQUIRE, "agent");
            xb_add(&bar[XB_XGEN(b.x)], 1u);
            asm volatile("s_waitcnt vmcnt(0)" ::: "memory");
        } else {
            XB_SPIN(xb_ld(&bar[XB_XGEN(b.x)]) == gen, bar);
            __builtin_amdgcn_fence(__ATOMIC_ACQUIRE, "agent");
            asm volatile("s_waitcnt vmcnt(0)" ::: "memory");
        }
    }
    __syncthreads();
}


constexpr int N_PHASES = 1 + 9 * DEPTH;
#ifndef DBG_REP
#define DBG_REP 0
#endif
#define NREP(j) (1 + ((DBG_REP >> (j)) & 1))
#ifndef DBG_MASK
#define DBG_MASK 0x3ff
#endif
#define EN(j) ((DBG_MASK >> (j)) & 1)
__device__ __forceinline__ const Args* args_here() { const Args* p = (const Args*)__builtin_amdgcn_kernarg_segment_ptr(); asm volatile("" : "+s"(p)); return p; }
#define PH_ARGS Args a = a_in; { __attribute__((address_space(1))) unsigned char* w_ = (__attribute__((address_space(1))) unsigned char*)a.ws; asm volatile("" : "+s"(w_)); a.ws = (unsigned char*)w_; } unsigned char* const ws = a.ws; (void)ws
__global__ void __launch_bounds__(NTHR, 2) mega_fwd(Args a_in) {
    extern __shared__ __attribute__((aligned(16))) unsigned char lds_raw[];
    LAS unsigned char* lds = (LAS unsigned char*)lds_raw;
    cg::grid_group grid = cg::this_grid();
    volatile LAS unsigned* bst = (volatile LAS unsigned*)(lds + 131072 + 64);
    if (threadIdx.x < 2) bst[threadIdx.x] = 0u;
    __syncthreads();
    XcdBarrier bar = xcd_barrier_post((unsigned*)(a_in.ws + WS_BAR), bst);
    const int G = gridDim.x, bid = blockIdx.x;
    const int lo = a_in.ph_lo, hi = a_in.ph_hi;
#define IN(k) (lo <= (k) && (k) < hi)
#define SEAM(k) do { if (IN((k) + 1)) { if ((k) == 0) grid.sync(); else { XcdBarrier b2 = bar; asm volatile("" : "+s"(b2.bar)); xcd_barrier(b2); } } } while (0)
    if (IN(0) && EN(0)) for (int rep = 0; rep < NREP(0); ++rep) { PH_ARGS; p0_prologue(a, lds); SEAM(0); }
    for (int l = 0; l < DEPTH; ++l) {
        const int P = 1 + 9 * l;
        if (IN(P) && EN(1)) for (int rep = 0; rep < NREP(1); ++rep) {
            PH_ARGS; const bf16* wl = (const bf16*)(ws + WS_W) + (size_t)l * W_LAYER;
            pg8::Gemm gm{(const bf16*)(ws + WS_XB), wl + W_IN, MT, NIN, DM, DM, DM}; pg8::StaticOrder S; S.init(MT, NIN, G, bid);
            pg8::EpiRow E{(bf16*)(ws + WS_PROJ), NIN, (const float*)(ws + WS_RSTD), 0, 0, 0.f, EPS, (float*)(ws + WS_PS_QKV), 16, 14, 18};
            pg8::gemm_phase<pg8::EpiRow, pg8::StaticOrder, true, true>(lds, gm, S, E); SEAM(P); }
        if (IN(P + 1) && EN(2)) for (int rep = 0; rep < NREP(2); ++rep) {
#define P1_ARGS PH_ARGS; const bf16* wl = (const bf16*)(ws + WS_W) + (size_t)l * W_LAYER; const bf16* proj = (const bf16*)(ws + WS_PROJ); float* ps_qkv = (float*)(ws + WS_PS_QKV); (void)wl; (void)proj; (void)ps_qkv
            { P1_ARGS; pg8::Gemm gm{proj + C_QC, wl + W_Q, MT, 1536, 512, NIN, 512}; pg8::StaticOrder S; S.init(MT, 1536, G, bid);
              pg8::EpiQ E{(bf16*)(ws + WS_Q), ps_qkv, EPS, QSCALE, (const float*)(ws + WS_COS), (const float*)(ws + WS_SIN)};
              pg8::gemm_phase<pg8::EpiQ, pg8::StaticOrder, true, true>(lds, gm, S, E); }
            { P1_ARGS; pg8::Gemm gm{proj + C_KVC, wl + W_K, MT, 1024, 512, NIN, 512}; pg8::StaticOrder S; S.init(MT, 1024, G, (bid + 64) % G);
              pg8::EpiRow E{(bf16*)(ws + WS_KN), 1024, ps_qkv + 8, 16, 8, 1.f / 512.f, EPS, nullptr, 0, 0, 0};
              pg8::gemm_phase<pg8::EpiRow, pg8::StaticOrder, true, true>(lds, gm, S, E); }
            { P1_ARGS; pg8::Gemm gm{wl + W_V, proj + C_KVC, 1024, MT, 512, 512, NIN}; pg8::StaticOrder S; S.init(1024, MT, G, (bid + 192) % G);
              pg8::EpiVT E{(bf16*)(ws + WS_VT), MT, ps_qkv, EPS};
              pg8::gemm_phase<pg8::EpiVT, pg8::StaticOrder, true, true>(lds, gm, S, E); }
            { PH_ARGS; kpe_rope(a); }
            __syncthreads();
            PH_ARGS;
            for (int it = bid; it < 1024; it += G) { if (it < 512) gla_local_item<0>(a, lds, l, it >> 6, it & 63); else gla_local_item<1>(a, lds, l, (it - 512) >> 6, it & 63); }
            SEAM(P + 1); }
        if (IN(P + 2) && EN(3)) for (int rep = 0; rep < NREP(3); ++rep) {
            PH_ARGS;
            for (int it = bid; it < 96; it += G) scan_item(a, it);
            attn_queue(a, lds, (unsigned*)(ws + WS_BAR) + 8 + 8 * l);
            if (l + 1 < DEPTH && rep == 0) conv_layer(a, l + 1, lds, (unsigned*)(ws + WS_BAR) + l);
            SEAM(P + 2); }
        if (IN(P + 3) && EN(4)) for (int rep = 0; rep < NREP(4); ++rep) {
            PH_ARGS;
            for (int it = bid; it < 256; it += G) gla_final_item(a, l, it);
            if (rep + 1 == NREP(4)) mla_finish(a);
            SEAM(P + 3); }
        if (IN(P + 4) && EN(5)) for (int rep = 0; rep < NREP(5); ++rep) {
            PH_ARGS; const bf16* wl = (const bf16*)(ws + WS_W) + (size_t)l * W_LAYER;
            pg8::Gemm gm{(const bf16*)(ws + WS_Y), wl + W_OUT, MT, DM, DM, DM, DM}; pg8::StaticOrder S; S.init(MT, DM, G, bid);
            pg8::EpiRow E{(bf16*)(ws + WS_MB), DM, nullptr, 0, 0, 0.f, EPS, (float*)(ws + WS_PS_M), 32, 0, 8};
            pg8::gemm_phase<pg8::EpiRow, pg8::StaticOrder, true, true>(lds, gm, S, E); SEAM(P + 4); }
        if (IN(P + 5) && EN(6)) { PH_ARGS; rowpass(l == 0 ? a.x : a.out, a.out, (const bf16*)(ws + WS_MB), (const float*)(ws + WS_PS_M), a.attn_post + l * DM, (bf16*)(ws + WS_XB), (float*)(ws + WS_RSTD)); SEAM(P + 5); }
        if (IN(P + 6) && EN(7)) for (int rep = 0; rep < NREP(7); ++rep) {
            PH_ARGS; const bf16* wl = (const bf16*)(ws + WS_W) + (size_t)l * W_LAYER;
            pg8::Gemm gm{(const bf16*)(ws + WS_XB), wl + W_GU, MT, NGU, DM, DM, DM}; pg8::StaticOrder S; S.init(MT, NGU, G, bid);
            pg8::EpiGU E{(bf16*)(ws + WS_HDN), DFF, (const float*)(ws + WS_RSTD)};
            pg8::gemm_phase<pg8::EpiGU, pg8::StaticOrder, true, true>(lds, gm, S, E); SEAM(P + 6); }
        if (IN(P + 7) && EN(8)) for (int rep = 0; rep < NREP(8); ++rep) {
            PH_ARGS; const bf16* wl = (const bf16*)(ws + WS_W) + (size_t)l * W_LAYER;
            pg8::Gemm gm{(const bf16*)(ws + WS_HDN), wl + W_DN, MT, DM, DFF, DFF, DFF}; pg8::StaticOrder S; S.init(MT, DM, G, bid);
            pg8::EpiRow E{(bf16*)(ws + WS_MB), DM, nullptr, 0, 0, 0.f, EPS, (float*)(ws + WS_PS_M), 32, 0, 8};
            pg8::gemm_phase<pg8::EpiRow, pg8::StaticOrder, true, true>(lds, gm, S, E); SEAM(P + 7); }
        if (IN(P + 8) && EN(9)) { PH_ARGS; rowpass(a.out, a.out, (const bf16*)(ws + WS_MB), (const float*)(ws + WS_PS_M), a.ffn_post + l * DM, (bf16*)(ws + WS_XB), (float*)(ws + WS_RSTD)); if (l + 1 < DEPTH) SEAM(P + 8); }
    }
#undef IN
#undef SEAM
}

extern "C" void kernel_launch(void* const* d_in, const int* in_sizes, int n_in, void* d_out, int out_size, void* d_ws, size_t ws_size, hipStream_t stream) {
    static int grid = 0;
    if (grid == 0) {
        if (n_in != 21 || in_sizes[0] != MT * DM || out_size != MT * DM || ws_size < WS_END) { fprintf(stderr, "kernel_launch: unexpected shapes (n_in %d, in0 %d, out %d, ws %zu, need %zu)\n", n_in, n_in > 0 ? in_sizes[0] : -1, out_size, ws_size, (size_t)WS_END); grid = -1; return; }
        int dev = 0, cus = 0, per_cu = 0;
        hipGetDevice(&dev); hipDeviceGetAttribute(&cus, hipDeviceAttributeMultiprocessorCount, dev);
        if (hipFuncSetAttribute((const void*)mega_fwd, hipFuncAttributeMaxDynamicSharedMemorySize, LDS_BYTES) != hipSuccess) { fprintf(stderr, "kernel_launch: hipFuncSetAttribute failed\n"); grid = -1; return; }
        if (hipOccupancyMaxActiveBlocksPerMultiprocessor(&per_cu, (const void*)mega_fwd, NTHR, LDS_BYTES) != hipSuccess || per_cu < 1) { fprintf(stderr, "kernel_launch: occupancy query says %d blocks per CU\n", per_cu); (void)hipGetLastError(); per_cu = 1; }
        grid = cus > 0 ? cus : 256;
    }
    if (grid < 0) return;
    Args a{};
    a.x = (const float*)d_in[0]; a.pos = (const int*)d_in[1]; a.attn_pre = (const float*)d_in[2]; a.w_in = (const float*)d_in[3]; a.gate_w2 = (const float*)d_in[4]; a.gate_b = (const float*)d_in[5];
    a.gla_norm = (const float*)d_in[6]; a.lb_logits = (const float*)d_in[7]; a.hgrn_norm = (const float*)d_in[8]; a.q_norm = (const float*)d_in[9]; a.wq_b = (const float*)d_in[10]; a.kv_norm = (const float*)d_in[11];
    a.wkv_b = (const float*)d_in[12]; a.mla_out_norm = (const float*)d_in[13]; a.w_out = (const float*)d_in[14]; a.attn_post = (const float*)d_in[15]; a.ffn_pre = (const float*)d_in[16];
    a.w_gate = (const float*)d_in[17]; a.w_up = (const float*)d_in[18]; a.w_down = (const float*)d_in[19]; a.ffn_post = (const float*)d_in[20]; a.out = (float*)d_out; a.ws = (unsigned char*)d_ws;
    if (hipMemsetAsync((char*)d_ws + WS_BAR, 0, BAR_BYTES, stream) != hipSuccess) { fprintf(stderr, "kernel_launch: memset failed\n"); return; }
#if MK_PER_PHASE
    for (int p = 0; p < N_PHASES; ++p) { a.ph_lo = p; a.ph_hi = p + 1; hipLaunchKernelGGL(mega_fwd, dim3(grid), dim3(NTHR), LDS_BYTES, stream, a); }
#else
    a.ph_lo = 0; a.ph_hi = N_PHASES; void* args[] = {&a};
    hipError_t e = hipLaunchCooperativeKernel((const void*)mega_fwd, dim3(grid), dim3(NTHR), args, LDS_BYTES, stream);
    if (e != hipSuccess) fprintf(stderr, "kernel_launch: cooperative launch failed: %s (grid %d)\n", hipGetErrorString(e), grid);
#endif
}
```

```cpp
#include <hip/hip_runtime.h>
#include <hip/hip_cooperative_groups.h>
#include <cstdio>
#include <cstdint>
namespace cg = cooperative_groups;
#ifndef MK_PER_PHASE
#define MK_PER_PHASE 0
#endif
namespace pg8 {
#define PG8_LAS __attribute__((address_space(3)))
typedef unsigned short bf16_t;
typedef short bf16x8 __attribute__((ext_vector_type(8)));
typedef float f32x4 __attribute__((ext_vector_type(4)));
typedef unsigned u32x4 __attribute__((ext_vector_type(4)));
constexpr int BM = 256, BK = 64, HALF = 128, HTB = HALF * BK * 2  , STAGE_BYTES = 8 * HTB, NXCD = 8, WGM = 8;

__host__ __device__ __forceinline__ int lds_byte(int r, int c) { const int st = (r >> 4) * 2 + (c >> 5), rr = r & 15, cc = c & 31, ob = rr * 64 + cc * 2; return st * 1024 + (ob ^ (((ob >> 9) & 1) << 5)); }
__host__ __device__ __forceinline__ void stage_rc(int b, int& R, int& C) { const int st = b / 1024, sb = b % 1024, swz = sb ^ (((sb >> 9) & 1) << 5); R = (st >> 1) * 16 + swz / 64; C = (st & 1) * 32 + (swz % 64) / 2; }
__host__ __device__ __forceinline__ int perm32(int rho) { const int n = rho >> 4, i = rho & 15; return 8 * (i >> 2) + 4 * n + (i & 3); }

struct Unit { int pm, pn; };
struct Gemm { const bf16_t* A; const bf16_t* Bt; int M, N, K, lda, ldb; };

struct StaticOrder {
    int nM, nN, nwg, G, c;
    __host__ __device__ void init(int M, int N, int G_, int c_) { nM = M / BM; nN = N / BM; nwg = nM * nN; G = G_; c = c_; }
    __host__ __device__ bool next(int i, Unit& u) const {
        const long L = (long)i * G + c; if (L >= nwg) return false;
        int wgid = (int)L; { const int q = nwg / NXCD, r = nwg % NXCD, xcd = wgid % NXCD, off = wgid / NXCD; wgid = (xcd < r ? xcd * (q + 1) : r * (q + 1) + (xcd - r) * q) + off; }
        const int nig = WGM * nN, gid = wgid / nig, fm = gid * WGM, gsz = (nM - fm) < WGM ? (nM - fm) : WGM;
        u.pm = fm + ((wgid % nig) % gsz); u.pn = (wgid % nig) / gsz; return true;
    }
    __device__ __forceinline__ void a_ready(const Unit&) const {}
    __device__ __forceinline__ void done(const Unit&) const {}
};

__device__ __forceinline__ unsigned cvt_pk_bf16(float lo, float hi) { unsigned r; asm volatile("v_cvt_pk_bf16_f32 %0, %1, %2" : "=v"(r) : "v"(lo), "v"(hi)); return r; }
typedef float f32x2 __attribute__((ext_vector_type(2)));
#define PG8_GAS __attribute__((address_space(1)))
__device__ __forceinline__ float quad_col_sum(float v) { v += __shfl_xor(v, 16); v += __shfl_xor(v, 32); return v; }
struct EpiRow {
    static constexpr bool PERM = true, AFTER_DRAIN = false;
    bf16_t* O; int ldc; const float* rs; int rs_ld, rs_n; float rs_mul; float eps;
    float* ps; int ps_ld, pn_lo, pn_hi;
    __device__ __forceinline__ void operator()(const f32x4 (&acc)[2][2][4][2], const Unit& u, int wr, int wc, int fr, int fq) const {
        const int row0 = u.pm * BM + wr * 64 + fr, col0 = u.pn * BM + wc * 32 + 8 * fq;
        float* sq = (ps && u.pn >= pn_lo && u.pn < pn_hi) ? ps + (u.pn - pn_lo) * 4 + wc : nullptr;
        float scv[2][4];
#pragma unroll
        for (int ai = 0; ai < 2; ++ai)
#pragma unroll
            for (int m = 0; m < 4; ++m) { const int row = row0 + ai * HALF + m * 16;
                float sc = 1.f; if (rs) { if (rs_n == 0) sc = *(const PG8_GAS float*)(rs + row); else { float t = 0.f; for (int i = 0; i < rs_n; i += 4) { const f32x4 q = *(const PG8_GAS f32x4*)(rs + (size_t)row * rs_ld + i); t += (q[0] + q[1]) + (q[2] + q[3]); } sc = __builtin_amdgcn_rsqf(t * rs_mul + eps); } }
                scv[ai][m] = sc; }
#pragma unroll
        for (int ai = 0; ai < 2; ++ai)
#pragma unroll
            for (int m = 0; m < 4; ++m) { const int row = row0 + ai * HALF + m * 16; bf16_t* rowp = O + (size_t)row * ldc + col0;
                const float sc = scv[ai][m];
                float ss = 0.f;
#pragma unroll
                for (int bj = 0; bj < 2; ++bj) { f32x4 v0 = acc[ai][bj][m][0] * sc, v1 = acc[ai][bj][m][1] * sc;
                    ss += (v0[0] * v0[0] + v0[1] * v0[1]) + (v0[2] * v0[2] + v0[3] * v0[3]) + (v1[0] * v1[0] + v1[1] * v1[1]) + (v1[2] * v1[2] + v1[3] * v1[3]);
                    u32x4 w; w.x = cvt_pk_bf16(v0[0], v0[1]); w.y = cvt_pk_bf16(v0[2], v0[3]); w.z = cvt_pk_bf16(v1[0], v1[1]); w.w = cvt_pk_bf16(v1[2], v1[3]);
                    *(PG8_GAS u32x4*)(rowp + bj * HALF) = w; }
                if (sq) { ss = quad_col_sum(ss); if (fq == 0) *(PG8_GAS float*)(sq + (size_t)row * ps_ld) = ss; } }
    }
};
struct EpiQ {
    static constexpr bool PERM = true, AFTER_DRAIN = false;
    bf16_t* O; const float* ssq; float eps; float qscale; const float* ctab; const float* stab;
    __device__ __forceinline__ void operator()(const f32x4 (&acc)[2][2][4][2], const Unit& u, int wr, int wc, int fr, int fq) const {
        const int row0 = u.pm * BM + wr * 64 + fr; const bool rope = u.pn >= 4;
        float scv[2][4];
#pragma unroll
        for (int ai = 0; ai < 2; ++ai)
#pragma unroll
            for (int m = 0; m < 4; ++m) { const int row = row0 + ai * HALF + m * 16; const f32x4 s0 = *(const PG8_GAS f32x4*)(ssq + (size_t)row * 16), s1 = *(const PG8_GAS f32x4*)(ssq + (size_t)row * 16 + 4);
                scv[ai][m] = __builtin_amdgcn_rsqf((((s0[0] + s0[1]) + (s0[2] + s0[3])) + ((s1[0] + s1[1]) + (s1[2] + s1[3]))) * (1.f / 512.f) + eps) * qscale; }
#pragma unroll
        for (int ai = 0; ai < 2; ++ai)
#pragma unroll
            for (int m = 0; m < 4; ++m) { const int row = row0 + ai * HALF + m * 16; const float sc = scv[ai][m];
#pragma unroll
                for (int bj = 0; bj < 2; ++bj) { f32x4 v0 = acc[ai][bj][m][0] * sc, v1 = acc[ai][bj][m][1] * sc; int dst;
                    if (!rope) { const int c = u.pn * BM + bj * HALF + wc * 32 + 8 * fq; dst = (c >> 7) * 192 + (c & 127); }
                    else { const int c = (u.pn - 4) * BM + bj * HALF + wc * 32 + 8 * fq; const int hh = c >> 6, j = c & 63; dst = hh * 192 + 128 + j;
                        const f32x4 cs = *(const PG8_GAS f32x4*)(ctab + (size_t)row * 32 + (j >> 1)), sn = *(const PG8_GAS f32x4*)(stab + (size_t)row * 32 + (j >> 1));
                        f32x4 a0, a1; a0[0] = v0[0] * cs[0] - v0[1] * sn[0]; a0[1] = v0[1] * cs[0] + v0[0] * sn[0]; a0[2] = v0[2] * cs[1] - v0[3] * sn[1]; a0[3] = v0[3] * cs[1] + v0[2] * sn[1];
                        a1[0] = v1[0] * cs[2] - v1[1] * sn[2]; a1[1] = v1[1] * cs[2] + v1[0] * sn[2]; a1[2] = v1[2] * cs[3] - v1[3] * sn[3]; a1[3] = v1[3] * cs[3] + v1[2] * sn[3]; v0 = a0; v1 = a1; }
                    u32x4 w; w.x = cvt_pk_bf16(v0[0], v0[1]); w.y = cvt_pk_bf16(v0[2], v0[3]); w.z = cvt_pk_bf16(v1[0], v1[1]); w.w = cvt_pk_bf16(v1[2], v1[3]);
                    *(PG8_GAS u32x4*)(O + (size_t)row * 1536 + dst) = w; } }
    }
};
struct EpiVT {
    static constexpr bool PERM = true, AFTER_DRAIN = false;
    bf16_t* O; int ldc; const float* ssq; float eps;
    __device__ __forceinline__ void operator()(const f32x4 (&acc)[2][2][4][2], const Unit& u, int wr, int wc, int fr, int fq) const {
        const int row0 = u.pm * BM + wr * 64 + fr, col0 = u.pn * BM + wc * 32 + 8 * fq;
        f32x4 s[2][2];
#pragma unroll
        for (int bj = 0; bj < 2; ++bj)
#pragma unroll
            for (int n = 0; n < 2; ++n)
#pragma unroll
                for (int e = 0; e < 4; ++e) { const float* p = ssq + (size_t)(col0 + bj * HALF + 4 * n + e) * 16 + 8; const f32x4 s0 = *(const PG8_GAS f32x4*)p, s1 = *(const PG8_GAS f32x4*)(p + 4);
                    s[bj][n][e] = __builtin_amdgcn_rsqf((((s0[0] + s0[1]) + (s0[2] + s0[3])) + ((s1[0] + s1[1]) + (s1[2] + s1[3]))) * (1.f / 512.f) + eps); }
#pragma unroll
        for (int ai = 0; ai < 2; ++ai)
#pragma unroll
            for (int m = 0; m < 4; ++m) { bf16_t* rowp = O + (size_t)(row0 + ai * HALF + m * 16) * ldc + col0;
#pragma unroll
                for (int bj = 0; bj < 2; ++bj) { const f32x4 v0 = acc[ai][bj][m][0] * s[bj][0], v1 = acc[ai][bj][m][1] * s[bj][1];
                    u32x4 w; w.x = cvt_pk_bf16(v0[0], v0[1]); w.y = cvt_pk_bf16(v0[2], v0[3]); w.z = cvt_pk_bf16(v1[0], v1[1]); w.w = cvt_pk_bf16(v1[2], v1[3]);
                    *(PG8_GAS u32x4*)(rowp + bj * HALF) = w; } }
    }
};
struct EpiGU {
    static constexpr bool PERM = true, AFTER_DRAIN = false;
    bf16_t* O; int ldc; const float* rs;
    __device__ __forceinline__ void operator()(const f32x4 (&acc)[2][2][4][2], const Unit& u, int wr, int wc, int fr, int fq) const {
        const int row0 = u.pm * BM + wr * 64 + fr, col0 = u.pn * HALF + wc * 32 + 8 * fq;
        float scv[2][4];
#pragma unroll
        for (int ai = 0; ai < 2; ++ai)
#pragma unroll
            for (int m = 0; m < 4; ++m) scv[ai][m] = *(const PG8_GAS float*)(rs + row0 + ai * HALF + m * 16);
#pragma unroll
        for (int ai = 0; ai < 2; ++ai)
#pragma unroll
            for (int m = 0; m < 4; ++m) { const int row = row0 + ai * HALF + m * 16; const float sc = scv[ai][m]; float o[8];
#pragma unroll
                for (int n = 0; n < 2; ++n)
#pragma unroll
                    for (int e = 0; e < 4; ++e) { const float gv = acc[ai][0][m][n][e] * sc, uv = acc[ai][1][m][n][e] * sc;
                        o[4 * n + e] = gv * __builtin_amdgcn_rcpf(1.f + __expf(-gv)) * uv; }
                u32x4 w; w.x = cvt_pk_bf16(o[0], o[1]); w.y = cvt_pk_bf16(o[2], o[3]); w.z = cvt_pk_bf16(o[4], o[5]); w.w = cvt_pk_bf16(o[6], o[7]);
                *(PG8_GAS u32x4*)(O + (size_t)row * ldc + col0) = w; }
    }
};
template <class Epi, class Sched, bool ALIGN_EPI = false, bool SP2 = false>
__device__ __forceinline__ void gemm_phase(PG8_LAS unsigned char* lds, const Gemm g, const Sched& S, const Epi& E) {
    int tid_o = threadIdx.x; asm volatile("" : "+v"(tid_o)); const int tid = tid_o, wid = __builtin_amdgcn_readfirstlane(tid >> 6), lane = tid & 63, wr = wid >> 2, wc = wid & 3, fr = lane & 15, fq = lane >> 4;
    const int K = g.K, nt = K / BK;
    unsigned voffA[2], voffB[2];
#pragma unroll
    for (int i = 0; i < 2; ++i) { int R, C; stage_rc(tid * 16 + i * 8192, R, C); const int Rb = Epi::PERM ? ((R & ~31) + perm32(R & 31)) : R;
        voffA[i] = (unsigned)(R * g.lda + C) * 2u; voffB[i] = (unsigned)(Rb * g.ldb + C) * 2u; }
    const size_t kstep = (size_t)(BK * 2);
    const size_t hstepA = (size_t)HALF * g.lda * 2, hstepB = (size_t)HALF * g.ldb * 2;
    const size_t tstepA = 2 * hstepA, tstepB = 2 * hstepB;
    const unsigned ldsw = (unsigned)wid * 1024u;
    const int aoff = lds_byte(wr * 64 + fr, fq * 8), boff = lds_byte(wc * 32 + fr, fq * 8);
#define PG8_SA(b, h) (((b) * 2 + (h)) * HTB)
#define PG8_SB(b, h) ((4 + (b) * 2 + (h)) * HTB)
#define PG8_STAGE(bufoff, gbase, voff) do { _Pragma("unroll") for (int _i = 0; _i < 2; ++_i) \
        __builtin_amdgcn_global_load_lds((const unsigned*)((const char*)(gbase) + (voff)[_i]), (PG8_LAS unsigned*)(lds + (bufoff) + ldsw + _i * 8192), 16, 0, 0); } while (0)
#define PG8_LDA(dst, b, h) do { _Pragma("unroll") for (int m = 0; m < 4; ++m) _Pragma("unroll") for (int k = 0; k < 2; ++k) dst[m][k] = *(const PG8_LAS bf16x8*)(lds + PG8_SA(b, h) + aoff + m * 2048 + k * 1024); } while (0)
#define PG8_LDB(dst, b, h) do { _Pragma("unroll") for (int n = 0; n < 2; ++n) _Pragma("unroll") for (int k = 0; k < 2; ++k) dst[n][k] = *(const PG8_LAS bf16x8*)(lds + PG8_SB(b, h) + boff + n * 2048 + k * 1024); } while (0)
#define PG8_MMA(ai, bj, At, Bt) do { __builtin_amdgcn_s_setprio(1); _Pragma("unroll") for (int m = 0; m < 4; ++m) _Pragma("unroll") for (int n = 0; n < 2; ++n) _Pragma("unroll") for (int k = 0; k < 2; ++k) \
        acc[ai][bj][m][n] = __builtin_amdgcn_mfma_f32_16x16x32_bf16(Bt[n][k], At[m][k], acc[ai][bj][m][n], 0, 0, 0); __builtin_amdgcn_s_setprio(0); } while (0)
#define PG8_WAIT_V(n) asm volatile("s_waitcnt vmcnt(" #n ")" ::: "memory")
#define PG8_WAIT_L(n) asm volatile("s_waitcnt lgkmcnt(" #n ")" ::: "memory")
#define PG8_BAR __builtin_amdgcn_s_barrier()
#define PG8_SCHED __builtin_amdgcn_sched_barrier(0)
    Unit cur, nxt; int ui = 0;
    if (!S.next(0, cur)) return;
    f32x4 acc[2][2][4][2];
#pragma unroll
    for (int a = 0; a < 2; ++a)
#pragma unroll
        for (int b = 0; b < 2; ++b)
#pragma unroll
            for (int m = 0; m < 4; ++m)
#pragma unroll
                for (int n = 0; n < 2; ++n) acc[a][b][m][n] = (f32x4){0.f, 0.f, 0.f, 0.f};
    bf16x8 At[4][2], B0[2][2], B1[2][2];
    const char* cA = (const char*)g.A + (size_t)cur.pm * tstepA; const char* cB = (const char*)g.Bt + (size_t)cur.pn * tstepB;
    S.a_ready(cur);
    if constexpr (SP2) {
        PG8_STAGE(PG8_SB(0, 0), cB, voffB); PG8_STAGE(PG8_SB(0, 1), cB + hstepB, voffB); PG8_STAGE(PG8_SA(0, 0), cA, voffA); PG8_STAGE(PG8_SA(0, 1), cA + hstepA, voffA);
        if (wr == 1) PG8_BAR;
        PG8_WAIT_V(2); PG8_BAR;
        PG8_STAGE(PG8_SB(1, 0), cB + kstep, voffB); PG8_STAGE(PG8_SA(1, 0), cA + kstep, voffA); PG8_STAGE(PG8_SB(1, 1), cB + hstepB + kstep, voffB);
        PG8_WAIT_V(6); PG8_BAR;
    } else {
        PG8_STAGE(PG8_SB(0, 0), cB, voffB); PG8_STAGE(PG8_SA(0, 0), cA, voffA); PG8_STAGE(PG8_SB(0, 1), cB + hstepB, voffB); PG8_STAGE(PG8_SA(0, 1), cA + hstepA, voffA);
        if (wr == 1) PG8_BAR;
        PG8_WAIT_V(4); PG8_BAR;
        PG8_STAGE(PG8_SB(1, 0), cB + kstep, voffB); PG8_STAGE(PG8_SA(1, 0), cA + kstep, voffA); PG8_STAGE(PG8_SB(1, 1), cB + hstepB + kstep, voffB);
        PG8_WAIT_V(6); PG8_BAR;
    }
    for (;;) {
        const bool has_next = S.next(ui + 1, nxt);
        const char* nA = has_next ? (const char*)g.A + (size_t)nxt.pm * tstepA : cA; const char* nB = has_next ? (const char*)g.Bt + (size_t)nxt.pn * tstepB : cB;
        for (int t = 0; t < nt; t += 2) {
            const bool last = (t == nt - 2);
            const char* a1 = cA + (size_t)(t + 1) * kstep;
            const char* a2 = last ? nA : cA + (size_t)(t + 2) * kstep; const char* b2 = last ? nB : cB + (size_t)(t + 2) * kstep;
            const char* a3 = a2 + kstep; const char* b3 = b2 + kstep;
            if (last && has_next) S.a_ready(nxt);
            if constexpr (SP2) {
            PG8_LDB(B0, 0, 0); PG8_LDB(B1, 0, 1); PG8_SCHED; PG8_LDA(At, 0, 0); PG8_STAGE(PG8_SA(1, 1), a1 + hstepA, voffA);
            PG8_WAIT_V(8); PG8_WAIT_L(0); PG8_BAR; PG8_MMA(0, 0, At, B0); PG8_MMA(0, 1, At, B1); PG8_BAR; PG8_SCHED;
            PG8_LDA(At, 0, 1); PG8_STAGE(PG8_SB(0, 0), b2, voffB); PG8_STAGE(PG8_SB(0, 1), b2 + hstepB, voffB); PG8_STAGE(PG8_SA(0, 0), a2, voffA);
            PG8_WAIT_V(8); PG8_WAIT_L(0); PG8_BAR; PG8_MMA(1, 0, At, B0); PG8_MMA(1, 1, At, B1); PG8_BAR; PG8_SCHED;
            PG8_LDB(B0, 1, 0); PG8_LDB(B1, 1, 1); PG8_SCHED; PG8_LDA(At, 1, 0); PG8_STAGE(PG8_SA(0, 1), a2 + hstepA, voffA);
            PG8_WAIT_V(8); PG8_WAIT_L(0); PG8_BAR; PG8_MMA(0, 0, At, B0); PG8_MMA(0, 1, At, B1); PG8_BAR; PG8_SCHED;
            PG8_LDA(At, 1, 1); PG8_STAGE(PG8_SB(1, 0), b3, voffB); PG8_STAGE(PG8_SB(1, 1), b3 + hstepB, voffB); PG8_STAGE(PG8_SA(1, 0), a3, voffA);
            PG8_WAIT_V(8); PG8_WAIT_L(0); PG8_BAR; PG8_MMA(1, 0, At, B0); PG8_MMA(1, 1, At, B1); PG8_BAR; PG8_SCHED;
            } else {
            PG8_LDB(B0, 0, 0); PG8_SCHED; PG8_LDA(At, 0, 0); PG8_STAGE(PG8_SA(1, 1), a1 + hstepA, voffA);
            PG8_WAIT_L(8); PG8_BAR; PG8_WAIT_L(0); PG8_MMA(0, 0, At, B0); PG8_BAR; PG8_SCHED;
            PG8_LDB(B1, 0, 1); PG8_STAGE(PG8_SB(0, 0), b2, voffB);
            PG8_BAR; PG8_WAIT_L(0); PG8_MMA(0, 1, At, B1); PG8_BAR;
            PG8_LDA(At, 0, 1); PG8_STAGE(PG8_SA(0, 0), a2, voffA);
            PG8_BAR; PG8_WAIT_L(0); PG8_MMA(1, 0, At, B0); PG8_BAR; PG8_SCHED;
            PG8_STAGE(PG8_SB(0, 1), b2 + hstepB, voffB);
            PG8_WAIT_V(6); PG8_BAR; PG8_MMA(1, 1, At, B1); PG8_BAR;
            PG8_LDB(B0, 1, 0); PG8_SCHED; PG8_LDA(At, 1, 0); PG8_STAGE(PG8_SA(0, 1), a2 + hstepA, voffA);
            PG8_WAIT_L(8); PG8_BAR; PG8_WAIT_L(0); PG8_MMA(0, 0, At, B0); PG8_BAR; PG8_SCHED;
            PG8_LDB(B1, 1, 1); PG8_STAGE(PG8_SB(1, 0), b3, voffB);
            PG8_BAR; PG8_WAIT_L(0); PG8_MMA(0, 1, At, B1); PG8_BAR;
            PG8_LDA(At, 1, 1); PG8_STAGE(PG8_SA(1, 0), a3, voffA);
            PG8_BAR; PG8_WAIT_L(0); PG8_MMA(1, 0, At, B0); PG8_BAR; PG8_SCHED;
            PG8_STAGE(PG8_SB(1, 1), b3 + hstepB, voffB);
            PG8_WAIT_V(6); PG8_BAR; PG8_MMA(1, 1, At, B1); PG8_BAR;
            }
        }
        if constexpr (ALIGN_EPI) { if (wr == 0) PG8_BAR; }
        if constexpr (!Epi::AFTER_DRAIN) { E(acc, cur, wr, wc, fr, fq); S.done(cur); }
        if (!has_next) break;
#pragma unroll
        for (int a = 0; a < 2; ++a)
#pragma unroll
            for (int b = 0; b < 2; ++b)
#pragma unroll
                for (int m = 0; m < 4; ++m)
#pragma unroll
                    for (int n = 0; n < 2; ++n) acc[a][b][m][n] = (f32x4){0.f, 0.f, 0.f, 0.f};
        cur = nxt; cA = nA; cB = nB; ++ui;
        if constexpr (ALIGN_EPI) { if (wr == 1) PG8_BAR; }
    }
    PG8_WAIT_V(0);
    if constexpr (!ALIGN_EPI) { if (wr == 0) PG8_BAR; }
    PG8_BAR;
    if constexpr (Epi::AFTER_DRAIN) { E.fused(acc, cur, wr, wc, fr, fq, lds, wid, lane); S.done(cur); }
#undef PG8_SA
#undef PG8_SB
#undef PG8_STAGE
#undef PG8_LDA
#undef PG8_LDB
#undef PG8_MMA
#undef PG8_WAIT_V
#undef PG8_WAIT_L
#undef PG8_BAR
#undef PG8_SCHED
}
}
#define LAS __attribute__((address_space(3)))
typedef unsigned short bf16;
typedef short bf16x8 __attribute__((ext_vector_type(8)));
typedef float f32x4 __attribute__((ext_vector_type(4)));
typedef float f32x16 __attribute__((ext_vector_type(16)));
typedef unsigned u32x4 __attribute__((ext_vector_type(4)));
typedef unsigned u32x2 __attribute__((ext_vector_type(2)));
typedef float f32x2 __attribute__((ext_vector_type(2)));
constexpr int NB = 2, SEQ = 4096, MT = NB * SEQ, DM = 2048, DEPTH = 4, DIN = 4688, NIN = 4864, DFF = 5632, NGU = 2 * DFF;
constexpr int C_GQ = 0, C_GK = 256, C_GV = 512, C_GO = 1024, C_HQ = 1536, C_HF = 2048, C_HI = 2560, C_HO = 3072, C_QC = 3584, C_KVC = 4096, C_KPE = 4608, C_GLOW = 4672;
constexpr float EPS = 1e-6f;
constexpr float QSCALE = 0.07216878364870322f * 1.4426950408889634f;
constexpr int NWAVES = 8, NTHR = 512;
constexpr int LDS_BYTES = 143360;
constexpr size_t W_IN = 0, W_Q = W_IN + (size_t)NIN * DM, W_K = W_Q + 1536 * 512, W_V = W_K + 1024 * 512, W_OUT = W_V + 1024 * 512, W_GU = W_OUT + (size_t)DM * DM,
                 W_DN = W_GU + (size_t)NGU * DM, W_LAYER = W_DN + (size_t)DM * DFF;
constexpr size_t al256(size_t x) { return (x + 255) & ~(size_t)255; }
constexpr size_t WS_PS_QKV = 0, WS_PS_O = WS_PS_QKV + (size_t)MT * 16 * 4, WS_PS_M = WS_PS_O + (size_t)MT * 8 * 4, WS_RSTD = WS_PS_M + (size_t)MT * 32 * 4;
constexpr size_t WS_COS = WS_RSTD + MT * 4, WS_SIN = WS_COS + (size_t)MT * 32 * 4, WS_DL_G = WS_SIN + (size_t)MT * 32 * 4, WS_DL_H = WS_DL_G + 8 * 64 * 64 * 4, WS_KPE = WS_DL_H + 8 * 64 * 128 * 4;
constexpr size_t WS_ML = al256(WS_KPE + (size_t)MT * 64 * 2);
constexpr size_t WS_BAR = al256(WS_ML + (size_t)2 * 16 * 8 * 256 * 2 * 4), BAR_BYTES = 16384;
constexpr size_t WS_W = al256(WS_BAR + BAR_BYTES);
constexpr size_t WS_XB = al256(WS_W + W_LAYER * DEPTH * 2);
constexpr size_t WS_Y = WS_XB + (size_t)MT * DM * 2;
constexpr size_t WS_MB = WS_Y + (size_t)MT * DM * 2;
constexpr size_t WS_VT = WS_MB + (size_t)MT * DM * 2;
constexpr size_t WS_QE_G = WS_VT + (size_t)1024 * MT * 2;
constexpr size_t WS_QE_H = WS_QE_G + (size_t)MT * 256 * 2;
constexpr size_t WS_UT_G = WS_QE_H + (size_t)MT * 512 * 2;
constexpr size_t WS_UT_H = WS_UT_G + (size_t)8 * 64 * 128 * 64 * 4;
constexpr size_t WS_SP_G = WS_UT_H + (size_t)8 * 64 * 128 * 128 * 4;
constexpr size_t WS_SP_H = WS_SP_G + (size_t)8 * 64 * 128 * 64 * 2;
constexpr size_t WS_OI = WS_SP_H + (size_t)8 * 64 * 128 * 128 * 2;
constexpr size_t WS_R1 = WS_OI + (size_t)2 * MT * 512 * 4;
constexpr size_t WS_PROJ = WS_R1, WS_Q = WS_PROJ + (size_t)MT * NIN * 2, WS_KN = WS_Q + (size_t)MT * 1536 * 2, WS_R1_END = WS_KN + (size_t)MT * 1024 * 2;
constexpr size_t WS_HDN = WS_R1;
static_assert(WS_HDN + (size_t)MT * DFF * 2 <= WS_R1_END, "hdn overlay");
constexpr size_t WS_END = WS_R1_END;

struct Args {
    const float* x; const int* pos; const float* attn_pre; const float* w_in; const float* gate_w2; const float* gate_b; const float* gla_norm; const float* lb_logits; const float* hgrn_norm;
    const float* q_norm; const float* wq_b; const float* kv_norm; const float* wkv_b; const float* mla_out_norm; const float* w_out; const float* attn_post; const float* ffn_pre;
    const float* w_gate; const float* w_up; const float* w_down; const float* ffn_post; float* out; unsigned char* ws; int ph_lo, ph_hi;
};

__device__ __forceinline__ unsigned f2bf(float f) { unsigned u = __builtin_bit_cast(unsigned, f); return (u + 0x7fffu + ((u >> 16) & 1u)) >> 16; }
__device__ __forceinline__ float bf2f(bf16 b) { return __builtin_bit_cast(float, (unsigned)b << 16); }
__device__ __forceinline__ unsigned pk2(float lo, float hi) { return pg8::cvt_pk_bf16(lo, hi); }
__device__ __forceinline__ float wave_sum(float v) {
#pragma unroll
    for (int o = 1; o < 64; o <<= 1) v += __shfl_xor(v, o);
    return v;
}
__device__ __forceinline__ int crow(int r, int hi) { return (r & 3) + 8 * (r >> 2) + 4 * hi; }
#define LDS_WAIT() asm volatile("s_waitcnt lgkmcnt(0)" ::: "memory")

__device__ __forceinline__ int w_srccol(int mat, int n) {
    switch (mat) {
    case 0: return n < 1024 ? n : (n < 4672 ? n + 16 : (n < 4688 ? n - 3648 : -1));
    case 1: { if (n < 1024) return (n >> 7) * 192 + (n & 127); const int c = n - 1024, hh = c >> 6, j = c & 63, i = j >> 1; return hh * 192 + 128 + ((j & 1) ? i + 32 : i); }
    case 2: return (n >> 7) * 256 + (n & 127);
    case 3: return (n >> 7) * 256 + 128 + (n & 127);
    case 5: return (n >> 8) * 128 + (n & 127);
    default: return n;
    }
}
struct ConvDesc { const float* src; const float* gain; bf16* dst; int ldsrc, mat, gmin, k0, K, n0; };
constexpr int I_IN = (NIN / 128) * (DM / 128), I_Q = 12 * 4, I_K = 8 * 4, I_V = 8 * 4, I_OUT = 16 * 16, I_GU = (NGU / 128) * 16, I_DN = 16 * (DFF / 128);
constexpr int I_LAYER = I_IN + I_Q + I_K + I_V + I_OUT + I_GU + I_DN;
__device__ __forceinline__ ConvDesc conv_decode(const Args& a, int l, int r) {
    bf16* wl = (bf16*)(a.ws + WS_W) + (size_t)l * W_LAYER; ConvDesc d;
    if (r < I_IN) { const int nb = r % (NIN / 128), kb = r / (NIN / 128); d = ConvDesc{a.w_in + (size_t)l * DM * DIN, a.attn_pre + l * DM, wl + W_IN, DIN, 0, 0, kb * 128, DM, nb * 128}; return d; } r -= I_IN;
    if (r < I_Q) { const int nb = r % 12, kb = r / 12; d = ConvDesc{a.wq_b + (size_t)l * 512 * 1536, a.q_norm + l * 512, wl + W_Q, 1536, 1, 0, kb * 128, 512, nb * 128}; return d; } r -= I_Q;
    if (r < I_K) { const int nb = r % 8, kb = r / 8; d = ConvDesc{a.wkv_b + (size_t)l * 512 * 2048, a.kv_norm + l * 512, wl + W_K, 2048, 2, 0, kb * 128, 512, nb * 128}; return d; } r -= I_K;
    if (r < I_V) { const int nb = r % 8, kb = r / 8; d = ConvDesc{a.wkv_b + (size_t)l * 512 * 2048, a.kv_norm + l * 512, wl + W_V, 2048, 3, 0, kb * 128, 512, nb * 128}; return d; } r -= I_V;
    if (r < I_OUT) { const int nb = r % 16, kb = r / 16; d = ConvDesc{a.w_out + (size_t)l * DM * DM, a.mla_out_norm + l * 1024, wl + W_OUT, DM, 4, 1024, kb * 128, DM, nb * 128}; return d; } r -= I_OUT;
    if (r < I_GU) { const int nb = r % (NGU / 128), kb = r / (NGU / 128); d = ConvDesc{((nb & 1) ? a.w_up : a.w_gate) + (size_t)l * DM * DFF, a.ffn_pre + l * DM, wl + W_GU, DFF, 5, 0, kb * 128, DM, nb * 128}; return d; } r -= I_GU;
    { const int nb = r % 16, kb = r / 16; d = ConvDesc{a.w_down + (size_t)l * DFF * DM, nullptr, wl + W_DN, DM, 6, 0, kb * 128, DFF, nb * 128}; return d; }
}
__device__ __forceinline__ void conv_load(const ConvDesc& d, int tid, f32x4 (&v)[4][2], float (&gn)[4][2], float& zm) {
    const int c4 = tid & 31, rp = tid >> 5;
    zm = 1.f;
    const bool scat = (d.mat == 1 && d.n0 >= 1024);
    if (scat) {
        int sc[4];
#pragma unroll
        for (int j = 0; j < 4; ++j) sc[j] = w_srccol(d.mat, d.n0 + 4 * c4 + j);
#pragma unroll
        for (int i = 0; i < 4; ++i)
#pragma unroll
            for (int e = 0; e < 2; ++e) { const int k = d.k0 + i * 32 + 2 * rp + e; const float* rowp = d.src + (size_t)k * d.ldsrc;
                v[i][e][0] = rowp[sc[0]]; v[i][e][1] = rowp[sc[1]]; v[i][e][2] = rowp[sc[2]]; v[i][e][3] = rowp[sc[3]];
                gn[i][e] = (d.gain && k >= d.gmin) ? d.gain[k - d.gmin] : 1.f; }
    } else {
        const int sc0 = w_srccol(d.mat, d.n0 + 4 * c4); const bool zero = sc0 < 0; const int c0 = zero ? 0 : sc0; zm = zero ? 0.f : 1.f;
#pragma unroll
        for (int i = 0; i < 4; ++i)
#pragma unroll
            for (int e = 0; e < 2; ++e) { const int k = d.k0 + i * 32 + 2 * rp + e; const float* rowp = d.src + (size_t)k * d.ldsrc;
                v[i][e] = *(const f32x4*)(rowp + c0);
                gn[i][e] = (d.gain && k >= d.gmin) ? d.gain[k - d.gmin] : 1.f; }
    }
}
__device__ __forceinline__ void conv_store(const ConvDesc& d, int tid, const f32x4 (&v)[4][2], const float (&gn)[4][2], float zm, LAS unsigned* T) {
    constexpr int SD = 65; const int c4 = tid & 31, rp = tid >> 5;
#pragma unroll
    for (int i = 0; i < 4; ++i)
#pragma unroll
        for (int j = 0; j < 4; ++j) T[(c4 + 32 * j) * SD + i * 16 + rp] = pk2(v[i][0][j] * (gn[i][0] * zm), v[i][1][j] * (gn[i][1] * zm));
    __syncthreads();
#pragma unroll
    for (int i = 0; i < 4; ++i) { const int n = i * 32 + (tid >> 4), kc = tid & 15; const LAS unsigned* p = T + n * SD + kc * 4; u32x4 o; o.x = p[0]; o.y = p[1]; o.z = p[2]; o.w = p[3];
        *(u32x4*)(d.dst + (size_t)(d.n0 + 4 * (n & 31) + (n >> 5)) * d.K + d.k0 + kc * 8) = o; }
    __syncthreads();
}
__device__ __forceinline__ void conv_layer(const Args& a, int l, LAS unsigned char* lds, unsigned* ctr) {
    int tid_o = threadIdx.x; asm volatile("" : "+v"(tid_o)); const int tid = tid_o;
    LAS unsigned* T = (LAS unsigned*)lds; volatile LAS unsigned* slot = (volatile LAS unsigned*)(lds + 131072 + 128);
    int stat = (int)blockIdx.x - (int)gridDim.x;
    unsigned pend = 0u;
#define CONV_ISSUE() do { if (ctr && tid == 0) pend = __hip_atomic_fetch_add(ctr, 1u, __ATOMIC_RELAXED, __HIP_MEMORY_SCOPE_AGENT); } while (0)
#define CONV_NEXT(r) do { if (ctr) { sl ^= 1; if (tid == 0) slot[sl] = pend; __syncthreads(); r = (int)slot[sl]; } else { stat += (int)gridDim.x; r = stat; } } while (0)
    int sl = 0;
    __syncthreads();
    f32x4 vA[4][2], vB[4][2], vC[4][2]; float gA[4][2], gB[4][2], gC[4][2], zA, zB, zC; ConvDesc d0, d1, d2; int r0, r1, r2;
    CONV_ISSUE(); CONV_NEXT(r0); CONV_ISSUE(); if (r0 < I_LAYER) { d0 = conv_decode(a, l, r0); conv_load(d0, tid, vA, gA, zA); }
    CONV_NEXT(r1); CONV_ISSUE(); if (r1 < I_LAYER) { d1 = conv_decode(a, l, r1); conv_load(d1, tid, vB, gB, zB); }
    for (;;) {
        if (r0 >= I_LAYER) break;
        CONV_NEXT(r2); CONV_ISSUE(); if (r2 < I_LAYER) { d2 = conv_decode(a, l, r2); conv_load(d2, tid, vC, gC, zC); }
        conv_store(d0, tid, vA, gA, zA, T);
        if (r1 >= I_LAYER) break;
        CONV_NEXT(r0); CONV_ISSUE(); if (r0 < I_LAYER) { d0 = conv_decode(a, l, r0); conv_load(d0, tid, vA, gA, zA); }
        conv_store(d1, tid, vB, gB, zB, T);
        if (r2 >= I_LAYER) break;
        CONV_NEXT(r1); CONV_ISSUE(); if (r1 < I_LAYER) { d1 = conv_decode(a, l, r1); conv_load(d1, tid, vB, gB, zB); }
        conv_store(d2, tid, vC, gC, zC, T);
    }
#undef CONV_NEXT
#undef CONV_ISSUE
}
__device__ __forceinline__ void p0_prologue(const Args& a, LAS unsigned char* lds) {
    int tid_o = threadIdx.x; asm volatile("" : "+v"(tid_o)); const int tid = tid_o, lane = tid & 63, wave = tid >> 6, G = gridDim.x;
    const int gw = blockIdx.x * NWAVES + wave, NGW = G * NWAVES;
    conv_layer(a, 0, lds, nullptr);
    float* ct = (float*)(a.ws + WS_COS); float* st = (float*)(a.ws + WS_SIN);
    for (int i = blockIdx.x * NTHR + tid; i < MT * 32; i += G * NTHR) { const int row = i >> 5, j = i & 31;
        const float inv = (float)exp(-((double)(2 * j) / 64.0) * 9.210340371976184);
        const float ang = (float)a.pos[row] * inv;
        double rev = (double)ang * 0.15915494309189535; rev -= rint(rev); const float rf = (float)rev;
        ct[i] = __builtin_amdgcn_cosf(rf); st[i] = __builtin_amdgcn_sinf(rf); }
    bf16* xb = (bf16*)(a.ws + WS_XB); float* rstd = (float*)(a.ws + WS_RSTD);
    for (int row = gw; row < MT; row += NGW) { const f32x4* xr = (const f32x4*)(a.x + (size_t)row * DM); u32x2* ob = (u32x2*)(xb + (size_t)row * DM); float ss = 0.f;
#pragma unroll
        for (int j = 0; j < 8; ++j) { const f32x4 v = xr[j * 64 + lane]; ss += (v[0] * v[0] + v[1] * v[1]) + (v[2] * v[2] + v[3] * v[3]); u32x2 o; o.x = pk2(v[0], v[1]); o.y = pk2(v[2], v[3]); ob[j * 64 + lane] = o; }
        ss = wave_sum(ss);
        if (lane == 0) rstd[row] = 1.f / sqrtf(ss * (1.f / DM) + EPS); }
}
__device__ __forceinline__ void rowpass(const float* xin, float* xout, const bf16* mb, const float* ps, const float* gain, bf16* xb, float* rstd) {
    int tid_o = threadIdx.x; asm volatile("" : "+v"(tid_o)); const int tid = tid_o, lane = tid & 63, wave = tid >> 6; const int gw = blockIdx.x * NWAVES + wave, NGW = gridDim.x * NWAVES;
    for (int row = gw; row < MT; row += NGW) { const f32x4* xr = (const f32x4*)(xin + (size_t)row * DM); f32x4* xo = (f32x4*)(xout + (size_t)row * DM);
        const u32x2* mr = (const u32x2*)(mb + (size_t)row * DM); u32x2* ob = (u32x2*)(xb + (size_t)row * DM); const f32x4* gr = (const f32x4*)gain;
        f32x4 xv[8]; u32x2 mv[8];
#pragma unroll
        for (int j = 0; j < 8; ++j) { xv[j] = xr[j * 64 + lane]; mv[j] = mr[j * 64 + lane]; }
        const float r = 1.f / sqrtf(wave_sum(lane < 32 ? ps[(size_t)row * 32 + lane] : 0.f) * (1.f / DM) + EPS); float ss = 0.f;
#pragma unroll
        for (int j = 0; j < 8; ++j) { const int i = j * 64 + lane; f32x4 v = xv[j]; const u32x2 mm = mv[j]; const f32x4 g = gr[i];
            v[0] += __builtin_bit_cast(float, mm.x << 16) * r * g[0]; v[1] += __builtin_bit_cast(float, mm.x & 0xffff0000u) * r * g[1];
            v[2] += __builtin_bit_cast(float, mm.y << 16) * r * g[2]; v[3] += __builtin_bit_cast(float, mm.y & 0xffff0000u) * r * g[3];
            xv[j] = v; ss += (v[0] * v[0] + v[1] * v[1]) + (v[2] * v[2] + v[3] * v[3]); }
#pragma unroll
        for (int j = 0; j < 8; ++j) { const int i = j * 64 + lane; xo[i] = xv[j]; u32x2 o; o.x = pk2(xv[j][0], xv[j][1]); o.y = pk2(xv[j][2], xv[j][3]); ob[i] = o; }
        ss = wave_sum(ss);
        if (lane == 0) rstd[row] = 1.f / sqrtf(ss * (1.f / DM) + EPS); }
}
__device__ __forceinline__ f32x16 mfma32(bf16x8 a, bf16x8 b, f32x16 c) { return __builtin_amdgcn_mfma_f32_32x32x16_bf16(a, b, c, 0, 0, 0); }
template <int KD> __device__ __forceinline__ f32x16 mm32(const LAS bf16* A, int lda, const LAS bf16* B, int ldb, int ql, int g, f32x16 acc) {
#pragma unroll
    for (int s = 0; s < KD / 16; ++s) { const bf16x8 a = *(const LAS bf16x8*)(A + ql * lda + 16 * s + 8 * g), b = *(const LAS bf16x8*)(B + ql * ldb + 16 * s + 8 * g); acc = mfma32(a, b, acc); }
    return acc;
}
constexpr f32x16 Z16 = {0.f, 0.f, 0.f, 0.f, 0.f, 0.f, 0.f, 0.f, 0.f, 0.f, 0.f, 0.f, 0.f, 0.f, 0.f, 0.f};
template <int TYPE> __device__ __forceinline__ void gla_local_item(const Args& a, LAS unsigned char* lds, int layer, int bh, int c) {
    constexpr int DK = TYPE ? 128 : 64, QS = DK + 8, TS = 72, NTG = NTHR / DK, RPT = 64 / NTG;
    LAS bf16* qh = (LAS bf16*)lds; LAS bf16* kh = qh + 64 * QS; LAS bf16* ktT = kh + 64 * QS; LAS bf16* vT = ktT + DK * TS; LAS bf16* Ab = vT + 128 * TS; LAS float* bc = (LAS float*)(Ab + 64 * TS);
    int tid_o = threadIdx.x; asm volatile("" : "+v"(tid_o)); const int tid = tid_o, lane = tid & 63, wave = tid >> 6, ql = lane & 31, g = lane >> 5;
    const int b = bh >> 2, h = bh & 3, t0 = b * SEQ + c * 64;
    const bf16* prow = (const bf16*)(a.ws + WS_PROJ) + (size_t)t0 * NIN;
    const int d = tid % DK, tg = tid / DK;
    float lbv = 0.f;
    bf16 rq[RPT], rk[RPT], rv[16];
#pragma unroll
    for (int tt = 0; tt < RPT; ++tt) { const int t = tg * RPT + tt; rq[tt] = prow[(size_t)t * NIN + (TYPE ? C_HQ : C_GQ) + h * DK + d]; rk[tt] = prow[(size_t)t * NIN + (TYPE ? C_HF : C_GK) + h * DK + d]; }
    { const int e = tid & 127, tq = tid >> 7; const int vcol = (TYPE ? C_HI : C_GV) + h * 128 + e;
#pragma unroll
      for (int i = 0; i < 16; ++i) rv[i] = prow[(size_t)(tq * 16 + i) * NIN + vcol]; }
    {
        float run = 0.f;
        if (TYPE == 0) {
            float w2c[16]; const float* w2 = a.gate_w2 + (size_t)layer * 16 * 256 + h * 64 + d;
#pragma unroll
            for (int r = 0; r < 16; ++r) w2c[r] = w2[r * 256];
            const float bias = a.gate_b[layer * 256 + h * 64 + d];
            bf16x8 rg0[RPT], rg1[RPT];
#pragma unroll
            for (int tt = 0; tt < RPT; ++tt) { const bf16x8* gl = (const bf16x8*)(prow + (size_t)(tg * RPT + tt) * NIN + C_GLOW); rg0[tt] = gl[0]; rg1[tt] = gl[1]; }
#pragma unroll
            for (int tt = 0; tt < RPT; ++tt) { const int t = tg * RPT + tt; const bf16x8 g0 = rg0[tt], g1 = rg1[tt]; float z = bias;
#pragma unroll
                for (int r = 0; r < 8; ++r) { z += bf2f((bf16)g0[r]) * w2c[r]; z += bf2f((bf16)g1[r]) * w2c[8 + r]; }
                const float lg = (fminf(z, 0.f) - __logf(1.f + __expf(-fabsf(z)))) * (1.f / 16.f);
                run += lg; bc[t * DK + d] = run; }
        } else {
            const float* lg4 = a.lb_logits + h * 128 + d; const float l0 = lg4[0], l1 = lg4[512], l2 = lg4[1024], l3 = lg4[1536];
            const float mx = fmaxf(fmaxf(l0, l1), fmaxf(l2, l3)); const float e0 = __expf(l0 - mx), e1 = __expf(l1 - mx), e2 = __expf(l2 - mx), e3 = __expf(l3 - mx); const float inv = 1.f / (e0 + e1 + e2 + e3);
            lbv = (layer >= 1 ? e1 : 0.f) + (layer >= 2 ? e2 : 0.f) + (layer >= 3 ? e3 : 0.f); lbv *= inv;
#pragma unroll
            for (int tt = 0; tt < RPT; ++tt) { const int t = tg * RPT + tt; const float hf = bf2f(rk[tt]);
                const float sg = 1.f / (1.f + __expf(-hf)); const float f = lbv + (1.f - lbv) * sg;
                run += __logf(f); bc[t * DK + d] = run; }
        }
    }
    __syncthreads();
    { float off = 0.f; for (int s = 0; s < tg; ++s) off += bc[(s * RPT + RPT - 1) * DK + d];
      __syncthreads();
      if (tg > 0) for (int tt = 0; tt < RPT; ++tt) bc[(tg * RPT + tt) * DK + d] += off; }
    __syncthreads();
    {
        const float bmid = bc[32 * DK + d], blast = bc[63 * DK + d]; const float scale = TYPE ? 1.f : 0.125f;
        bf16* qe = (bf16*)(a.ws + (TYPE ? WS_QE_H : WS_QE_G));
#pragma unroll
        for (int tt = 0; tt < RPT; ++tt) { const int t = tg * RPT + tt; const float bb = bc[t * DK + d]; float q = bf2f(rq[tt]), k = bf2f(rk[tt]);
            if (TYPE == 1) { const float hq = q, hf = k; q = hq / (1.f + __expf(-hq)); k = (1.f - lbv) / (1.f + __expf(hf)); }
            q *= scale;
            qh[t * QS + d] = (bf16)f2bf(q * __expf(bb - bmid)); kh[t * QS + d] = (bf16)f2bf(k * __expf(bmid - bb));
            ktT[d * TS + t] = (bf16)f2bf(k * __expf(blast - bb));
            qe[(size_t)(t0 + t) * (4 * DK) + h * DK + d] = (bf16)f2bf(q * __expf(bb)); }
        if (tg == 0) ((float*)(a.ws + (TYPE ? WS_DL_H : WS_DL_G)))[(bh * 64 + c) * DK + d] = __expf(blast);
        const int e = tid & 127, tq = tid >> 7;
#pragma unroll
        for (int i = 0; i < 16; ++i) vT[e * TS + tq * 16 + i] = rv[i];
    }
    __syncthreads();
    if (wave < 4) {
        const int jb = wave & 1, ib = wave >> 1; f32x16 acc = Z16;
        if (!(jb == 1 && ib == 0)) acc = mm32<DK>(kh + 32 * jb * QS, QS, qh + 32 * ib * QS, QS, ql, g, acc);
        const int i = 32 * ib + ql;
#pragma unroll
        for (int rg = 0; rg < 4; ++rg) { const int j0 = 32 * jb + 8 * rg + 4 * g; float v[4];
#pragma unroll
            for (int e = 0; e < 4; ++e) v[e] = (j0 + e <= i) ? acc[4 * rg + e] : 0.f;
            u32x2 o; o.x = pk2(v[0], v[1]); o.y = pk2(v[2], v[3]); *(LAS u32x2*)(Ab + i * TS + j0) = o; }
    }
    __syncthreads();
    {
        const int eb = wave & 3, ib = wave >> 2; f32x16 acc = mm32<64>(vT + 32 * eb * TS, TS, Ab + 32 * ib * TS, TS, ql, g, Z16);
        float* oi = (float*)(a.ws + WS_OI) + (size_t)TYPE * MT * 512 + (size_t)(t0 + 32 * ib + ql) * 512 + h * 128 + 32 * eb + 4 * g;
#pragma unroll
        for (int rg = 0; rg < 4; ++rg) { f32x4 o = {acc[4 * rg], acc[4 * rg + 1], acc[4 * rg + 2], acc[4 * rg + 3]}; *(f32x4*)(oi + 8 * rg) = o; }
    }
    {
        float* ut = (float*)(a.ws + (TYPE ? WS_UT_H : WS_UT_G)) + (size_t)(bh * 64 + c) * 128 * DK;
#pragma unroll
        for (int bi = 0; bi < DK / 64; ++bi) { const int blk = wave + 8 * bi, eb = blk & 3, db = blk >> 2;
            f32x16 acc = mm32<64>(ktT + 32 * db * TS, TS, vT + 32 * eb * TS, TS, ql, g, Z16);
            float* up = ut + (size_t)(32 * eb + ql) * DK + 32 * db + 4 * g;
#pragma unroll
            for (int rg = 0; rg < 4; ++rg) { f32x4 o = {acc[4 * rg], acc[4 * rg + 1], acc[4 * rg + 2], acc[4 * rg + 3]}; *(f32x4*)(up + 8 * rg) = o; } }
    }
    __syncthreads();
}
__device__ __forceinline__ void scan_item(const Args& a, int si) {
    int tid_o = threadIdx.x; asm volatile("" : "+v"(tid_o)); const int tid = tid_o; const bool hg = si >= 32; const int DK = hg ? 128 : 64; const int idx = (hg ? si - 32 : si) * NTHR + tid;
    const int per_bh = 128 * DK / 4; const int bh = idx / per_bh, rem = idx % per_bh, e = rem / (DK / 4), d = 4 * (rem % (DK / 4));
    const float* ut = (const float*)(a.ws + (hg ? WS_UT_H : WS_UT_G)) + (size_t)bh * 64 * 128 * DK + (size_t)e * DK + d;
    bf16* sp = (bf16*)(a.ws + (hg ? WS_SP_H : WS_SP_G)) + (size_t)bh * 64 * 128 * DK + (size_t)e * DK + d;
    const float* dl = (const float*)(a.ws + (hg ? WS_DL_H : WS_DL_G)) + (size_t)bh * 64 * DK + d;
    f32x4 S = {0.f, 0.f, 0.f, 0.f}; const size_t cs = (size_t)128 * DK;
    for (int cb = 0; cb < 64; cb += 16) {
        f32x4 u[16], dd[16];
#pragma unroll
        for (int i = 0; i < 16; ++i) { u[i] = __builtin_nontemporal_load((const f32x4*)(ut + (size_t)(cb + i) * cs)); dd[i] = *(const f32x4*)(dl + (cb + i) * DK); }
#pragma unroll
        for (int i = 0; i < 16; ++i) { u32x2 o; o.x = pk2(S[0], S[1]); o.y = pk2(S[2], S[3]); *(u32x2*)(sp + (size_t)(cb + i) * cs) = o; S = dd[i] * S + u[i]; }
    }
}
__device__ __forceinline__ void gla_final_item(const Args& a, int layer, int item) {
    const int type = item >> 7, bh = (item >> 4) & 7, cg4 = item & 15; const int DK = type ? 128 : 64;
    int tid_o = threadIdx.x; asm volatile("" : "+v"(tid_o)); const int tid = tid_o, lane = tid & 63, wave = tid >> 6, ql = lane & 31, g = lane >> 5;
    const int b = bh >> 2, h = bh & 3, c = cg4 * 4 + (wave >> 1), t = b * SEQ + c * 64 + (wave & 1) * 32 + ql;
    const float* oi = (const float*)(a.ws + WS_OI) + (size_t)type * MT * 512 + (size_t)t * 512 + h * 128 + 4 * g;
    f32x16 acc[4];
#pragma unroll
    for (int eb = 0; eb < 4; ++eb)
#pragma unroll
        for (int rg = 0; rg < 4; ++rg) { const f32x4 v = *(const f32x4*)(oi + 32 * eb + 8 * rg); acc[eb][4 * rg] = v[0]; acc[eb][4 * rg + 1] = v[1]; acc[eb][4 * rg + 2] = v[2]; acc[eb][4 * rg + 3] = v[3]; }
    const bf16* qe = (const bf16*)(a.ws + (type ? WS_QE_H : WS_QE_G)) + (size_t)t * (4 * DK) + h * DK + 8 * g;
    const bf16* sp = (const bf16*)(a.ws + (type ? WS_SP_H : WS_SP_G)) + ((size_t)(bh * 64 + c) * 128 + ql) * DK + 8 * g;
    for (int s = 0; s < DK / 16; ++s) { const bf16x8 bq = *(const bf16x8*)(qe + 16 * s);
#pragma unroll
        for (int eb = 0; eb < 4; ++eb) { const bf16x8 as = *(const bf16x8*)(sp + (size_t)32 * eb * DK + 16 * s); acc[eb] = mfma32(as, bq, acc[eb]); } }
    float ss = 0.f;
#pragma unroll
    for (int eb = 0; eb < 4; ++eb)
#pragma unroll
        for (int r = 0; r < 16; ++r) ss += acc[eb][r] * acc[eb][r];
    ss += __shfl_xor(ss, 32);
    const float rstd = 1.f / sqrtf(ss * (1.f / 128.f) + EPS);
    const float* gn = (type ? a.hgrn_norm : a.gla_norm) + layer * 128 + 4 * g;
    const bf16* gt = (const bf16*)(a.ws + WS_PROJ) + (size_t)t * NIN + (type ? C_HO : C_GO) + h * 128 + 4 * g;
    bf16* y = (bf16*)(a.ws + WS_Y) + (size_t)t * DM + type * 512 + h * 128 + 4 * g;
    u32x2 gbv[16]; f32x4 gvv[16];
#pragma unroll
    for (int i = 0; i < 16; ++i) { const int eo = 32 * (i >> 2) + 8 * (i & 3); gbv[i] = *(const u32x2*)(gt + eo); gvv[i] = *(const f32x4*)(gn + eo); }
#pragma unroll
    for (int eb = 0; eb < 4; ++eb)
#pragma unroll
        for (int rg = 0; rg < 4; ++rg) { const int eo = 32 * eb + 8 * rg; const f32x4 gv = gvv[4 * eb + rg]; const u32x2 gb = gbv[4 * eb + rg];
            const float g0 = __builtin_bit_cast(float, gb.x << 16), g1 = __builtin_bit_cast(float, gb.x & 0xffff0000u), g2 = __builtin_bit_cast(float, gb.y << 16), g3 = __builtin_bit_cast(float, gb.y & 0xffff0000u);
            const float o0 = acc[eb][4 * rg] * rstd * gv[0] * g0 / (1.f + __expf(-g0)), o1 = acc[eb][4 * rg + 1] * rstd * gv[1] * g1 / (1.f + __expf(-g1));
            const float o2 = acc[eb][4 * rg + 2] * rstd * gv[2] * g2 / (1.f + __expf(-g2)), o3 = acc[eb][4 * rg + 3] * rstd * gv[3] * g3 / (1.f + __expf(-g3));
            u32x2 o; o.x = pk2(o0, o1); o.y = pk2(o2, o3); *(u32x2*)(y + eo) = o; }
}
__device__ __forceinline__ void kpe_rope(const Args& a) {
    const bf16* proj = (const bf16*)(a.ws + WS_PROJ); bf16* kpe = (bf16*)(a.ws + WS_KPE); const float* ct = (const float*)(a.ws + WS_COS); const float* st = (const float*)(a.ws + WS_SIN);
    int tid_o = threadIdx.x; asm volatile("" : "+v"(tid_o));
    for (int i = blockIdx.x * NTHR + tid_o; i < MT * 32; i += gridDim.x * NTHR) { const int row = i >> 5, j = i & 31;
        const float x1 = bf2f(proj[(size_t)row * NIN + C_KPE + j]), x2 = bf2f(proj[(size_t)row * NIN + C_KPE + 32 + j]); const float c = ct[i], s = st[i];
        *(unsigned*)(kpe + (size_t)row * 64 + 2 * j) = pk2(x1 * c - x2 * s, x2 * c + x1 * s); }
}
__device__ __forceinline__ void mla_out_norm(const Args& a) {
    bf16* y = (bf16*)(a.ws + WS_Y); const float* ssq = (const float*)(a.ws + WS_PS_O);
    int tid_o = threadIdx.x; asm volatile("" : "+v"(tid_o));
    const int i0 = blockIdx.x * NTHR + tid_o, stride = gridDim.x * NTHR;
    for (int ib = i0; ib < MT * 128; ib += 8 * stride) {
        u32x4 v[8]; f32x4 s0[8], s1[8];
#pragma unroll
        for (int k = 0; k < 8; ++k) { const int i = ib + k * stride; if (i < MT * 128) { const int row = i >> 7, cc = i & 127; v[k] = *(const u32x4*)(y + (size_t)row * DM + 1024 + cc * 8); s0[k] = *(const f32x4*)(ssq + (size_t)row * 8); s1[k] = *(const f32x4*)(ssq + (size_t)row * 8 + 4); } }
#pragma unroll
        for (int k = 0; k < 8; ++k) { const int i = ib + k * stride; if (i < MT * 128) { const int row = i >> 7, cc = i & 127;
            const float r = 1.f / sqrtf((((s0[k][0] + s0[k][1]) + (s0[k][2] + s0[k][3])) + ((s1[k][0] + s1[k][1]) + (s1[k][2] + s1[k][3]))) * (1.f / 1024.f) + EPS); u32x4 w = v[k];
#pragma unroll
            for (int e = 0; e < 4; ++e) { const float lo = __builtin_bit_cast(float, w[e] << 16) * r, hi = __builtin_bit_cast(float, w[e] & 0xffff0000u) * r; w[e] = pk2(lo, hi); }
            *(u32x4*)(y + (size_t)row * DM + 1024 + cc * 8) = w; } }
    }
}
constexpr int KSTR = 400, VSTR = 136, KBYTES = 64 * KSTR, VBYTES = 128 * VSTR, OSTR = 272;
__device__ __forceinline__ void attn_item(const Args& a, LAS unsigned char* lds, int b, int h, int qb, int t0, int t1, int part) {
    int tid_o = threadIdx.x; asm volatile("" : "+v"(tid_o)); const int tid = tid_o, lane = tid & 63, wave = tid >> 6, ql = lane & 31, g = lane >> 5;
    const bf16* Q = (const bf16*)(a.ws + WS_Q); const bf16* KN = (const bf16*)(a.ws + WS_KN); const bf16* KP = (const bf16*)(a.ws + WS_KPE); const bf16* VT = (const bf16*)(a.ws + WS_VT);
    const int tq0 = b * SEQ + qb * 256 + wave * 32, qpos = qb * 256 + wave * 32 + ql;
    bf16x8 qf[12];
    { const bf16* qp = Q + (size_t)(tq0 + ql) * 1536 + h * 192 + 8 * g;
#pragma unroll
      for (int s = 0; s < 12; ++s) qf[s] = *(const bf16x8*)(qp + 16 * s); }
    f32x16 oacc[4] = {Z16, Z16, Z16, Z16}; float mrun = 0.f, lrun = 0.f;
    const int nt = 4 * (qb + 1);
    int ksrc_off[3]; int kdst[3]; bool kpe_sel[3]; int vsrc_off[2]; int vdst[2];
#pragma unroll
    for (int i = 0; i < 3; ++i) { const int cid = tid + NTHR * i, key = cid / 24, cc = cid % 24; kpe_sel[i] = cc >= 16; kdst[i] = key * KSTR + cc * 16;
        ksrc_off[i] = kpe_sel[i] ? key * 64 + (cc - 16) * 8 : key * 1024 + h * 128 + cc * 8; }
#pragma unroll
    for (int i = 0; i < 2; ++i) { const int cid = tid + NTHR * i, row = cid >> 3, cc = cid & 7; vdst[i] = row * VSTR + cc * 16; vsrc_off[i] = (h * 128 + row) * MT + cc * 8; }
    u32x4 sk[3], sv[2];
#define ATT_GLOAD(t) do { const size_t tk = (size_t)(b * SEQ + (t) * 64); _Pragma("unroll") for (int i = 0; i < 3; ++i) sk[i] = kpe_sel[i] ? *(const u32x4*)(KP + tk * 64 + ksrc_off[i]) : *(const u32x4*)(KN + tk * 1024 + ksrc_off[i]); \
        _Pragma("unroll") for (int i = 0; i < 2; ++i) sv[i] = *(const u32x4*)(VT + (size_t)vsrc_off[i] + tk); } while (0)
#define ATT_LSTORE(kbuf, vbuf) do { LAS unsigned char* kb_ = lds + (kbuf) * KBYTES; LAS unsigned char* vb_ = lds + 2 * KBYTES + (vbuf) * VBYTES; \
        _Pragma("unroll") for (int i = 0; i < 3; ++i) *(LAS u32x4*)(kb_ + kdst[i]) = sk[i]; _Pragma("unroll") for (int i = 0; i < 2; ++i) { *(LAS u32x2*)(vb_ + vdst[i]) = (u32x2){sv[i].x, sv[i].y}; *(LAS u32x2*)(vb_ + vdst[i] + 8) = (u32x2){sv[i].z, sv[i].w}; } } while (0)
#define ATT_KLD(s_) (*(const LAS bf16x8*)(kp + 32 * (s_)))
#define ATT_KLD1(s_) (*(const LAS bf16x8*)(kp + 32 * KSTR + 32 * (s_)))
#define ATT_QK(kb_) do { const LAS unsigned char* kp = (kb_) + ql * KSTR + 16 * g; { const float ci = -mrun; _Pragma("unroll") for (int r = 0; r < 16; ++r) { p0[r] = ci; p1[r] = ci; } } \
        bf16x8 ka0 = ATT_KLD(0), ka1 = ATT_KLD1(0), kb0, kb1; \
        _Pragma("unroll") for (int s = 0; s < 12; s += 2) { \
            kb0 = ATT_KLD(s + 1); kb1 = ATT_KLD1(s + 1); __builtin_amdgcn_sched_barrier(0); \
            p0 = mfma32(ka0, qf[s], p0); p1 = mfma32(ka1, qf[s], p1); \
            if (s + 2 < 12) { ka0 = ATT_KLD(s + 2); ka1 = ATT_KLD1(s + 2); } __builtin_amdgcn_sched_barrier(0); \
            p0 = mfma32(kb0, qf[s + 1], p0); p1 = mfma32(kb1, qf[s + 1], p1); } } while (0)
#define ATT_SM() do { \
        if (t >= nt - 4) { const int kb0 = t * 64 + 4 * g; const float NEG = -__builtin_inff(); \
            _Pragma("unroll") for (int r = 0; r < 16; ++r) { const int kk = kb0 + (r & 3) + 8 * (r >> 2); if (kk > qpos) p0[r] = NEG; if (kk + 32 > qpos) p1[r] = NEG; } } \
        float mx = fmaxf(fmaxf(p0[0], p0[1]), p0[2]); \
        _Pragma("unroll") for (int r = 3; r < 15; r += 2) mx = fmaxf(fmaxf(mx, p0[r]), p0[r + 1]); \
        mx = fmaxf(fmaxf(mx, p0[15]), p1[0]); \
        _Pragma("unroll") for (int r = 1; r < 15; r += 2) mx = fmaxf(fmaxf(mx, p1[r]), p1[r + 1]); \
        mx = fmaxf(mx, p1[15]); \
        mx = fmaxf(mx, __shfl_xor(mx, 32)); \
          \
        { const bool first = (t == t0); \
          if (first || __builtin_amdgcn_ballot_w64(mx > 8.f) != 0ull) { \
            const float d = first ? mx : fmaxf(mx, 0.f); mrun += d; \
            _Pragma("unroll") for (int r = 0; r < 16; ++r) { p0[r] -= d; p1[r] -= d; } \
            if (!first) { const float alpha = __builtin_amdgcn_exp2f(-d); lrun *= alpha; \
                _Pragma("unroll") for (int db = 0; db < 4; ++db) oacc[db] = oacc[db] * alpha; } } } \
        float rs = 0.f; \
        _Pragma("unroll") for (int r = 0; r < 16; ++r) { p0[r] = __builtin_amdgcn_exp2f(p0[r]); p1[r] = __builtin_amdgcn_exp2f(p1[r]); rs += p0[r] + p1[r]; } \
        lrun += rs; \
        { u32x4 w; \
          w.x = pk2(p0[0], p0[1]); w.y = pk2(p0[2], p0[3]); w.z = pk2(p0[4], p0[5]); w.w = pk2(p0[6], p0[7]); pf[0] = __builtin_bit_cast(bf16x8, w); \
          w.x = pk2(p0[8], p0[9]); w.y = pk2(p0[10], p0[11]); w.z = pk2(p0[12], p0[13]); w.w = pk2(p0[14], p0[15]); pf[1] = __builtin_bit_cast(bf16x8, w); \
          w.x = pk2(p1[0], p1[1]); w.y = pk2(p1[2], p1[3]); w.z = pk2(p1[4], p1[5]); w.w = pk2(p1[6], p1[7]); pf[2] = __builtin_bit_cast(bf16x8, w); \
          w.x = pk2(p1[8], p1[9]); w.y = pk2(p1[10], p1[11]); w.z = pk2(p1[12], p1[13]); w.w = pk2(p1[14], p1[15]); pf[3] = __builtin_bit_cast(bf16x8, w); } } while (0)
#define ATT_VLD(i_) ({ const LAS unsigned char* vp_ = vbase + (32 * ((i_) & 3)) * VSTR + 32 * ((i_) >> 2); const u32x2 lo_ = *(const LAS u32x2*)vp_, hi_ = *(const LAS u32x2*)(vp_ + 16); (u32x4){lo_.x, lo_.y, hi_.x, hi_.y}; })
#define ATT_PV(vb_) do { const LAS unsigned char* vbase = (vb_) + ql * VSTR + 8 * g; u32x4 va = ATT_VLD(0), vb; \
        _Pragma("unroll") for (int i = 0; i < 16; i += 2) { \
            vb = ATT_VLD(i + 1); __builtin_amdgcn_sched_barrier(0); \
            oacc[i & 3] = mfma32(__builtin_bit_cast(bf16x8, va), pf[i >> 2], oacc[i & 3]); \
            if (i + 2 < 16) va = ATT_VLD(i + 2); __builtin_amdgcn_sched_barrier(0); \
            oacc[(i + 1) & 3] = mfma32(__builtin_bit_cast(bf16x8, vb), pf[(i + 1) >> 2], oacc[(i + 1) & 3]); } } while (0)
    const int wv = __builtin_amdgcn_readfirstlane(tid >> 6);
    f32x16 p0, p1; bf16x8 pf[4];
    __syncthreads();
    ATT_GLOAD(t0); ATT_LSTORE(0, 0);
    __syncthreads();
    const LAS unsigned char* vring = lds + 2 * KBYTES;
    if (wv < 4) {
        int vs = 0;
        for (int t = t0; t < t1; ++t) {
            if (t + 1 < t1) ATT_GLOAD(t + 1);
            const int bsel = (t - t0) & 1; const int vnext = vs == 2 ? 0 : vs + 1;
            ATT_QK(lds + bsel * KBYTES); ATT_SM(); ATT_PV(vring + vs * VBYTES);
            if (t + 1 < t1) ATT_LSTORE(bsel ^ 1, vnext);
            vs = vnext;
            __syncthreads();
        }
    } else {
        int vs = 0;
        for (int t = t0; t < t1; ++t) {
            const int bsel = (t - t0) & 1; const int vprev = vs == 0 ? 2 : vs - 1, vnext = vs == 2 ? 0 : vs + 1;
            if (t > t0) ATT_PV(vring + vprev * VBYTES);
            if (t + 1 < t1) ATT_GLOAD(t + 1);
            ATT_QK(lds + bsel * KBYTES); ATT_SM();
            if (t + 1 < t1) ATT_LSTORE(bsel ^ 1, vnext);
            vs = vnext;
            __syncthreads();
        }
        { const int vlast = vs == 0 ? 2 : vs - 1; ATT_PV(vring + vlast * VBYTES); }
    }
    __syncthreads();
#undef ATT_QK
#undef ATT_KLD
#undef ATT_KLD1
#undef ATT_SM
#undef ATT_PV
#undef ATT_VLD
#undef ATT_GLOAD
#undef ATT_LSTORE
    const float lt = lrun + __shfl_xor(lrun, 32), inv = 1.f / lt;
    LAS unsigned char* ob = lds + wave * (32 * OSTR);
#pragma unroll
    for (int db = 0; db < 4; ++db)
#pragma unroll
        for (int rg = 0; rg < 4; ++rg) { const float o0 = oacc[db][4 * rg] * inv, o1 = oacc[db][4 * rg + 1] * inv, o2 = oacc[db][4 * rg + 2] * inv, o3 = oacc[db][4 * rg + 3] * inv;
            u32x2 o; o.x = pk2(o0, o1); o.y = pk2(o2, o3); *(LAS u32x2*)(ob + ql * OSTR + (32 * db + 8 * rg + 4 * g) * 2) = o; }
    LDS_WAIT(); asm volatile("" ::: "memory");
    bf16* dst; int pitch;
    if (part < 0) { dst = (bf16*)(a.ws + WS_Y) + (size_t)tq0 * DM + 1024 + h * 128; pitch = DM; }
    else { const size_t rec = ((size_t)((part * 16 + b * 8 + h) * 8 + (qb - 8)) * 256 + wave * 32); dst = (bf16*)(a.ws + WS_MB) + rec * 128; pitch = 128;
        if (g == 0) { float* ml = (float*)(a.ws + WS_ML) + (rec + ql) * 2; ml[0] = mrun; ml[1] = lt; } }
#pragma unroll
    for (int i = 0; i < 8; ++i) { const int cid = lane + 64 * i, row = cid >> 4, cc = cid & 15; const u32x4 v = *(const LAS u32x4*)(ob + row * OSTR + cc * 16);
        *(u32x4*)(dst + (size_t)row * pitch + cc * 8) = v; }
}
__device__ __forceinline__ void attn_queue(const Args& a, LAS unsigned char* lds, unsigned* ctr) {
    int tid_o = threadIdx.x; asm volatile("" : "+v"(tid_o)); const int tid = tid_o; const int grp = (int)((unsigned)__builtin_amdgcn_s_getreg((3 << 11) | 20) & 7u);
    volatile LAS unsigned* slot = (volatile LAS unsigned*)(lds + 131072 + 160);
    for (;;) {
        if (tid == 0) *slot = __hip_atomic_fetch_add(ctr + grp, 1u, __ATOMIC_RELAXED, __HIP_MEMORY_SCOPE_AGENT);
        __syncthreads();
        const int idx = (int)*slot;
        if (idx >= 48) break;
        const int bh = 2 * grp + (idx >= 24 ? 1 : 0), k = idx >= 24 ? idx - 24 : idx; int qb, part;
        if (k < 20) { const int j = k / 5, r = k % 5; if (r == 0) { qb = 7 - j; part = -1; } else if (r < 3) { qb = 15 - 2 * j; part = r - 1; } else { qb = 14 - 2 * j; part = r - 3; } }
        else { qb = 23 - k; part = -1; }
        const int nt = 4 * (qb + 1);
        attn_item(a, lds, bh >> 3, bh & 7, qb, part == 1 ? nt / 2 : 0, part == 0 ? nt / 2 : nt, part);
    }
}
__device__ __forceinline__ void mla_finish(const Args& a) {
    int tid_o = threadIdx.x; asm volatile("" : "+v"(tid_o)); const int tid = tid_o, lane = tid & 63, wave = tid >> 6; const int gw = blockIdx.x * NWAVES + wave, NGW = gridDim.x * NWAVES;
    bf16* y = (bf16*)(a.ws + WS_Y); const bf16* po = (const bf16*)(a.ws + WS_MB); const float* ml = (const float*)(a.ws + WS_ML);
    for (int row = gw; row < MT; row += NGW) { const int b = row >> 12, pos = row & 4095, qb = pos >> 8, r = pos & 255; float o0[8], o1[8];
        if (qb < 8) {
#pragma unroll
            for (int h = 0; h < 8; ++h) { const unsigned u = *(const unsigned*)(y + (size_t)row * DM + 1024 + h * 128 + 2 * lane); o0[h] = __builtin_bit_cast(float, u << 16); o1[h] = __builtin_bit_cast(float, u & 0xffff0000u); }
        } else {
            unsigned ua[8], ub[8]; float ma[8], la[8], mb_[8], lb_[8];
#pragma unroll
            for (int h = 0; h < 8; ++h) { const size_t ra = (size_t)((0 * 16 + b * 8 + h) * 8 + (qb - 8)) * 256 + r, rb = (size_t)((1 * 16 + b * 8 + h) * 8 + (qb - 8)) * 256 + r;
                ua[h] = *(const unsigned*)(po + ra * 128 + 2 * lane); ub[h] = *(const unsigned*)(po + rb * 128 + 2 * lane);
                ma[h] = ml[ra * 2]; la[h] = ml[ra * 2 + 1]; mb_[h] = ml[rb * 2]; lb_[h] = ml[rb * 2 + 1]; }
#pragma unroll
            for (int h = 0; h < 8; ++h) { const float m = fmaxf(ma[h], mb_[h]); const float wa = la[h] * __builtin_amdgcn_exp2f(ma[h] - m), wb = lb_[h] * __builtin_amdgcn_exp2f(mb_[h] - m), iw = 1.f / (wa + wb);
                o0[h] = (wa * __builtin_bit_cast(float, ua[h] << 16) + wb * __builtin_bit_cast(float, ub[h] << 16)) * iw;
                o1[h] = (wa * __builtin_bit_cast(float, ua[h] & 0xffff0000u) + wb * __builtin_bit_cast(float, ub[h] & 0xffff0000u)) * iw; }
        }
        float ss = 0.f;
#pragma unroll
        for (int h = 0; h < 8; ++h) ss += o0[h] * o0[h] + o1[h] * o1[h];
        ss = wave_sum(ss); const float rs = 1.f / sqrtf(ss * (1.f / 1024.f) + EPS);
#pragma unroll
        for (int h = 0; h < 8; ++h) *(unsigned*)(y + (size_t)row * DM + 1024 + h * 128 + 2 * lane) = pk2(o0[h] * rs, o1[h] * rs);
    }
}
#define XB_TMO      128
#define XB_XCNT(j)  (256  + 64 * (j))
#define XB_XSUB(j)  (1280 + 64 * (j))
#define XB_XGEN(j)  (2304 + 64 * (j))
#define XB_TOP      3328
#define XB_TOPGEN   3392
#define XCD_BAR_WORDS 3456
#define XB_SPIN_CAP (1u << 18)

__device__ __forceinline__ unsigned xb_ld(unsigned* p)              { return __hip_atomic_load(p, __ATOMIC_RELAXED, __HIP_MEMORY_SCOPE_AGENT); }
__device__ __forceinline__ unsigned xb_add(unsigned* p, unsigned v) { return __hip_atomic_fetch_add(p, v, __ATOMIC_RELAXED, __HIP_MEMORY_SCOPE_AGENT); }
__device__ __forceinline__ unsigned xb_xcc_id() { return (unsigned)__builtin_amdgcn_s_getreg((3 << 11) | 20) & 0xFu; }
#define XB_SPIN(cond, bar) do { unsigned _sp = 0; while (cond) { __builtin_amdgcn_s_sleep(1); \
    if ((++_sp & 255u) == 0u) { if (xb_ld(&(bar)[XB_TMO])) break; if (_sp > XB_SPIN_CAP) { atomicAdd(&(bar)[XB_TMO], 1u); break; } } } } while (0)

struct XcdBarrier {
    unsigned* bar; unsigned x;
    volatile LAS unsigned* st;
};

__device__ __forceinline__ XcdBarrier xcd_barrier_post(unsigned* bar, volatile LAS unsigned* st) {
    XcdBarrier b; b.bar = bar; b.x = xb_xcc_id(); b.st = st;
    if (threadIdx.x == 0) (void)xb_add(&bar[XB_XCNT(b.x)], 1u);
    return b;
}
__device__ __forceinline__ void xcd_barrier_complete(unsigned* bar, unsigned x, unsigned& nloc, unsigned& nx) {
    const unsigned G = gridDim.x * gridDim.y * gridDim.z;
    unsigned sum, cnt, mine, sp = 0u;
    for (;;) {
        sum = 0u; cnt = 0u; mine = 0u;
#pragma unroll
        for (unsigned j = 0; j < 16; ++j) { const unsigned c = xb_ld(&bar[XB_XCNT(j)]); sum += c; cnt += (c > 0u) ? 1u : 0u; mine = (j == x) ? c : mine; }
        if (sum == G) break;
        __builtin_amdgcn_s_sleep(1);
        if ((++sp & 255u) == 0u) { if (xb_ld(&bar[XB_TMO])) break; if (sp > XB_SPIN_CAP) { atomicAdd(&bar[XB_TMO], 1u); break; } }
    }
    nloc = mine > 0u ? mine : 1u; nx = cnt > 0u ? cnt : 1u;
}

__device__ __forceinline__ void xcd_barrier(const XcdBarrier& b) {
    asm volatile("s_waitcnt vmcnt(0)" ::: "memory");
    __syncthreads();
    if (threadIdx.x == 0) {
        unsigned* bar = b.bar;
        __builtin_amdgcn_s_waitcnt(0);
        unsigned nloc = b.st[0], nx = b.st[1];
        if (nloc == 0u) { xcd_barrier_complete(bar, b.x, nloc, nx); b.st[0] = nloc; b.st[1] = nx; }
        const unsigned old = xb_add(&bar[XB_XSUB(b.x)], 1u);
        const unsigned gen = old / nloc;
        if (old + 1u == (gen + 1u) * nloc) {
            __builtin_amdgcn_fence(__ATOMIC_RELEASE, "agent");
            asm volatile("s_waitcnt vmcnt(0)" ::: "memory");
            const unsigned og = xb_add(&bar[XB_TOP], 1u);
            const unsigned tg = og / nx;
            if (og + 1u == (tg + 1u) * nx) xb_add(&bar[XB_TOPGEN], 1u);
            else XB_SPIN(xb_ld(&bar[XB_TOPGEN]) == tg, bar);
            __builtin_amdgcn_fence(__ATOMIC_ACQUIRE, "agent");
            xb_add(&bar[XB_XGEN(b.x)], 1u);
            asm volatile("s_waitcnt vmcnt(0)" ::: "memory");
        } else {
            XB_SPIN(xb_ld(&bar[XB_XGEN(b.x)]) == gen, bar);
            __builtin_amdgcn_fence(__ATOMIC_ACQUIRE, "agent");
            asm volatile("s_waitcnt vmcnt(0)" ::: "memory");
        }
    }
    __syncthreads();
}


constexpr int N_PHASES = 1 + 9 * DEPTH;
#ifndef DBG_REP
#define DBG_REP 0
#endif
#define NREP(j) (1 + ((DBG_REP >> (j)) & 1))
#ifndef DBG_MASK
#define DBG_MASK 0x3ff
#endif
#define EN(j) ((DBG_MASK >> (j)) & 1)
__device__ __forceinline__ const Args* args_here() { const Args* p = (const Args*)__builtin_amdgcn_kernarg_segment_ptr(); asm volatile("" : "+s"(p)); return p; }
#define PH_ARGS Args a = a_in; { __attribute__((address_space(1))) unsigned char* w_ = (__attribute__((address_space(1))) unsigned char*)a.ws; asm volatile("" : "+s"(w_)); a.ws = (unsigned char*)w_; } unsigned char* const ws = a.ws; (void)ws
__global__ void __launch_bounds__(NTHR, 2) mega_fwd(Args a_in) {
    extern __shared__ __attribute__((aligned(16))) unsigned char lds_raw[];
    LAS unsigned char* lds = (LAS unsigned char*)lds_raw;
    cg::grid_group grid = cg::this_grid();
    volatile LAS unsigned* bst = (volatile LAS unsigned*)(lds + 131072 + 64);
    if (threadIdx.x < 2) bst[threadIdx.x] = 0u;
    __syncthreads();
    XcdBarrier bar = xcd_barrier_post((unsigned*)(a_in.ws + WS_BAR), bst);
    const int G = gridDim.x, bid = blockIdx.x;
    const int lo = a_in.ph_lo, hi = a_in.ph_hi;
#define IN(k) (lo <= (k) && (k) < hi)
#define SEAM(k) do { if (IN((k) + 1)) { if ((k) == 0) grid.sync(); else { XcdBarrier b2 = bar; asm volatile("" : "+s"(b2.bar)); xcd_barrier(b2); } } } while (0)
    if (IN(0) && EN(0)) for (int rep = 0; rep < NREP(0); ++rep) { PH_ARGS; p0_prologue(a, lds); SEAM(0); }
    for (int l = 0; l < DEPTH; ++l) {
        const int P = 1 + 9 * l;
        if (IN(P) && EN(1)) for (int rep = 0; rep < NREP(1); ++rep) {
            PH_ARGS; const bf16* wl = (const bf16*)(ws + WS_W) + (size_t)l * W_LAYER;
            pg8::Gemm gm{(const bf16*)(ws + WS_XB), wl + W_IN, MT, NIN, DM, DM, DM}; pg8::StaticOrder S; S.init(MT, NIN, G, bid);
            pg8::EpiRow E{(bf16*)(ws + WS_PROJ), NIN, (const float*)(ws + WS_RSTD), 0, 0, 0.f, EPS, (float*)(ws + WS_PS_QKV), 16, 14, 18};
            pg8::gemm_phase<pg8::EpiRow, pg8::StaticOrder, true, true>(lds, gm, S, E); SEAM(P); }
        if (IN(P + 1) && EN(2)) for (int rep = 0; rep < NREP(2); ++rep) {
#define P1_ARGS PH_ARGS; const bf16* wl = (const bf16*)(ws + WS_W) + (size_t)l * W_LAYER; const bf16* proj = (const bf16*)(ws + WS_PROJ); float* ps_qkv = (float*)(ws + WS_PS_QKV); (void)wl; (void)proj; (void)ps_qkv
            { P1_ARGS; pg8::Gemm gm{proj + C_QC, wl + W_Q, MT, 1536, 512, NIN, 512}; pg8::StaticOrder S; S.init(MT, 1536, G, bid);
              pg8::EpiQ E{(bf16*)(ws + WS_Q), ps_qkv, EPS, QSCALE, (const float*)(ws + WS_COS), (const float*)(ws + WS_SIN)};
              pg8::gemm_phase<pg8::EpiQ, pg8::StaticOrder, true, true>(lds, gm, S, E); }
            { P1_ARGS; pg8::Gemm gm{proj + C_KVC, wl + W_K, MT, 1024, 512, NIN, 512}; pg8::StaticOrder S; S.init(MT, 1024, G, (bid + 64) % G);
              pg8::EpiRow E{(bf16*)(ws + WS_KN), 1024, ps_qkv + 8, 16, 8, 1.f / 512.f, EPS, nullptr, 0, 0, 0};
              pg8::gemm_phase<pg8::EpiRow, pg8::StaticOrder, true, true>(lds, gm, S, E); }
            { P1_ARGS; pg8::Gemm gm{wl + W_V, proj + C_KVC, 1024, MT, 512, 512, NIN}; pg8::StaticOrder S; S.init(1024, MT, G, (bid + 192) % G);
              pg8::EpiVT E{(bf16*)(ws + WS_VT), MT, ps_qkv, EPS};
              pg8::gemm_phase<pg8::EpiVT, pg8::StaticOrder, true, true>(lds, gm, S, E); }
            { PH_ARGS; kpe_rope(a); }
            __syncthreads();
            PH_ARGS;
            for (int it = bid; it < 1024; it += G) { if (it < 512) gla_local_item<0>(a, lds, l, it >> 6, it & 63); else gla_local_item<1>(a, lds, l, (it - 512) >> 6, it & 63); }
            SEAM(P + 1); }
        if (IN(P + 2) && EN(3)) for (int rep = 0; rep < NREP(3); ++rep) {
            PH_ARGS;
            for (int it = bid; it < 96; it += G) scan_item(a, it);
            attn_queue(a, lds, (unsigned*)(ws + WS_BAR) + 8 + 8 * l);
            if (l + 1 < DEPTH && rep == 0) conv_layer(a, l + 1, lds, (unsigned*)(ws + WS_BAR) + l);
            SEAM(P + 2); }
        if (IN(P + 3) && EN(4)) for (int rep = 0; rep < NREP(4); ++rep) {
            PH_ARGS;
            for (int it = bid; it < 256; it += G) gla_final_item(a, l, it);
            if (rep + 1 == NREP(4)) mla_finish(a);
            SEAM(P + 3); }
        if (IN(P + 4) && EN(5)) for (int rep = 0; rep < NREP(5); ++rep) {
            PH_ARGS; const bf16* wl = (const bf16*)(ws + WS_W) + (size_t)l * W_LAYER;
            pg8::Gemm gm{(const bf16*)(ws + WS_Y), wl + W_OUT, MT, DM, DM, DM, DM}; pg8::StaticOrder S; S.init(MT, DM, G, bid);
            pg8::EpiRow E{(bf16*)(ws + WS_MB), DM, nullptr, 0, 0, 0.f, EPS, (float*)(ws + WS_PS_M), 32, 0, 8};
            pg8::gemm_phase<pg8::EpiRow, pg8::StaticOrder, true, true>(lds, gm, S, E); SEAM(P + 4); }
        if (IN(P + 5) && EN(6)) { PH_ARGS; rowpass(l == 0 ? a.x : a.out, a.out, (const bf16*)(ws + WS_MB), (const float*)(ws + WS_PS_M), a.attn_post + l * DM, (bf16*)(ws + WS_XB), (float*)(ws + WS_RSTD)); SEAM(P + 5); }
        if (IN(P + 6) && EN(7)) for (int rep = 0; rep < NREP(7); ++rep) {
            PH_ARGS; const bf16* wl = (const bf16*)(ws + WS_W) + (size_t)l * W_LAYER;
            pg8::Gemm gm{(const bf16*)(ws + WS_XB), wl + W_GU, MT, NGU, DM, DM, DM}; pg8::StaticOrder S; S.init(MT, NGU, G, bid);
            pg8::EpiGU E{(bf16*)(ws + WS_HDN), DFF, (const float*)(ws + WS_RSTD)};
            pg8::gemm_phase<pg8::EpiGU, pg8::StaticOrder, true, true>(lds, gm, S, E); SEAM(P + 6); }
        if (IN(P + 7) && EN(8)) for (int rep = 0; rep < NREP(8); ++rep) {
            PH_ARGS; const bf16* wl = (const bf16*)(ws + WS_W) + (size_t)l * W_LAYER;
            pg8::Gemm gm{(const bf16*)(ws + WS_HDN), wl + W_DN, MT, DM, DFF, DFF, DFF}; pg8::StaticOrder S; S.init(MT, DM, G, bid);
            pg8::EpiRow E{(bf16*)(ws + WS_MB), DM, nullptr, 0, 0, 0.f, EPS, (float*)(ws + WS_PS_M), 32, 0, 8};
            pg8::gemm_phase<pg8::EpiRow, pg8::StaticOrder, true, true>(lds, gm, S, E); SEAM(P + 7); }
        if (IN(P + 8) && EN(9)) { PH_ARGS; rowpass(a.out, a.out, (const bf16*)(ws + WS_MB), (const float*)(ws + WS_PS_M), a.ffn_post + l * DM, (bf16*)(ws + WS_XB), (float*)(ws + WS_RSTD)); if (l + 1 < DEPTH) SEAM(P + 8); }
    }
#undef IN
#undef SEAM
}

extern "C" void kernel_launch(void* const* d_in, const int* in_sizes, int n_in, void* d_out, int out_size, void* d_ws, size_t ws_size, hipStream_t stream) {
    static int grid = 0;
    if (grid == 0) {
        if (n_in != 21 || in_sizes[0] != MT * DM || out_size != MT * DM || ws_size < WS_END) { fprintf(stderr, "kernel_launch: unexpected shapes (n_in %d, in0 %d, out %d, ws %zu, need %zu)\n", n_in, n_in > 0 ? in_sizes[0] : -1, out_size, ws_size, (size_t)WS_END); grid = -1; return; }
        int dev = 0, cus = 0, per_cu = 0;
        hipGetDevice(&dev); hipDeviceGetAttribute(&cus, hipDeviceAttributeMultiprocessorCount, dev);
        if (hipFuncSetAttribute((const void*)mega_fwd, hipFuncAttributeMaxDynamicSharedMemorySize, LDS_BYTES) != hipSuccess) { fprintf(stderr, "kernel_launch: hipFuncSetAttribute failed\n"); grid = -1; return; }
        if (hipOccupancyMaxActiveBlocksPerMultiprocessor(&per_cu, (const void*)mega_fwd, NTHR, LDS_BYTES) != hipSuccess || per_cu < 1) { fprintf(stderr, "kernel_launch: occupancy query says %d blocks per CU\n", per_cu); (void)hipGetLastError(); per_cu = 1; }
        grid = cus > 0 ? cus : 256;
    }
    if (grid < 0) return;
    Args a{};
    a.x = (const float*)d_in[0]; a.pos = (const int*)d_in[1]; a.attn_pre = (const float*)d_in[2]; a.w_in = (const float*)d_in[3]; a.gate_w2 = (const float*)d_in[4]; a.gate_b = (const float*)d_in[5];
    a.gla_norm = (const float*)d_in[6]; a.lb_logits = (const float*)d_in[7]; a.hgrn_norm = (const float*)d_in[8]; a.q_norm = (const float*)d_in[9]; a.wq_b = (const float*)d_in[10]; a.kv_norm = (const float*)d_in[11];
    a.wkv_b = (const float*)d_in[12]; a.mla_out_norm = (const float*)d_in[13]; a.w_out = (const float*)d_in[14]; a.attn_post = (const float*)d_in[15]; a.ffn_pre = (const float*)d_in[16];
    a.w_gate = (const float*)d_in[17]; a.w_up = (const float*)d_in[18]; a.w_down = (const float*)d_in[19]; a.ffn_post = (const float*)d_in[20]; a.out = (float*)d_out; a.ws = (unsigned char*)d_ws;
    if (hipMemsetAsync((char*)d_ws + WS_BAR, 0, BAR_BYTES, stream) != hipSuccess) { fprintf(stderr, "kernel_launch: memset failed\n"); return; }
#if MK_PER_PHASE
    for (int p = 0; p < N_PHASES; ++p) { a.ph_lo = p; a.ph_hi = p + 1; hipLaunchKernelGGL(mega_fwd, dim3(grid), dim3(NTHR), LDS_BYTES, stream, a); }
#else
    a.ph_lo = 0; a.ph_hi = N_PHASES; void* args[] = {&a};
    hipError_t e = hipLaunchCooperativeKernel((const void*)mega_fwd, dim3(grid), dim3(NTHR), args, LDS_BYTES, stream);
    if (e != hipSuccess) fprintf(stderr, "kernel_launch: cooperative launch failed: %s (grid %d)\n", hipGetErrorString(e), grid);
#endif
}
```

```cpp
#include <hip/hip_runtime.h>
#include <hip/hip_cooperative_groups.h>
#include <cstdio>
#include <cstdint>
namespace cg = cooperative_groups;
#ifndef MK_PER_PHASE
#define MK_PER_PHASE 0
#endif
namespace pg8 {
#define PG8_LAS __attribute__((address_space(3)))
typedef unsigned short bf16_t;
typedef short bf16x8 __attribute__((ext_vector_type(8)));
typedef float f32x4 __attribute__((ext_vector_type(4)));
typedef unsigned u32x4 __attribute__((ext_vector_type(4)));
constexpr int BM = 256, BK = 64, HALF = 128, HTB = HALF * BK * 2  , STAGE_BYTES = 8 * HTB, NXCD = 8, WGM = 8;

__host__ __device__ __forceinline__ int lds_byte(int r, int c) { const int st = (r >> 4) * 2 + (c >> 5), rr = r & 15, cc = c & 31, ob = rr * 64 + cc * 2; return st * 1024 + (ob ^ (((ob >> 9) & 1) << 5)); }
__host__ __device__ __forceinline__ void stage_rc(int b, int& R, int& C) { const int st = b / 1024, sb = b % 1024, swz = sb ^ (((sb >> 9) & 1) << 5); R = (st >> 1) * 16 + swz / 64; C = (st & 1) * 32 + (swz % 64) / 2; }
__host__ __device__ __forceinline__ int perm32(int rho) { const int n = rho >> 4, i = rho & 15; return 8 * (i >> 2) + 4 * n + (i & 3); }

struct Unit { int pm, pn; };
struct Gemm { const bf16_t* A; const bf16_t* Bt; int M, N, K, lda, ldb; };

struct StaticOrder {
    int nM, nN, nwg, G, c;
    __host__ __device__ void init(int M, int N, int G_, int c_) { nM = M / BM; nN = N / BM; nwg = nM * nN; G = G_; c = c_; }
    __host__ __device__ bool next(int i, Unit& u) const {
        const long L = (long)i * G + c; if (L >= nwg) return false;
        int wgid = (int)L; { const int q = nwg / NXCD, r = nwg % NXCD, xcd = wgid % NXCD, off = wgid / NXCD; wgid = (xcd < r ? xcd * (q + 1) : r * (q + 1) + (xcd - r) * q) + off; }
        const int nig = WGM * nN, gid = wgid / nig, fm = gid * WGM, gsz = (nM - fm) < WGM ? (nM - fm) : WGM;
        u.pm = fm + ((wgid % nig) % gsz); u.pn = (wgid % nig) / gsz; return true;
    }
    __device__ __forceinline__ void a_ready(const Unit&) const {}
    __device__ __forceinline__ void done(const Unit&) const {}
};

__device__ __forceinline__ unsigned cvt_pk_bf16(float lo, float hi) { unsigned r; asm volatile("v_cvt_pk_bf16_f32 %0, %1, %2" : "=v"(r) : "v"(lo), "v"(hi)); return r; }
typedef float f32x2 __attribute__((ext_vector_type(2)));
#define PG8_GAS __attribute__((address_space(1)))
__device__ __forceinline__ float quad_col_sum(float v) { v += __shfl_xor(v, 16); v += __shfl_xor(v, 32); return v; }
struct EpiRow {
    static constexpr bool PERM = true, AFTER_DRAIN = false;
    bf16_t* O; int ldc; const float* rs; int rs_ld, rs_n; float rs_mul; float eps;
    float* ps; int ps_ld, pn_lo, pn_hi;
    __device__ __forceinline__ void operator()(const f32x4 (&acc)[2][2][4][2], const Unit& u, int wr, int wc, int fr, int fq) const {
        const int row0 = u.pm * BM + wr * 64 + fr, col0 = u.pn * BM + wc * 32 + 8 * fq;
        float* sq = (ps && u.pn >= pn_lo && u.pn < pn_hi) ? ps + (u.pn - pn_lo) * 4 + wc : nullptr;
        float scv[2][4];
#pragma unroll
        for (int ai = 0; ai < 2; ++ai)
#pragma unroll
            for (int m = 0; m < 4; ++m) { const int row = row0 + ai * HALF + m * 16;
                float sc = 1.f; if (rs) { if (rs_n == 0) sc = *(const PG8_GAS float*)(rs + row); else { float t = 0.f; for (int i = 0; i < rs_n; i += 4) { const f32x4 q = *(const PG8_GAS f32x4*)(rs + (size_t)row * rs_ld + i); t += (q[0] + q[1]) + (q[2] + q[3]); } sc = __builtin_amdgcn_rsqf(t * rs_mul + eps); } }
                scv[ai][m] = sc; }
#pragma unroll
        for (int ai = 0; ai < 2; ++ai)
#pragma unroll
            for (int m = 0; m < 4; ++m) { const int row = row0 + ai * HALF + m * 16; bf16_t* rowp = O + (size_t)row * ldc + col0;
                const float sc = scv[ai][m];
                float ss = 0.f;
#pragma unroll
                for (int bj = 0; bj < 2; ++bj) { f32x4 v0 = acc[ai][bj][m][0] * sc, v1 = acc[ai][bj][m][1] * sc;
                    ss += (v0[0] * v0[0] + v0[1] * v0[1]) + (v0[2] * v0[2] + v0[3] * v0[3]) + (v1[0] * v1[0] + v1[1] * v1[1]) + (v1[2] * v1[2] + v1[3] * v1[3]);
                    u32x4 w; w.x = cvt_pk_bf16(v0[0], v0[1]); w.y = cvt_pk_bf16(v0[2], v0[3]); w.z = cvt_pk_bf16(v1[0], v1[1]); w.w = cvt_pk_bf16(v1[2], v1[3]);
                    *(PG8_GAS u32x4*)(rowp + bj * HALF) = w; }
                if (sq) { ss = quad_col_sum(ss); if (fq == 0) *(PG8_GAS float*)(sq + (size_t)row * ps_ld) = ss; } }
    }
};
struct EpiQ {
    static constexpr bool PERM = true, AFTER_DRAIN = false;
    bf16_t* O; const float* ssq; float eps; float qscale; const float* ctab; const float* stab;
    __device__ __forceinline__ void operator()(const f32x4 (&acc)[2][2][4][2], const Unit& u, int wr, int wc, int fr, int fq) const {
        const int row0 = u.pm * BM + wr * 64 + fr; const bool rope = u.pn >= 4;
        float scv[2][4];
#pragma unroll
        for (int ai = 0; ai < 2; ++ai)
#pragma unroll
            for (int m = 0; m < 4; ++m) { const int row = row0 + ai * HALF + m * 16; const f32x4 s0 = *(const PG8_GAS f32x4*)(ssq + (size_t)row * 16), s1 = *(const PG8_GAS f32x4*)(ssq + (size_t)row * 16 + 4);
                scv[ai][m] = __builtin_amdgcn_rsqf((((s0[0] + s0[1]) + (s0[2] + s0[3])) + ((s1[0] + s1[1]) + (s1[2] + s1[3]))) * (1.f / 512.f) + eps) * qscale; }
#pragma unroll
        for (int ai = 0; ai < 2; ++ai)
#pragma unroll
            for (int m = 0; m < 4; ++m) { const int row = row0 + ai * HALF + m * 16; const float sc = scv[ai][m];
#pragma unroll
                for (int bj = 0; bj < 2; ++bj) { f32x4 v0 = acc[ai][bj][m][0] * sc, v1 = acc[ai][bj][m][1] * sc; int dst;
                    if (!rope) { const int c = u.pn * BM + bj * HALF + wc * 32 + 8 * fq; dst = (c >> 7) * 192 + (c & 127); }
                    else { const int c = (u.pn - 4) * BM + bj * HALF + wc * 32 + 8 * fq; const int hh = c >> 6, j = c & 63; dst = hh * 192 + 128 + j;
                        const f32x4 cs = *(const PG8_GAS f32x4*)(ctab + (size_t)row * 32 + (j >> 1)), sn = *(const PG8_GAS f32x4*)(stab + (size_t)row * 32 + (j >> 1));
                        f32x4 a0, a1; a0[0] = v0[0] * cs[0] - v0[1] * sn[0]; a0[1] = v0[1] * cs[0] + v0[0] * sn[0]; a0[2] = v0[2] * cs[1] - v0[3] * sn[1]; a0[3] = v0[3] * cs[1] + v0[2] * sn[1];
                        a1[0] = v1[0] * cs[2] - v1[1] * sn[2]; a1[1] = v1[1] * cs[2] + v1[0] * sn[2]; a1[2] = v1[2] * cs[3] - v1[3] * sn[3]; a1[3] = v1[3] * cs[3] + v1[2] * sn[3]; v0 = a0; v1 = a1; }
                    u32x4 w; w.x = cvt_pk_bf16(v0[0], v0[1]); w.y = cvt_pk_bf16(v0[2], v0[3]); w.z = cvt_pk_bf16(v1[0], v1[1]); w.w = cvt_pk_bf16(v1[2], v1[3]);
                    *(PG8_GAS u32x4*)(O + (size_t)row * 1536 + dst) = w; } }
    }
};
struct EpiVT {
    static constexpr bool PERM = true, AFTER_DRAIN = false;
    bf16_t* O; int ldc; const float* ssq; float eps;
    __device__ __forceinline__ void operator()(const f32x4 (&acc)[2][2][4][2], const Unit& u, int wr, int wc, int fr, int fq) const {
        const int row0 = u.pm * BM + wr * 64 + fr, col0 = u.pn * BM + wc * 32 + 8 * fq;
        f32x4 s[2][2];
#pragma unroll
        for (int bj = 0; bj < 2; ++bj) { f32x4 t0[8], t1[8];
#pragma unroll
            for (int c = 0; c < 8; ++c) { const float* p = ssq + (size_t)(col0 + bj * HALF + c) * 16 + 8; t0[c] = *(const PG8_GAS f32x4*)p; t1[c] = *(const PG8_GAS f32x4*)(p + 4); }
#pragma unroll
            for (int c = 0; c < 8; ++c) s[bj][c >> 2][c & 3] = __builtin_amdgcn_rsqf((((t0[c][0] + t0[c][1]) + (t0[c][2] + t0[c][3])) + ((t1[c][0] + t1[c][1]) + (t1[c][2] + t1[c][3]))) * (1.f / 512.f) + eps); }
#pragma unroll
        for (int ai = 0; ai < 2; ++ai)
#pragma unroll
            for (int m = 0; m < 4; ++m) { bf16_t* rowp = O + (size_t)(row0 + ai * HALF + m * 16) * ldc + col0;
#pragma unroll
                for (int bj = 0; bj < 2; ++bj) { const f32x4 v0 = acc[ai][bj][m][0] * s[bj][0], v1 = acc[ai][bj][m][1] * s[bj][1];
                    u32x4 w; w.x = cvt_pk_bf16(v0[0], v0[1]); w.y = cvt_pk_bf16(v0[2], v0[3]); w.z = cvt_pk_bf16(v1[0], v1[1]); w.w = cvt_pk_bf16(v1[2], v1[3]);
                    *(PG8_GAS u32x4*)(rowp + bj * HALF) = w; } }
    }
};
struct EpiGU {
    static constexpr bool PERM = true, AFTER_DRAIN = false;
    bf16_t* O; int ldc; const float* rs;
    __device__ __forceinline__ void operator()(const f32x4 (&acc)[2][2][4][2], const Unit& u, int wr, int wc, int fr, int fq) const {
        const int row0 = u.pm * BM + wr * 64 + fr, col0 = u.pn * HALF + wc * 32 + 8 * fq;
        float scv[2][4];
#pragma unroll
        for (int ai = 0; ai < 2; ++ai)
#pragma unroll
            for (int m = 0; m < 4; ++m) scv[ai][m] = *(const PG8_GAS float*)(rs + row0 + ai * HALF + m * 16);
#pragma unroll
        for (int ai = 0; ai < 2; ++ai)
#pragma unroll
            for (int m = 0; m < 4; ++m) { const int row = row0 + ai * HALF + m * 16; const float sc = scv[ai][m]; float o[8];
#pragma unroll
                for (int n = 0; n < 2; ++n)
#pragma unroll
                    for (int e = 0; e < 4; ++e) { const float gv = acc[ai][0][m][n][e] * sc, uv = acc[ai][1][m][n][e] * sc;
                        o[4 * n + e] = gv * __builtin_amdgcn_rcpf(1.f + __expf(-gv)) * uv; }
                u32x4 w; w.x = cvt_pk_bf16(o[0], o[1]); w.y = cvt_pk_bf16(o[2], o[3]); w.z = cvt_pk_bf16(o[4], o[5]); w.w = cvt_pk_bf16(o[6], o[7]);
                *(PG8_GAS u32x4*)(O + (size_t)row * ldc + col0) = w; }
    }
};
template <class Epi, class Sched, bool ALIGN_EPI = false, bool SP2 = false>
__device__ __forceinline__ void gemm_phase(PG8_LAS unsigned char* lds, const Gemm g, const Sched& S, const Epi& E) {
    int tid_o = threadIdx.x; asm volatile("" : "+v"(tid_o)); const int tid = tid_o, wid = __builtin_amdgcn_readfirstlane(tid >> 6), lane = tid & 63, wr = wid >> 2, wc = wid & 3, fr = lane & 15, fq = lane >> 4;
    const int K = g.K, nt = K / BK;
    unsigned voffA[2], voffB[2];
#pragma unroll
    for (int i = 0; i < 2; ++i) { int R, C; stage_rc(tid * 16 + i * 8192, R, C); const int Rb = Epi::PERM ? ((R & ~31) + perm32(R & 31)) : R;
        voffA[i] = (unsigned)(R * g.lda + C) * 2u; voffB[i] = (unsigned)(Rb * g.ldb + C) * 2u; }
    const size_t kstep = (size_t)(BK * 2);
    const size_t hstepA = (size_t)HALF * g.lda * 2, hstepB = (size_t)HALF * g.ldb * 2;
    const size_t tstepA = 2 * hstepA, tstepB = 2 * hstepB;
    const unsigned ldsw = (unsigned)wid * 1024u;
    const int aoff = lds_byte(wr * 64 + fr, fq * 8), boff = lds_byte(wc * 32 + fr, fq * 8);
#define PG8_SA(b, h) (((b) * 2 + (h)) * HTB)
#define PG8_SB(b, h) ((4 + (b) * 2 + (h)) * HTB)
#define PG8_STAGE(bufoff, gbase, voff) do { _Pragma("unroll") for (int _i = 0; _i < 2; ++_i) \
        __builtin_amdgcn_global_load_lds((const unsigned*)((const char*)(gbase) + (voff)[_i]), (PG8_LAS unsigned*)(lds + (bufoff) + ldsw + _i * 8192), 16, 0, 0); } while (0)
#define PG8_LDA(dst, b, h) do { _Pragma("unroll") for (int m = 0; m < 4; ++m) _Pragma("unroll") for (int k = 0; k < 2; ++k) dst[m][k] = *(const PG8_LAS bf16x8*)(lds + PG8_SA(b, h) + aoff + m * 2048 + k * 1024); } while (0)
#define PG8_LDB(dst, b, h) do { _Pragma("unroll") for (int n = 0; n < 2; ++n) _Pragma("unroll") for (int k = 0; k < 2; ++k) dst[n][k] = *(const PG8_LAS bf16x8*)(lds + PG8_SB(b, h) + boff + n * 2048 + k * 1024); } while (0)
#define PG8_MMA(ai, bj, At, Bt) do { __builtin_amdgcn_s_setprio(1); _Pragma("unroll") for (int m = 0; m < 4; ++m) _Pragma("unroll") for (int n = 0; n < 2; ++n) _Pragma("unroll") for (int k = 0; k < 2; ++k) \
        acc[ai][bj][m][n] = __builtin_amdgcn_mfma_f32_16x16x32_bf16(Bt[n][k], At[m][k], acc[ai][bj][m][n], 0, 0, 0); __builtin_amdgcn_s_setprio(0); } while (0)
#define PG8_WAIT_V(n) asm volatile("s_waitcnt vmcnt(" #n ")" ::: "memory")
#define PG8_WAIT_L(n) asm volatile("s_waitcnt lgkmcnt(" #n ")" ::: "memory")
#define PG8_BAR __builtin_amdgcn_s_barrier()
#define PG8_SCHED __builtin_amdgcn_sched_barrier(0)
    Unit cur, nxt; int ui = 0;
    if (!S.next(0, cur)) return;
    f32x4 acc[2][2][4][2];
#pragma unroll
    for (int a = 0; a < 2; ++a)
#pragma unroll
        for (int b = 0; b < 2; ++b)
#pragma unroll
            for (int m = 0; m < 4; ++m)
#pragma unroll
                for (int n = 0; n < 2; ++n) acc[a][b][m][n] = (f32x4){0.f, 0.f, 0.f, 0.f};
    bf16x8 At[4][2], B0[2][2], B1[2][2];
    const char* cA = (const char*)g.A + (size_t)cur.pm * tstepA; const char* cB = (const char*)g.Bt + (size_t)cur.pn * tstepB;
    S.a_ready(cur);
    if constexpr (SP2) {
        PG8_STAGE(PG8_SB(0, 0), cB, voffB); PG8_STAGE(PG8_SB(0, 1), cB + hstepB, voffB); PG8_STAGE(PG8_SA(0, 0), cA, voffA); PG8_STAGE(PG8_SA(0, 1), cA + hstepA, voffA);
        if (wr == 1) PG8_BAR;
        PG8_WAIT_V(2); PG8_BAR;
        PG8_STAGE(PG8_SB(1, 0), cB + kstep, voffB); PG8_STAGE(PG8_SA(1, 0), cA + kstep, voffA); PG8_STAGE(PG8_SB(1, 1), cB + hstepB + kstep, voffB);
        PG8_WAIT_V(6); PG8_BAR;
    } else {
        PG8_STAGE(PG8_SB(0, 0), cB, voffB); PG8_STAGE(PG8_SA(0, 0), cA, voffA); PG8_STAGE(PG8_SB(0, 1), cB + hstepB, voffB); PG8_STAGE(PG8_SA(0, 1), cA + hstepA, voffA);
        if (wr == 1) PG8_BAR;
        PG8_WAIT_V(4); PG8_BAR;
        PG8_STAGE(PG8_SB(1, 0), cB + kstep, voffB); PG8_STAGE(PG8_SA(1, 0), cA + kstep, voffA); PG8_STAGE(PG8_SB(1, 1), cB + hstepB + kstep, voffB);
        PG8_WAIT_V(6); PG8_BAR;
    }
    for (;;) {
        const bool has_next = S.next(ui + 1, nxt);
        const char* nA = has_next ? (const char*)g.A + (size_t)nxt.pm * tstepA : cA; const char* nB = has_next ? (const char*)g.Bt + (size_t)nxt.pn * tstepB : cB;
        for (int t = 0; t < nt; t += 2) {
            const bool last = (t == nt - 2);
            const char* a1 = cA + (size_t)(t + 1) * kstep;
            const char* a2 = last ? nA : cA + (size_t)(t + 2) * kstep; const char* b2 = last ? nB : cB + (size_t)(t + 2) * kstep;
            const char* a3 = a2 + kstep; const char* b3 = b2 + kstep;
            if (last && has_next) S.a_ready(nxt);
            if constexpr (SP2) {
            PG8_LDB(B0, 0, 0); PG8_LDB(B1, 0, 1); PG8_SCHED; PG8_LDA(At, 0, 0); PG8_STAGE(PG8_SA(1, 1), a1 + hstepA, voffA);
            PG8_WAIT_V(8); PG8_WAIT_L(0); PG8_BAR; PG8_MMA(0, 0, At, B0); PG8_MMA(0, 1, At, B1); PG8_BAR; PG8_SCHED;
            PG8_LDA(At, 0, 1); PG8_STAGE(PG8_SB(0, 0), b2, voffB); PG8_STAGE(PG8_SB(0, 1), b2 + hstepB, voffB); PG8_STAGE(PG8_SA(0, 0), a2, voffA);
            PG8_WAIT_V(8); PG8_WAIT_L(0); PG8_BAR; PG8_MMA(1, 0, At, B0); PG8_MMA(1, 1, At, B1); PG8_BAR; PG8_SCHED;
            PG8_LDB(B0, 1, 0); PG8_LDB(B1, 1, 1); PG8_SCHED; PG8_LDA(At, 1, 0); PG8_STAGE(PG8_SA(0, 1), a2 + hstepA, voffA);
            PG8_WAIT_V(8); PG8_WAIT_L(0); PG8_BAR; PG8_MMA(0, 0, At, B0); PG8_MMA(0, 1, At, B1); PG8_BAR; PG8_SCHED;
            PG8_LDA(At, 1, 1); PG8_STAGE(PG8_SB(1, 0), b3, voffB); PG8_STAGE(PG8_SB(1, 1), b3 + hstepB, voffB); PG8_STAGE(PG8_SA(1, 0), a3, voffA);
            PG8_WAIT_V(8); PG8_WAIT_L(0); PG8_BAR; PG8_MMA(1, 0, At, B0); PG8_MMA(1, 1, At, B1); PG8_BAR; PG8_SCHED;
            } else {
            PG8_LDB(B0, 0, 0); PG8_SCHED; PG8_LDA(At, 0, 0); PG8_STAGE(PG8_SA(1, 1), a1 + hstepA, voffA);
            PG8_WAIT_L(8); PG8_BAR; PG8_WAIT_L(0); PG8_MMA(0, 0, At, B0); PG8_BAR; PG8_SCHED;
            PG8_LDB(B1, 0, 1); PG8_STAGE(PG8_SB(0, 0), b2, voffB);
            PG8_BAR; PG8_WAIT_L(0); PG8_MMA(0, 1, At, B1); PG8_BAR;
            PG8_LDA(At, 0, 1); PG8_STAGE(PG8_SA(0, 0), a2, voffA);
            PG8_BAR; PG8_WAIT_L(0); PG8_MMA(1, 0, At, B0); PG8_BAR; PG8_SCHED;
            PG8_STAGE(PG8_SB(0, 1), b2 + hstepB, voffB);
            PG8_WAIT_V(6); PG8_BAR; PG8_MMA(1, 1, At, B1); PG8_BAR;
            PG8_LDB(B0, 1, 0); PG8_SCHED; PG8_LDA(At, 1, 0); PG8_STAGE(PG8_SA(0, 1), a2 + hstepA, voffA);
            PG8_WAIT_L(8); PG8_BAR; PG8_WAIT_L(0); PG8_MMA(0, 0, At, B0); PG8_BAR; PG8_SCHED;
            PG8_LDB(B1, 1, 1); PG8_STAGE(PG8_SB(1, 0), b3, voffB);
            PG8_BAR; PG8_WAIT_L(0); PG8_MMA(0, 1, At, B1); PG8_BAR;
            PG8_LDA(At, 1, 1); PG8_STAGE(PG8_SA(1, 0), a3, voffA);
            PG8_BAR; PG8_WAIT_L(0); PG8_MMA(1, 0, At, B0); PG8_BAR; PG8_SCHED;
            PG8_STAGE(PG8_SB(1, 1), b3 + hstepB, voffB);
            PG8_WAIT_V(6); PG8_BAR; PG8_MMA(1, 1, At, B1); PG8_BAR;
            }
        }
        if constexpr (ALIGN_EPI) { if (wr == 0) PG8_BAR; }
        if constexpr (!Epi::AFTER_DRAIN) { E(acc, cur, wr, wc, fr, fq); S.done(cur); }
        if (!has_next) break;
#pragma unroll
        for (int a = 0; a < 2; ++a)
#pragma unroll
            for (int b = 0; b < 2; ++b)
#pragma unroll
                for (int m = 0; m < 4; ++m)
#pragma unroll
                    for (int n = 0; n < 2; ++n) acc[a][b][m][n] = (f32x4){0.f, 0.f, 0.f, 0.f};
        cur = nxt; cA = nA; cB = nB; ++ui;
        if constexpr (ALIGN_EPI) { if (wr == 1) PG8_BAR; }
    }
    PG8_WAIT_V(0);
    if constexpr (!ALIGN_EPI) { if (wr == 0) PG8_BAR; }
    PG8_BAR;
    if constexpr (Epi::AFTER_DRAIN) { E.fused(acc, cur, wr, wc, fr, fq, lds, wid, lane); S.done(cur); }
#undef PG8_SA
#undef PG8_SB
#undef PG8_STAGE
#undef PG8_LDA
#undef PG8_LDB
#undef PG8_MMA
#undef PG8_WAIT_V
#undef PG8_WAIT_L
#undef PG8_BAR
#undef PG8_SCHED
}
}
#define LAS __attribute__((address_space(3)))
typedef unsigned short bf16;
typedef short bf16x8 __attribute__((ext_vector_type(8)));
typedef float f32x4 __attribute__((ext_vector_type(4)));
typedef float f32x16 __attribute__((ext_vector_type(16)));
typedef unsigned u32x4 __attribute__((ext_vector_type(4)));
typedef unsigned u32x2 __attribute__((ext_vector_type(2)));
typedef float f32x2 __attribute__((ext_vector_type(2)));
constexpr int NB = 2, SEQ = 4096, MT = NB * SEQ, DM = 2048, DEPTH = 4, DIN = 4688, NIN = 4864, DFF = 5632, NGU = 2 * DFF;
constexpr int C_GQ = 0, C_GK = 256, C_GV = 512, C_GO = 1024, C_HQ = 1536, C_HF = 2048, C_HI = 2560, C_HO = 3072, C_QC = 3584, C_KVC = 4096, C_KPE = 4608, C_GLOW = 4672;
constexpr float EPS = 1e-6f;
constexpr float QSCALE = 0.07216878364870322f * 1.4426950408889634f;
constexpr int NWAVES = 8, NTHR = 512;
constexpr int LDS_BYTES = 143360;
constexpr size_t W_IN = 0, W_Q = W_IN + (size_t)NIN * DM, W_K = W_Q + 1536 * 512, W_V = W_K + 1024 * 512, W_OUT = W_V + 1024 * 512, W_GU = W_OUT + (size_t)DM * DM,
                 W_DN = W_GU + (size_t)NGU * DM, W_LAYER = W_DN + (size_t)DM * DFF;
constexpr size_t al256(size_t x) { return (x + 255) & ~(size_t)255; }
constexpr size_t WS_PS_QKV = 0, WS_PS_O = WS_PS_QKV + (size_t)MT * 16 * 4, WS_PS_M = WS_PS_O + (size_t)MT * 8 * 4, WS_RSTD = WS_PS_M + (size_t)MT * 32 * 4;
constexpr size_t WS_COS = WS_RSTD + MT * 4, WS_SIN = WS_COS + (size_t)MT * 32 * 4, WS_DL_G = WS_SIN + (size_t)MT * 32 * 4, WS_DL_H = WS_DL_G + 8 * 64 * 64 * 4, WS_KPE = WS_DL_H + 8 * 64 * 128 * 4;
constexpr size_t WS_ML = al256(WS_KPE + (size_t)MT * 64 * 2);
constexpr size_t WS_BAR = al256(WS_ML + (size_t)2 * 16 * 8 * 256 * 2 * 4), BAR_BYTES = 16384;
constexpr size_t WS_W = al256(WS_BAR + BAR_BYTES);
constexpr size_t WS_XB = al256(WS_W + W_LAYER * DEPTH * 2);
constexpr size_t WS_Y = WS_XB + (size_t)MT * DM * 2;
constexpr size_t WS_MB = WS_Y + (size_t)MT * DM * 2;
constexpr size_t WS_VT = WS_MB + (size_t)MT * DM * 2;
constexpr size_t WS_QE_G = WS_VT + (size_t)1024 * MT * 2;
constexpr size_t WS_QE_H = WS_QE_G + (size_t)MT * 256 * 2;
constexpr size_t WS_UT_G = WS_QE_H + (size_t)MT * 512 * 2;
constexpr size_t WS_UT_H = WS_UT_G + (size_t)8 * 64 * 128 * 64 * 4;
constexpr size_t WS_SP_G = WS_UT_H + (size_t)8 * 64 * 128 * 128 * 4;
constexpr size_t WS_SP_H = WS_SP_G + (size_t)8 * 64 * 128 * 64 * 2;
constexpr size_t WS_OI = WS_SP_H + (size_t)8 * 64 * 128 * 128 * 2;
constexpr size_t WS_R1 = WS_OI + (size_t)2 * MT * 512 * 4;
constexpr size_t WS_PROJ = WS_R1, WS_Q = WS_PROJ + (size_t)MT * NIN * 2, WS_KN = WS_Q + (size_t)MT * 1536 * 2, WS_R1_END = WS_KN + (size_t)MT * 1024 * 2;
constexpr size_t WS_HDN = WS_R1;
static_assert(WS_HDN + (size_t)MT * DFF * 2 <= WS_R1_END, "hdn overlay");
constexpr size_t WS_END = WS_R1_END;

struct Args {
    const float* x; const int* pos; const float* attn_pre; const float* w_in; const float* gate_w2; const float* gate_b; const float* gla_norm; const float* lb_logits; const float* hgrn_norm;
    const float* q_norm; const float* wq_b; const float* kv_norm; const float* wkv_b; const float* mla_out_norm; const float* w_out; const float* attn_post; const float* ffn_pre;
    const float* w_gate; const float* w_up; const float* w_down; const float* ffn_post; float* out; unsigned char* ws; int ph_lo, ph_hi;
};

__device__ __forceinline__ unsigned f2bf(float f) { unsigned u = __builtin_bit_cast(unsigned, f); return (u + 0x7fffu + ((u >> 16) & 1u)) >> 16; }
__device__ __forceinline__ float bf2f(bf16 b) { return __builtin_bit_cast(float, (unsigned)b << 16); }
__device__ __forceinline__ unsigned pk2(float lo, float hi) { return pg8::cvt_pk_bf16(lo, hi); }
__device__ __forceinline__ float wave_sum(float v) {
#pragma unroll
    for (int o = 1; o < 64; o <<= 1) v += __shfl_xor(v, o);
    return v;
}
__device__ __forceinline__ int crow(int r, int hi) { return (r & 3) + 8 * (r >> 2) + 4 * hi; }
#define LDS_WAIT() asm volatile("s_waitcnt lgkmcnt(0)" ::: "memory")

__device__ __forceinline__ int w_srccol(int mat, int n) {
    switch (mat) {
    case 0: return n < 1024 ? n : (n < 4672 ? n + 16 : (n < 4688 ? n - 3648 : -1));
    case 1: { if (n < 1024) return (n >> 7) * 192 + (n & 127); const int c = n - 1024, hh = c >> 6, j = c & 63, i = j >> 1; return hh * 192 + 128 + ((j & 1) ? i + 32 : i); }
    case 2: return (n >> 7) * 256 + (n & 127);
    case 3: return (n >> 7) * 256 + 128 + (n & 127);
    case 5: return (n >> 8) * 128 + (n & 127);
    default: return n;
    }
}
struct ConvDesc { const float* src; const float* gain; bf16* dst; int ldsrc, mat, gmin, k0, K, n0; };
constexpr int I_IN = (NIN / 128) * (DM / 128), I_Q = 12 * 4, I_K = 8 * 4, I_V = 8 * 4, I_OUT = 16 * 16, I_GU = (NGU / 128) * 16, I_DN = 16 * (DFF / 128);
constexpr int I_LAYER = I_IN + I_Q + I_K + I_V + I_OUT + I_GU + I_DN;
__device__ __forceinline__ ConvDesc conv_decode(const Args& a, int l, int r) {
    bf16* wl = (bf16*)(a.ws + WS_W) + (size_t)l * W_LAYER; ConvDesc d;
    if (r < I_IN) { const int nb = r % (NIN / 128), kb = r / (NIN / 128); d = ConvDesc{a.w_in + (size_t)l * DM * DIN, a.attn_pre + l * DM, wl + W_IN, DIN, 0, 0, kb * 128, DM, nb * 128}; return d; } r -= I_IN;
    if (r < I_Q) { const int nb = r % 12, kb = r / 12; d = ConvDesc{a.wq_b + (size_t)l * 512 * 1536, a.q_norm + l * 512, wl + W_Q, 1536, 1, 0, kb * 128, 512, nb * 128}; return d; } r -= I_Q;
    if (r < I_K) { const int nb = r % 8, kb = r / 8; d = ConvDesc{a.wkv_b + (size_t)l * 512 * 2048, a.kv_norm + l * 512, wl + W_K, 2048, 2, 0, kb * 128, 512, nb * 128}; return d; } r -= I_K;
    if (r < I_V) { const int nb = r % 8, kb = r / 8; d = ConvDesc{a.wkv_b + (size_t)l * 512 * 2048, a.kv_norm + l * 512, wl + W_V, 2048, 3, 0, kb * 128, 512, nb * 128}; return d; } r -= I_V;
    if (r < I_OUT) { const int nb = r % 16, kb = r / 16; d = ConvDesc{a.w_out + (size_t)l * DM * DM, a.mla_out_norm + l * 1024, wl + W_OUT, DM, 4, 1024, kb * 128, DM, nb * 128}; return d; } r -= I_OUT;
    if (r < I_GU) { const int nb = r % (NGU / 128), kb = r / (NGU / 128); d = ConvDesc{((nb & 1) ? a.w_up : a.w_gate) + (size_t)l * DM * DFF, a.ffn_pre + l * DM, wl + W_GU, DFF, 5, 0, kb * 128, DM, nb * 128}; return d; } r -= I_GU;
    { const int nb = r % 16, kb = r / 16; d = ConvDesc{a.w_down + (size_t)l * DFF * DM, nullptr, wl + W_DN, DM, 6, 0, kb * 128, DFF, nb * 128}; return d; }
}
__device__ __forceinline__ void conv_load(const ConvDesc& d, int tid, f32x4 (&v)[4][2], float (&gn)[4][2], float& zm) {
    const int c4 = tid & 31, rp = tid >> 5;
    zm = 1.f;
    const bool scat = (d.mat == 1 && d.n0 >= 1024);
    if (scat) {
        int sc[4];
#pragma unroll
        for (int j = 0; j < 4; ++j) sc[j] = w_srccol(d.mat, d.n0 + 4 * c4 + j);
#pragma unroll
        for (int i = 0; i < 4; ++i)
#pragma unroll
            for (int e = 0; e < 2; ++e) { const int k = d.k0 + i * 32 + 2 * rp + e; const float* rowp = d.src + (size_t)k * d.ldsrc;
                v[i][e][0] = rowp[sc[0]]; v[i][e][1] = rowp[sc[1]]; v[i][e][2] = rowp[sc[2]]; v[i][e][3] = rowp[sc[3]];
                gn[i][e] = (d.gain && k >= d.gmin) ? d.gain[k - d.gmin] : 1.f; }
    } else {
        const int sc0 = w_srccol(d.mat, d.n0 + 4 * c4); const bool zero = sc0 < 0; const int c0 = zero ? 0 : sc0; zm = zero ? 0.f : 1.f;
#pragma unroll
        for (int i = 0; i < 4; ++i)
#pragma unroll
            for (int e = 0; e < 2; ++e) { const int k = d.k0 + i * 32 + 2 * rp + e; const float* rowp = d.src + (size_t)k * d.ldsrc;
                v[i][e] = *(const f32x4*)(rowp + c0);
                gn[i][e] = (d.gain && k >= d.gmin) ? d.gain[k - d.gmin] : 1.f; }
    }
}
__device__ __forceinline__ void conv_store(const ConvDesc& d, int tid, const f32x4 (&v)[4][2], const float (&gn)[4][2], float zm, LAS unsigned* T) {
    constexpr int SD = 65; const int c4 = tid & 31, rp = tid >> 5;
#pragma unroll
    for (int i = 0; i < 4; ++i)
#pragma unroll
        for (int j = 0; j < 4; ++j) T[(c4 + 32 * j) * SD + i * 16 + rp] = pk2(v[i][0][j] * (gn[i][0] * zm), v[i][1][j] * (gn[i][1] * zm));
    __syncthreads();
#pragma unroll
    for (int i = 0; i < 4; ++i) { const int n = i * 32 + (tid >> 4), kc = tid & 15; const LAS unsigned* p = T + n * SD + kc * 4; u32x4 o; o.x = p[0]; o.y = p[1]; o.z = p[2]; o.w = p[3];
        *(u32x4*)(d.dst + (size_t)(d.n0 + 4 * (n & 31) + (n >> 5)) * d.K + d.k0 + kc * 8) = o; }
    __syncthreads();
}
__device__ __forceinline__ void conv_layer(const Args& a, int l, LAS unsigned char* lds, unsigned* ctr) {
    int tid_o = threadIdx.x; asm volatile("" : "+v"(tid_o)); const int tid = tid_o;
    LAS unsigned* T = (LAS unsigned*)lds; volatile LAS unsigned* slot = (volatile LAS unsigned*)(lds + 131072 + 128);
    int stat = (int)blockIdx.x - (int)gridDim.x;
    unsigned pend = 0u;
#define CONV_ISSUE() do { if (ctr && tid == 0) pend = __hip_atomic_fetch_add(ctr, 1u, __ATOMIC_RELAXED, __HIP_MEMORY_SCOPE_AGENT); } while (0)
#define CONV_NEXT(r) do { if (ctr) { sl ^= 1; if (tid == 0) slot[sl] = pend; __syncthreads(); r = (int)slot[sl]; } else { stat += (int)gridDim.x; r = stat; } } while (0)
    int sl = 0;
    __syncthreads();
    f32x4 vA[4][2], vB[4][2], vC[4][2]; float gA[4][2], gB[4][2], gC[4][2], zA, zB, zC; ConvDesc d0, d1, d2; int r0, r1, r2;
    CONV_ISSUE(); CONV_NEXT(r0); CONV_ISSUE(); if (r0 < I_LAYER) { d0 = conv_decode(a, l, r0); conv_load(d0, tid, vA, gA, zA); }
    CONV_NEXT(r1); CONV_ISSUE(); if (r1 < I_LAYER) { d1 = conv_decode(a, l, r1); conv_load(d1, tid, vB, gB, zB); }
    for (;;) {
        if (r0 >= I_LAYER) break;
        CONV_NEXT(r2); CONV_ISSUE(); if (r2 < I_LAYER) { d2 = conv_decode(a, l, r2); conv_load(d2, tid, vC, gC, zC); }
        conv_store(d0, tid, vA, gA, zA, T);
        if (r1 >= I_LAYER) break;
        CONV_NEXT(r0); CONV_ISSUE(); if (r0 < I_LAYER) { d0 = conv_decode(a, l, r0); conv_load(d0, tid, vA, gA, zA); }
        conv_store(d1, tid, vB, gB, zB, T);
        if (r2 >= I_LAYER) break;
        CONV_NEXT(r1); CONV_ISSUE(); if (r1 < I_LAYER) { d1 = conv_decode(a, l, r1); conv_load(d1, tid, vB, gB, zB); }
        conv_store(d2, tid, vC, gC, zC, T);
    }
#undef CONV_NEXT
#undef CONV_ISSUE
}
__device__ __forceinline__ void p0_prologue(const Args& a, LAS unsigned char* lds) {
    int tid_o = threadIdx.x; asm volatile("" : "+v"(tid_o)); const int tid = tid_o, lane = tid & 63, wave = tid >> 6, G = gridDim.x;
    const int gw = blockIdx.x * NWAVES + wave, NGW = G * NWAVES;
    conv_layer(a, 0, lds, nullptr);
    float* ct = (float*)(a.ws + WS_COS); float* st = (float*)(a.ws + WS_SIN);
    for (int i = blockIdx.x * NTHR + tid; i < MT * 32; i += G * NTHR) { const int row = i >> 5, j = i & 31;
        const float inv = (float)exp(-((double)(2 * j) / 64.0) * 9.210340371976184);
        const float ang = (float)a.pos[row] * inv;
        double rev = (double)ang * 0.15915494309189535; rev -= rint(rev); const float rf = (float)rev;
        ct[i] = __builtin_amdgcn_cosf(rf); st[i] = __builtin_amdgcn_sinf(rf); }
    bf16* xb = (bf16*)(a.ws + WS_XB); float* rstd = (float*)(a.ws + WS_RSTD);
    for (int row = gw; row < MT; row += NGW) { const f32x4* xr = (const f32x4*)(a.x + (size_t)row * DM); u32x2* ob = (u32x2*)(xb + (size_t)row * DM); float ss = 0.f;
        f32x4 xv[8];
#pragma unroll
        for (int j = 0; j < 8; ++j) xv[j] = xr[j * 64 + lane];
#pragma unroll
        for (int j = 0; j < 8; ++j) { const f32x4 v = xv[j]; ss += (v[0] * v[0] + v[1] * v[1]) + (v[2] * v[2] + v[3] * v[3]); u32x2 o; o.x = pk2(v[0], v[1]); o.y = pk2(v[2], v[3]); ob[j * 64 + lane] = o; }
        ss = wave_sum(ss);
        if (lane == 0) rstd[row] = 1.f / sqrtf(ss * (1.f / DM) + EPS); }
}
__device__ __forceinline__ void rowpass(const float* xin, float* xout, const bf16* mb, const float* ps, const float* gain, bf16* xb, float* rstd) {
    int tid_o = threadIdx.x; asm volatile("" : "+v"(tid_o)); const int tid = tid_o, lane = tid & 63, wave = tid >> 6; const int gw = blockIdx.x * NWAVES + wave, NGW = gridDim.x * NWAVES;
    for (int row = gw; row < MT; row += NGW) { const f32x4* xr = (const f32x4*)(xin + (size_t)row * DM); f32x4* xo = (f32x4*)(xout + (size_t)row * DM);
        const u32x2* mr = (const u32x2*)(mb + (size_t)row * DM); u32x2* ob = (u32x2*)(xb + (size_t)row * DM); const f32x4* gr = (const f32x4*)gain;
        f32x4 xv[8]; u32x2 mv[8];
#pragma unroll
        for (int j = 0; j < 8; ++j) { xv[j] = xr[j * 64 + lane]; mv[j] = mr[j * 64 + lane]; }
        const float r = 1.f / sqrtf(wave_sum(lane < 32 ? ps[(size_t)row * 32 + lane] : 0.f) * (1.f / DM) + EPS); float ss = 0.f;
#pragma unroll
        for (int j = 0; j < 8; ++j) { const int i = j * 64 + lane; f32x4 v = xv[j]; const u32x2 mm = mv[j]; const f32x4 g = gr[i];
            v[0] += __builtin_bit_cast(float, mm.x << 16) * r * g[0]; v[1] += __builtin_bit_cast(float, mm.x & 0xffff0000u) * r * g[1];
            v[2] += __builtin_bit_cast(float, mm.y << 16) * r * g[2]; v[3] += __builtin_bit_cast(float, mm.y & 0xffff0000u) * r * g[3];
            xv[j] = v; ss += (v[0] * v[0] + v[1] * v[1]) + (v[2] * v[2] + v[3] * v[3]); }
#pragma unroll
        for (int j = 0; j < 8; ++j) { const int i = j * 64 + lane; xo[i] = xv[j]; u32x2 o; o.x = pk2(xv[j][0], xv[j][1]); o.y = pk2(xv[j][2], xv[j][3]); ob[i] = o; }
        ss = wave_sum(ss);
        if (lane == 0) rstd[row] = 1.f / sqrtf(ss * (1.f / DM) + EPS); }
}
__device__ __forceinline__ f32x16 mfma32(bf16x8 a, bf16x8 b, f32x16 c) { return __builtin_amdgcn_mfma_f32_32x32x16_bf16(a, b, c, 0, 0, 0); }
template <int KD> __device__ __forceinline__ f32x16 mm32(const LAS bf16* A, int lda, const LAS bf16* B, int ldb, int ql, int g, f32x16 acc) {
#pragma unroll
    for (int s = 0; s < KD / 16; ++s) { const bf16x8 a = *(const LAS bf16x8*)(A + ql * lda + 16 * s + 8 * g), b = *(const LAS bf16x8*)(B + ql * ldb + 16 * s + 8 * g); acc = mfma32(a, b, acc); }
    return acc;
}
constexpr f32x16 Z16 = {0.f, 0.f, 0.f, 0.f, 0.f, 0.f, 0.f, 0.f, 0.f, 0.f, 0.f, 0.f, 0.f, 0.f, 0.f, 0.f};
template <int TYPE> __device__ __forceinline__ void gla_local_item(const Args& a, LAS unsigned char* lds, int layer, int bh, int c) {
    constexpr int DK = TYPE ? 128 : 64, QS = DK + 8, TS = 72, NTG = NTHR / DK, RPT = 64 / NTG;
    LAS bf16* qh = (LAS bf16*)lds; LAS bf16* kh = qh + 64 * QS; LAS bf16* ktT = kh + 64 * QS; LAS bf16* vT = ktT + DK * TS; LAS bf16* Ab = vT + 128 * TS; LAS float* bc = (LAS float*)(Ab + 64 * TS);
    int tid_o = threadIdx.x; asm volatile("" : "+v"(tid_o)); const int tid = tid_o, lane = tid & 63, wave = tid >> 6, ql = lane & 31, g = lane >> 5;
    const int b = bh >> 2, h = bh & 3, t0 = b * SEQ + c * 64;
    const bf16* prow = (const bf16*)(a.ws + WS_PROJ) + (size_t)t0 * NIN;
    const int d = tid % DK, tg = tid / DK;
    float lbv = 0.f;
    bf16 rq[RPT], rk[RPT], rv[16];
#pragma unroll
    for (int tt = 0; tt < RPT; ++tt) { const int t = tg * RPT + tt; rq[tt] = prow[(size_t)t * NIN + (TYPE ? C_HQ : C_GQ) + h * DK + d]; rk[tt] = prow[(size_t)t * NIN + (TYPE ? C_HF : C_GK) + h * DK + d]; }
    { const int e = tid & 127, tq = tid >> 7; const int vcol = (TYPE ? C_HI : C_GV) + h * 128 + e;
#pragma unroll
      for (int i = 0; i < 16; ++i) rv[i] = prow[(size_t)(tq * 16 + i) * NIN + vcol]; }
    {
        float run = 0.f;
        if (TYPE == 0) {
            float w2c[16]; const float* w2 = a.gate_w2 + (size_t)layer * 16 * 256 + h * 64 + d;
#pragma unroll
            for (int r = 0; r < 16; ++r) w2c[r] = w2[r * 256];
            const float bias = a.gate_b[layer * 256 + h * 64 + d];
            bf16x8 rg0[RPT], rg1[RPT];
#pragma unroll
            for (int tt = 0; tt < RPT; ++tt) { const bf16x8* gl = (const bf16x8*)(prow + (size_t)(tg * RPT + tt) * NIN + C_GLOW); rg0[tt] = gl[0]; rg1[tt] = gl[1]; }
#pragma unroll
            for (int tt = 0; tt < RPT; ++tt) { const int t = tg * RPT + tt; const bf16x8 g0 = rg0[tt], g1 = rg1[tt]; float z = bias;
#pragma unroll
                for (int r = 0; r < 8; ++r) { z += bf2f((bf16)g0[r]) * w2c[r]; z += bf2f((bf16)g1[r]) * w2c[8 + r]; }
                const float lg = (fminf(z, 0.f) - __logf(1.f + __expf(-fabsf(z)))) * (1.f / 16.f);
                run += lg; bc[t * DK + d] = run; }
        } else {
            const float* lg4 = a.lb_logits + h * 128 + d; const float l0 = lg4[0], l1 = lg4[512], l2 = lg4[1024], l3 = lg4[1536];
            const float mx = fmaxf(fmaxf(l0, l1), fmaxf(l2, l3)); const float e0 = __expf(l0 - mx), e1 = __expf(l1 - mx), e2 = __expf(l2 - mx), e3 = __expf(l3 - mx); const float inv = 1.f / (e0 + e1 + e2 + e3);
            lbv = (layer >= 1 ? e1 : 0.f) + (layer >= 2 ? e2 : 0.f) + (layer >= 3 ? e3 : 0.f); lbv *= inv;
#pragma unroll
            for (int tt = 0; tt < RPT; ++tt) { const int t = tg * RPT + tt; const float hf = bf2f(rk[tt]);
                const float sg = 1.f / (1.f + __expf(-hf)); const float f = lbv + (1.f - lbv) * sg;
                run += __logf(f); bc[t * DK + d] = run; }
        }
    }
    __syncthreads();
    { float off = 0.f; for (int s = 0; s < tg; ++s) off += bc[(s * RPT + RPT - 1) * DK + d];
      __syncthreads();
      if (tg > 0) for (int tt = 0; tt < RPT; ++tt) bc[(tg * RPT + tt) * DK + d] += off; }
    __syncthreads();
    {
        const float bmid = bc[32 * DK + d], blast = bc[63 * DK + d]; const float scale = TYPE ? 1.f : 0.125f;
        bf16* qe = (bf16*)(a.ws + (TYPE ? WS_QE_H : WS_QE_G));
#pragma unroll
        for (int tt = 0; tt < RPT; ++tt) { const int t = tg * RPT + tt; const float bb = bc[t * DK + d]; float q = bf2f(rq[tt]), k = bf2f(rk[tt]);
            if (TYPE == 1) { const float hq = q, hf = k; q = hq / (1.f + __expf(-hq)); k = (1.f - lbv) / (1.f + __expf(hf)); }
            q *= scale;
            qh[t * QS + d] = (bf16)f2bf(q * __expf(bb - bmid)); kh[t * QS + d] = (bf16)f2bf(k * __expf(bmid - bb));
            ktT[d * TS + t] = (bf16)f2bf(k * __expf(blast - bb));
            qe[(size_t)(t0 + t) * (4 * DK) + h * DK + d] = (bf16)f2bf(q * __expf(bb)); }
        if (tg == 0) ((float*)(a.ws + (TYPE ? WS_DL_H : WS_DL_G)))[(bh * 64 + c) * DK + d] = __expf(blast);
        const int e = tid & 127, tq = tid >> 7;
#pragma unroll
        for (int i = 0; i < 16; ++i) vT[e * TS + tq * 16 + i] = rv[i];
    }
    __syncthreads();
    if (wave < 4) {
        const int jb = wave & 1, ib = wave >> 1; f32x16 acc = Z16;
        if (!(jb == 1 && ib == 0)) acc = mm32<DK>(kh + 32 * jb * QS, QS, qh + 32 * ib * QS, QS, ql, g, acc);
        const int i = 32 * ib + ql;
#pragma unroll
        for (int rg = 0; rg < 4; ++rg) { const int j0 = 32 * jb + 8 * rg + 4 * g; float v[4];
#pragma unroll
            for (int e = 0; e < 4; ++e) v[e] = (j0 + e <= i) ? acc[4 * rg + e] : 0.f;
            u32x2 o; o.x = pk2(v[0], v[1]); o.y = pk2(v[2], v[3]); *(LAS u32x2*)(Ab + i * TS + j0) = o; }
    }
    __syncthreads();
    {
        const int eb = wave & 3, ib = wave >> 2; f32x16 acc = mm32<64>(vT + 32 * eb * TS, TS, Ab + 32 * ib * TS, TS, ql, g, Z16);
        float* oi = (float*)(a.ws + WS_OI) + (size_t)TYPE * MT * 512 + (size_t)(t0 + 32 * ib + ql) * 512 + h * 128 + 32 * eb + 4 * g;
#pragma unroll
        for (int rg = 0; rg < 4; ++rg) { f32x4 o = {acc[4 * rg], acc[4 * rg + 1], acc[4 * rg + 2], acc[4 * rg + 3]}; *(f32x4*)(oi + 8 * rg) = o; }
    }
    {
        float* ut = (float*)(a.ws + (TYPE ? WS_UT_H : WS_UT_G)) + (size_t)(bh * 64 + c) * 128 * DK;
#pragma unroll
        for (int bi = 0; bi < DK / 64; ++bi) { const int blk = wave + 8 * bi, eb = blk & 3, db = blk >> 2;
            f32x16 acc = mm32<64>(ktT + 32 * db * TS, TS, vT + 32 * eb * TS, TS, ql, g, Z16);
            float* up = ut + (size_t)(32 * eb + ql) * DK + 32 * db + 4 * g;
#pragma unroll
            for (int rg = 0; rg < 4; ++rg) { f32x4 o = {acc[4 * rg], acc[4 * rg + 1], acc[4 * rg + 2], acc[4 * rg + 3]}; *(f32x4*)(up + 8 * rg) = o; } }
    }
    __syncthreads();
}
__device__ __forceinline__ void scan_item(const Args& a, int si) {
    int tid_o = threadIdx.x; asm volatile("" : "+v"(tid_o)); const int tid = tid_o; const bool hg = si >= 32; const int DK = hg ? 128 : 64; const int idx = (hg ? si - 32 : si) * NTHR + tid;
    const int per_bh = 128 * DK / 4; const int bh = idx / per_bh, rem = idx % per_bh, e = rem / (DK / 4), d = 4 * (rem % (DK / 4));
    const float* ut = (const float*)(a.ws + (hg ? WS_UT_H : WS_UT_G)) + (size_t)bh * 64 * 128 * DK + (size_t)e * DK + d;
    bf16* sp = (bf16*)(a.ws + (hg ? WS_SP_H : WS_SP_G)) + (size_t)bh * 64 * 128 * DK + (size_t)e * DK + d;
    const float* dl = (const float*)(a.ws + (hg ? WS_DL_H : WS_DL_G)) + (size_t)bh * 64 * DK + d;
    f32x4 S = {0.f, 0.f, 0.f, 0.f}; const size_t cs = (size_t)128 * DK;
    for (int cb = 0; cb < 64; cb += 16) {
        f32x4 u[16], dd[16];
#pragma unroll
        for (int i = 0; i < 16; ++i) { u[i] = __builtin_nontemporal_load((const f32x4*)(ut + (size_t)(cb + i) * cs)); dd[i] = *(const f32x4*)(dl + (cb + i) * DK); }
#pragma unroll
        for (int i = 0; i < 16; ++i) { u32x2 o; o.x = pk2(S[0], S[1]); o.y = pk2(S[2], S[3]); *(u32x2*)(sp + (size_t)(cb + i) * cs) = o; S = dd[i] * S + u[i]; }
    }
}
__device__ __forceinline__ void gla_final_item(const Args& a, int layer, int item) {
    const int type = item >> 7, bh = (item >> 4) & 7, cg4 = item & 15; const int DK = type ? 128 : 64;
    int tid_o = threadIdx.x; asm volatile("" : "+v"(tid_o)); const int tid = tid_o, lane = tid & 63, wave = tid >> 6, ql = lane & 31, g = lane >> 5;
    const int b = bh >> 2, h = bh & 3, c = cg4 * 4 + (wave >> 1), t = b * SEQ + c * 64 + (wave & 1) * 32 + ql;
    const float* oi = (const float*)(a.ws + WS_OI) + (size_t)type * MT * 512 + (size_t)t * 512 + h * 128 + 4 * g;
    f32x16 acc[4];
#pragma unroll
    for (int eb = 0; eb < 4; ++eb)
#pragma unroll
        for (int rg = 0; rg < 4; ++rg) { const f32x4 v = *(const f32x4*)(oi + 32 * eb + 8 * rg); acc[eb][4 * rg] = v[0]; acc[eb][4 * rg + 1] = v[1]; acc[eb][4 * rg + 2] = v[2]; acc[eb][4 * rg + 3] = v[3]; }
    const bf16* qe = (const bf16*)(a.ws + (type ? WS_QE_H : WS_QE_G)) + (size_t)t * (4 * DK) + h * DK + 8 * g;
    const bf16* sp = (const bf16*)(a.ws + (type ? WS_SP_H : WS_SP_G)) + ((size_t)(bh * 64 + c) * 128 + ql) * DK + 8 * g;
    for (int s = 0; s < DK / 16; ++s) { const bf16x8 bq = *(const bf16x8*)(qe + 16 * s);
#pragma unroll
        for (int eb = 0; eb < 4; ++eb) { const bf16x8 as = *(const bf16x8*)(sp + (size_t)32 * eb * DK + 16 * s); acc[eb] = mfma32(as, bq, acc[eb]); } }
    float ss = 0.f;
#pragma unroll
    for (int eb = 0; eb < 4; ++eb)
#pragma unroll
        for (int r = 0; r < 16; ++r) ss += acc[eb][r] * acc[eb][r];
    ss += __shfl_xor(ss, 32);
    const float rstd = 1.f / sqrtf(ss * (1.f / 128.f) + EPS);
    const float* gn = (type ? a.hgrn_norm : a.gla_norm) + layer * 128 + 4 * g;
    const bf16* gt = (const bf16*)(a.ws + WS_PROJ) + (size_t)t * NIN + (type ? C_HO : C_GO) + h * 128 + 4 * g;
    bf16* y = (bf16*)(a.ws + WS_Y) + (size_t)t * DM + type * 512 + h * 128 + 4 * g;
    u32x2 gbv[16]; f32x4 gvv[16];
#pragma unroll
    for (int i = 0; i < 16; ++i) { const int eo = 32 * (i >> 2) + 8 * (i & 3); gbv[i] = *(const u32x2*)(gt + eo); gvv[i] = *(const f32x4*)(gn + eo); }
#pragma unroll
    for (int eb = 0; eb < 4; ++eb)
#pragma unroll
        for (int rg = 0; rg < 4; ++rg) { const int eo = 32 * eb + 8 * rg; const f32x4 gv = gvv[4 * eb + rg]; const u32x2 gb = gbv[4 * eb + rg];
            const float g0 = __builtin_bit_cast(float, gb.x << 16), g1 = __builtin_bit_cast(float, gb.x & 0xffff0000u), g2 = __builtin_bit_cast(float, gb.y << 16), g3 = __builtin_bit_cast(float, gb.y & 0xffff0000u);
            const float o0 = acc[eb][4 * rg] * rstd * gv[0] * g0 / (1.f + __expf(-g0)), o1 = acc[eb][4 * rg + 1] * rstd * gv[1] * g1 / (1.f + __expf(-g1));
            const float o2 = acc[eb][4 * rg + 2] * rstd * gv[2] * g2 / (1.f + __expf(-g2)), o3 = acc[eb][4 * rg + 3] * rstd * gv[3] * g3 / (1.f + __expf(-g3));
            u32x2 o; o.x = pk2(o0, o1); o.y = pk2(o2, o3); *(u32x2*)(y + eo) = o; }
}
__device__ __forceinline__ void kpe_rope(const Args& a) {
    const bf16* proj = (const bf16*)(a.ws + WS_PROJ); bf16* kpe = (bf16*)(a.ws + WS_KPE); const float* ct = (const float*)(a.ws + WS_COS); const float* st = (const float*)(a.ws + WS_SIN);
    int tid_o = threadIdx.x; asm volatile("" : "+v"(tid_o));
    for (int i = blockIdx.x * NTHR + tid_o; i < MT * 32; i += gridDim.x * NTHR) { const int row = i >> 5, j = i & 31;
        const float x1 = bf2f(proj[(size_t)row * NIN + C_KPE + j]), x2 = bf2f(proj[(size_t)row * NIN + C_KPE + 32 + j]); const float c = ct[i], s = st[i];
        *(unsigned*)(kpe + (size_t)row * 64 + 2 * j) = pk2(x1 * c - x2 * s, x2 * c + x1 * s); }
}
__device__ __forceinline__ void mla_out_norm(const Args& a) {
    bf16* y = (bf16*)(a.ws + WS_Y); const float* ssq = (const float*)(a.ws + WS_PS_O);
    int tid_o = threadIdx.x; asm volatile("" : "+v"(tid_o));
    const int i0 = blockIdx.x * NTHR + tid_o, stride = gridDim.x * NTHR;
    for (int ib = i0; ib < MT * 128; ib += 8 * stride) {
        u32x4 v[8]; f32x4 s0[8], s1[8];
#pragma unroll
        for (int k = 0; k < 8; ++k) { const int i = ib + k * stride; if (i < MT * 128) { const int row = i >> 7, cc = i & 127; v[k] = *(const u32x4*)(y + (size_t)row * DM + 1024 + cc * 8); s0[k] = *(const f32x4*)(ssq + (size_t)row * 8); s1[k] = *(const f32x4*)(ssq + (size_t)row * 8 + 4); } }
#pragma unroll
        for (int k = 0; k < 8; ++k) { const int i = ib + k * stride; if (i < MT * 128) { const int row = i >> 7, cc = i & 127;
            const float r = 1.f / sqrtf((((s0[k][0] + s0[k][1]) + (s0[k][2] + s0[k][3])) + ((s1[k][0] + s1[k][1]) + (s1[k][2] + s1[k][3]))) * (1.f / 1024.f) + EPS); u32x4 w = v[k];
#pragma unroll
            for (int e = 0; e < 4; ++e) { const float lo = __builtin_bit_cast(float, w[e] << 16) * r, hi = __builtin_bit_cast(float, w[e] & 0xffff0000u) * r; w[e] = pk2(lo, hi); }
            *(u32x4*)(y + (size_t)row * DM + 1024 + cc * 8) = w; } }
    }
}
constexpr int KSTR = 400, VSTR = 136, KBYTES = 64 * KSTR, VBYTES = 128 * VSTR, OSTR = 272;
__device__ __forceinline__ void attn_item(const Args& a, LAS unsigned char* lds, int b, int h, int qb, int t0, int t1, int part) {
    int tid_o = threadIdx.x; asm volatile("" : "+v"(tid_o)); const int tid = tid_o, lane = tid & 63, wave = tid >> 6, ql = lane & 31, g = lane >> 5;
    const bf16* Q = (const bf16*)(a.ws + WS_Q); const bf16* KN = (const bf16*)(a.ws + WS_KN); const bf16* KP = (const bf16*)(a.ws + WS_KPE); const bf16* VT = (const bf16*)(a.ws + WS_VT);
    const int tq0 = b * SEQ + qb * 256 + wave * 32, qpos = qb * 256 + wave * 32 + ql;
    bf16x8 qf[12];
    { const bf16* qp = Q + (size_t)(tq0 + ql) * 1536 + h * 192 + 8 * g;
#pragma unroll
      for (int s = 0; s < 12; ++s) qf[s] = *(const bf16x8*)(qp + 16 * s); }
    f32x16 oacc[4] = {Z16, Z16, Z16, Z16}; float mrun = 0.f, lrun = 0.f;
    const int nt = 4 * (qb + 1);
    int ksrc_off[3]; int kdst[3]; bool kpe_sel[3]; int vsrc_off[2]; int vdst[2];
#pragma unroll
    for (int i = 0; i < 3; ++i) { const int cid = tid + NTHR * i, key = cid / 24, cc = cid % 24; kpe_sel[i] = cc >= 16; kdst[i] = key * KSTR + cc * 16;
        ksrc_off[i] = kpe_sel[i] ? key * 64 + (cc - 16) * 8 : key * 1024 + h * 128 + cc * 8; }
#pragma unroll
    for (int i = 0; i < 2; ++i) { const int cid = tid + NTHR * i, row = cid >> 3, cc = cid & 7; vdst[i] = row * VSTR + cc * 16; vsrc_off[i] = (h * 128 + row) * MT + cc * 8; }
    u32x4 sk[3], sv[2];
#define ATT_GLOAD(t) do { const size_t tk = (size_t)(b * SEQ + (t) * 64); _Pragma("unroll") for (int i = 0; i < 3; ++i) sk[i] = kpe_sel[i] ? *(const u32x4*)(KP + tk * 64 + ksrc_off[i]) : *(const u32x4*)(KN + tk * 1024 + ksrc_off[i]); \
        _Pragma("unroll") for (int i = 0; i < 2; ++i) sv[i] = *(const u32x4*)(VT + (size_t)vsrc_off[i] + tk); } while (0)
#define ATT_LSTORE(kbuf, vbuf) do { LAS unsigned char* kb_ = lds + (kbuf) * KBYTES; LAS unsigned char* vb_ = lds + 2 * KBYTES + (vbuf) * VBYTES; \
        _Pragma("unroll") for (int i = 0; i < 3; ++i) *(LAS u32x4*)(kb_ + kdst[i]) = sk[i]; _Pragma("unroll") for (int i = 0; i < 2; ++i) { *(LAS u32x2*)(vb_ + vdst[i]) = (u32x2){sv[i].x, sv[i].y}; *(LAS u32x2*)(vb_ + vdst[i] + 8) = (u32x2){sv[i].z, sv[i].w}; } } while (0)
#define ATT_KLD(s_) (*(const LAS bf16x8*)(kp + 32 * (s_)))
#define ATT_KLD1(s_) (*(const LAS bf16x8*)(kp + 32 * KSTR + 32 * (s_)))
#define ATT_QK(kb_) do { const LAS unsigned char* kp = (kb_) + ql * KSTR + 16 * g; { const float ci = -mrun; _Pragma("unroll") for (int r = 0; r < 16; ++r) { p0[r] = ci; p1[r] = ci; } } \
        bf16x8 ka0 = ATT_KLD(0), ka1 = ATT_KLD1(0), kb0, kb1; \
        _Pragma("unroll") for (int s = 0; s < 12; s += 2) { \
            kb0 = ATT_KLD(s + 1); kb1 = ATT_KLD1(s + 1); __builtin_amdgcn_sched_barrier(0); \
            p0 = mfma32(ka0, qf[s], p0); p1 = mfma32(ka1, qf[s], p1); \
            if (s + 2 < 12) { ka0 = ATT_KLD(s + 2); ka1 = ATT_KLD1(s + 2); } __builtin_amdgcn_sched_barrier(0); \
            p0 = mfma32(kb0, qf[s + 1], p0); p1 = mfma32(kb1, qf[s + 1], p1); } } while (0)
#define ATT_SM() do { \
        if (t >= nt - 4) { const int kb0 = t * 64 + 4 * g; const float NEG = -__builtin_inff(); \
            _Pragma("unroll") for (int r = 0; r < 16; ++r) { const int kk = kb0 + (r & 3) + 8 * (r >> 2); if (kk > qpos) p0[r] = NEG; if (kk + 32 > qpos) p1[r] = NEG; } } \
        float mx = fmaxf(fmaxf(p0[0], p0[1]), p0[2]); \
        _Pragma("unroll") for (int r = 3; r < 15; r += 2) mx = fmaxf(fmaxf(mx, p0[r]), p0[r + 1]); \
        mx = fmaxf(fmaxf(mx, p0[15]), p1[0]); \
        _Pragma("unroll") for (int r = 1; r < 15; r += 2) mx = fmaxf(fmaxf(mx, p1[r]), p1[r + 1]); \
        mx = fmaxf(mx, p1[15]); \
        mx = fmaxf(mx, __shfl_xor(mx, 32)); \
          \
        { const bool first = (t == t0); \
          if (first || __builtin_amdgcn_ballot_w64(mx > 8.f) != 0ull) { \
            const float d = first ? mx : fmaxf(mx, 0.f); mrun += d; \
            _Pragma("unroll") for (int r = 0; r < 16; ++r) { p0[r] -= d; p1[r] -= d; } \
            if (!first) { const float alpha = __builtin_amdgcn_exp2f(-d); lrun *= alpha; \
                _Pragma("unroll") for (int db = 0; db < 4; ++db) oacc[db] = oacc[db] * alpha; } } } \
        float rs = 0.f; \
        _Pragma("unroll") for (int r = 0; r < 16; ++r) { p0[r] = __builtin_amdgcn_exp2f(p0[r]); p1[r] = __builtin_amdgcn_exp2f(p1[r]); rs += p0[r] + p1[r]; } \
        lrun += rs; \
        { u32x4 w; \
          w.x = pk2(p0[0], p0[1]); w.y = pk2(p0[2], p0[3]); w.z = pk2(p0[4], p0[5]); w.w = pk2(p0[6], p0[7]); pf[0] = __builtin_bit_cast(bf16x8, w); \
          w.x = pk2(p0[8], p0[9]); w.y = pk2(p0[10], p0[11]); w.z = pk2(p0[12], p0[13]); w.w = pk2(p0[14], p0[15]); pf[1] = __builtin_bit_cast(bf16x8, w); \
          w.x = pk2(p1[0], p1[1]); w.y = pk2(p1[2], p1[3]); w.z = pk2(p1[4], p1[5]); w.w = pk2(p1[6], p1[7]); pf[2] = __builtin_bit_cast(bf16x8, w); \
          w.x = pk2(p1[8], p1[9]); w.y = pk2(p1[10], p1[11]); w.z = pk2(p1[12], p1[13]); w.w = pk2(p1[14], p1[15]); pf[3] = __builtin_bit_cast(bf16x8, w); } } while (0)
#define ATT_VLD(i_) ({ const LAS unsigned char* vp_ = vbase + (32 * ((i_) & 3)) * VSTR + 32 * ((i_) >> 2); const u32x2 lo_ = *(const LAS u32x2*)vp_, hi_ = *(const LAS u32x2*)(vp_ + 16); (u32x4){lo_.x, lo_.y, hi_.x, hi_.y}; })
#define ATT_PV(vb_) do { const LAS unsigned char* vbase = (vb_) + ql * VSTR + 8 * g; u32x4 va = ATT_VLD(0), vb; \
        _Pragma("unroll") for (int i = 0; i < 16; i += 2) { \
            vb = ATT_VLD(i + 1); __builtin_amdgcn_sched_barrier(0); \
            oacc[i & 3] = mfma32(__builtin_bit_cast(bf16x8, va), pf[i >> 2], oacc[i & 3]); \
            if (i + 2 < 16) va = ATT_VLD(i + 2); __builtin_amdgcn_sched_barrier(0); \
            oacc[(i + 1) & 3] = mfma32(__builtin_bit_cast(bf16x8, vb), pf[(i + 1) >> 2], oacc[(i + 1) & 3]); } } while (0)
    const int wv = __builtin_amdgcn_readfirstlane(tid >> 6);
    f32x16 p0, p1; bf16x8 pf[4];
    __syncthreads();
    ATT_GLOAD(t0); ATT_LSTORE(0, 0);
    __syncthreads();
    const LAS unsigned char* vring = lds + 2 * KBYTES;
    if (wv < 4) {
        int vs = 0;
        for (int t = t0; t < t1; ++t) {
            if (t + 1 < t1) ATT_GLOAD(t + 1);
            const int bsel = (t - t0) & 1; const int vnext = vs == 2 ? 0 : vs + 1;
            ATT_QK(lds + bsel * KBYTES); ATT_SM(); ATT_PV(vring + vs * VBYTES);
            if (t + 1 < t1) ATT_LSTORE(bsel ^ 1, vnext);
            vs = vnext;
            __syncthreads();
        }
    } else {
        int vs = 0;
        for (int t = t0; t < t1; ++t) {
            const int bsel = (t - t0) & 1; const int vprev = vs == 0 ? 2 : vs - 1, vnext = vs == 2 ? 0 : vs + 1;
            if (t > t0) ATT_PV(vring + vprev * VBYTES);
            if (t + 1 < t1) ATT_GLOAD(t + 1);
            ATT_QK(lds + bsel * KBYTES); ATT_SM();
            if (t + 1 < t1) ATT_LSTORE(bsel ^ 1, vnext);
            vs = vnext;
            __syncthreads();
        }
        { const int vlast = vs == 0 ? 2 : vs - 1; ATT_PV(vring + vlast * VBYTES); }
    }
    __syncthreads();
#undef ATT_QK
#undef ATT_KLD
#undef ATT_KLD1
#undef ATT_SM
#undef ATT_PV
#undef ATT_VLD
#undef ATT_GLOAD
#undef ATT_LSTORE
    const float lt = lrun + __shfl_xor(lrun, 32), inv = 1.f / lt;
    LAS unsigned char* ob = lds + wave * (32 * OSTR);
#pragma unroll
    for (int db = 0; db < 4; ++db)
#pragma unroll
        for (int rg = 0; rg < 4; ++rg) { const float o0 = oacc[db][4 * rg] * inv, o1 = oacc[db][4 * rg + 1] * inv, o2 = oacc[db][4 * rg + 2] * inv, o3 = oacc[db][4 * rg + 3] * inv;
            u32x2 o; o.x = pk2(o0, o1); o.y = pk2(o2, o3); *(LAS u32x2*)(ob + ql * OSTR + (32 * db + 8 * rg + 4 * g) * 2) = o; }
    LDS_WAIT(); asm volatile("" ::: "memory");
    bf16* dst; int pitch;
    if (part < 0) { dst = (bf16*)(a.ws + WS_Y) + (size_t)tq0 * DM + 1024 + h * 128; pitch = DM; }
    else { const size_t rec = ((size_t)((part * 16 + b * 8 + h) * 8 + (qb - 8)) * 256 + wave * 32); dst = (bf16*)(a.ws + WS_MB) + rec * 128; pitch = 128;
        if (g == 0) { float* ml = (float*)(a.ws + WS_ML) + (rec + ql) * 2; ml[0] = mrun; ml[1] = lt; } }
#pragma unroll
    for (int i = 0; i < 8; ++i) { const int cid = lane + 64 * i, row = cid >> 4, cc = cid & 15; const u32x4 v = *(const LAS u32x4*)(ob + row * OSTR + cc * 16);
        *(u32x4*)(dst + (size_t)row * pitch + cc * 8) = v; }
}
__device__ __forceinline__ void attn_queue(const Args& a, LAS unsigned char* lds, unsigned* ctr) {
    int tid_o = threadIdx.x; asm volatile("" : "+v"(tid_o)); const int tid = tid_o; const int grp = (int)((unsigned)__builtin_amdgcn_s_getreg((3 << 11) | 20) & 7u);
    volatile LAS unsigned* slot = (volatile LAS unsigned*)(lds + 131072 + 160);
    for (;;) {
        if (tid == 0) *slot = __hip_atomic_fetch_add(ctr + grp, 1u, __ATOMIC_RELAXED, __HIP_MEMORY_SCOPE_AGENT);
        __syncthreads();
        const int idx = (int)*slot;
        if (idx >= 48) break;
        const int bh = 2 * grp + (idx >= 24 ? 1 : 0), k = idx >= 24 ? idx - 24 : idx; int qb, part;
        if (k < 20) { const int j = k / 5, r = k % 5; if (r == 0) { qb = 7 - j; part = -1; } else if (r < 3) { qb = 15 - 2 * j; part = r - 1; } else { qb = 14 - 2 * j; part = r - 3; } }
        else { qb = 23 - k; part = -1; }
        const int nt = 4 * (qb + 1);
        attn_item(a, lds, bh >> 3, bh & 7, qb, part == 1 ? nt / 2 : 0, part == 0 ? nt / 2 : nt, part);
    }
}
__device__ __forceinline__ void mla_finish(const Args& a) {
    int tid_o = threadIdx.x; asm volatile("" : "+v"(tid_o)); const int tid = tid_o, lane = tid & 63, wave = tid >> 6; const int gw = blockIdx.x * NWAVES + wave, NGW = gridDim.x * NWAVES;
    bf16* y = (bf16*)(a.ws + WS_Y); const bf16* po = (const bf16*)(a.ws + WS_MB); const float* ml = (const float*)(a.ws + WS_ML);
    for (int row = gw; row < MT; row += NGW) { const int b = row >> 12, pos = row & 4095, qb = pos >> 8, r = pos & 255; float o0[8], o1[8];
        if (qb < 8) {
#pragma unroll
            for (int h = 0; h < 8; ++h) { const unsigned u = *(const unsigned*)(y + (size_t)row * DM + 1024 + h * 128 + 2 * lane); o0[h] = __builtin_bit_cast(float, u << 16); o1[h] = __builtin_bit_cast(float, u & 0xffff0000u); }
        } else {
            unsigned ua[8], ub[8]; float ma[8], la[8], mb_[8], lb_[8];
#pragma unroll
            for (int h = 0; h < 8; ++h) { const size_t ra = (size_t)((0 * 16 + b * 8 + h) * 8 + (qb - 8)) * 256 + r, rb = (size_t)((1 * 16 + b * 8 + h) * 8 + (qb - 8)) * 256 + r;
                ua[h] = *(const unsigned*)(po + ra * 128 + 2 * lane); ub[h] = *(const unsigned*)(po + rb * 128 + 2 * lane);
                ma[h] = ml[ra * 2]; la[h] = ml[ra * 2 + 1]; mb_[h] = ml[rb * 2]; lb_[h] = ml[rb * 2 + 1]; }
#pragma unroll
            for (int h = 0; h < 8; ++h) { const float m = fmaxf(ma[h], mb_[h]); const float wa = la[h] * __builtin_amdgcn_exp2f(ma[h] - m), wb = lb_[h] * __builtin_amdgcn_exp2f(mb_[h] - m), iw = 1.f / (wa + wb);
                o0[h] = (wa * __builtin_bit_cast(float, ua[h] << 16) + wb * __builtin_bit_cast(float, ub[h] << 16)) * iw;
                o1[h] = (wa * __builtin_bit_cast(float, ua[h] & 0xffff0000u) + wb * __builtin_bit_cast(float, ub[h] & 0xffff0000u)) * iw; }
        }
        float ss = 0.f;
#pragma unroll
        for (int h = 0; h < 8; ++h) ss += o0[h] * o0[h] + o1[h] * o1[h];
        ss = wave_sum(ss); const float rs = 1.f / sqrtf(ss * (1.f / 1024.f) + EPS);
#pragma unroll
        for (int h = 0; h < 8; ++h) *(unsigned*)(y + (size_t)row * DM + 1024 + h * 128 + 2 * lane) = pk2(o0[h] * rs, o1[h] * rs);
    }
}
#define XB_TMO      128
#define XB_XCNT(j)  (256  + 64 * (j))
#define XB_XSUB(j)  (1280 + 64 * (j))
#define XB_XGEN(j)  (2304 + 64 * (j))
#define XB_TOP      3328
#define XB_TOPGEN   3392
#define XCD_BAR_WORDS 3456
#define XB_SPIN_CAP (1u << 18)

__device__ __forceinline__ unsigned xb_ld(unsigned* p)              { return __hip_atomic_load(p, __ATOMIC_RELAXED, __HIP_MEMORY_SCOPE_AGENT); }
__device__ __forceinline__ unsigned xb_add(unsigned* p, unsigned v) { return __hip_atomic_fetch_add(p, v, __ATOMIC_RELAXED, __HIP_MEMORY_SCOPE_AGENT); }
__device__ __forceinline__ unsigned xb_xcc_id() { return (unsigned)__builtin_amdgcn_s_getreg((3 << 11) | 20) & 0xFu; }
#define XB_SPIN(cond, bar) do { unsigned _sp = 0; while (cond) { __builtin_amdgcn_s_sleep(1); \
    if ((++_sp & 255u) == 0u) { if (xb_ld(&(bar)[XB_TMO])) break; if (_sp > XB_SPIN_CAP) { atomicAdd(&(bar)[XB_TMO], 1u); break; } } } } while (0)

struct XcdBarrier {
    unsigned* bar; unsigned x;
    volatile LAS unsigned* st;
};

__device__ __forceinline__ XcdBarrier xcd_barrier_post(unsigned* bar, volatile LAS unsigned* st) {
    XcdBarrier b; b.bar = bar; b.x = xb_xcc_id(); b.st = st;
    if (threadIdx.x == 0) (void)xb_add(&bar[XB_XCNT(b.x)], 1u);
    return b;
}
__device__ __forceinline__ void xcd_barrier_complete(unsigned* bar, unsigned x, unsigned& nloc, unsigned& nx) {
    const unsigned G = gridDim.x * gridDim.y * gridDim.z;
    unsigned sum, cnt, mine, sp = 0u;
    for (;;) {
        sum = 0u; cnt = 0u; mine = 0u;
#pragma unroll
        for (unsigned j = 0; j < 16; ++j) { const unsigned c = xb_ld(&bar[XB_XCNT(j)]); sum += c; cnt += (c > 0u) ? 1u : 0u; mine = (j == x) ? c : mine; }
        if (sum == G) break;
        __builtin_amdgcn_s_sleep(1);
        if ((++sp & 255u) == 0u) { if (xb_ld(&bar[XB_TMO])) break; if (sp > XB_SPIN_CAP) { atomicAdd(&bar[XB_TMO], 1u); break; } }
    }
    nloc = mine > 0u ? mine : 1u; nx = cnt > 0u ? cnt : 1u;
}

__device__ __forceinline__ void xcd_barrier(const XcdBarrier& b) {
    asm volatile("s_waitcnt vmcnt(0)" ::: "memory");
    __syncthreads();
    if (threadIdx.x == 0) {
        unsigned* bar = b.bar;
        __builtin_amdgcn_s_waitcnt(0);
        unsigned nloc = b.st[0], nx = b.st[1];
        if (nloc == 0u) { xcd_barrier_complete(bar, b.x, nloc, nx); b.st[0] = nloc; b.st[1] = nx; }
        const unsigned old = xb_add(&bar[XB_XSUB(b.x)], 1u);
        const unsigned gen = old / nloc;
        if (old + 1u == (gen + 1u) * nloc) {
            __builtin_amdgcn_fence(__ATOMIC_RELEASE, "agent");
            asm volatile("s_waitcnt vmcnt(0)" ::: "memory");
            const unsigned og = xb_add(&bar[XB_TOP], 1u);
            const unsigned tg = og / nx;
            if (og + 1u == (tg + 1u) * nx) xb_add(&bar[XB_TOPGEN], 1u);
            else XB_SPIN(xb_ld(&bar[XB_TOPGEN]) == tg, bar);
            __builtin_amdgcn_fence(__ATOMIC_ACQUIRE, "agent");
            xb_add(&bar[XB_XGEN(b.x)], 1u);
            asm volatile("s_waitcnt vmcnt(0)" ::: "memory");
        } else {
            XB_SPIN(xb_ld(&bar[XB_XGEN(b.x)]) == gen, bar);
            __builtin_amdgcn_fence(__ATOMIC_ACQUIRE, "agent");
            asm volatile("s_waitcnt vmcnt(0)" ::: "memory");
        }
    }
    __syncthreads();
}


constexpr int N_PHASES = 1 + 9 * DEPTH;
#ifndef DBG_REP
#define DBG_REP 0
#endif
#define NREP(j) (1 + ((DBG_REP >> (j)) & 1))
#ifndef DBG_MASK
#define DBG_MASK 0x3ff
#endif
#define EN(j) ((DBG_MASK >> (j)) & 1)
__device__ __forceinline__ const Args* args_here() { const Args* p = (const Args*)__builtin_amdgcn_kernarg_segment_ptr(); asm volatile("" : "+s"(p)); return p; }
#define PH_ARGS Args a = a_in; { __attribute__((address_space(1))) unsigned char* w_ = (__attribute__((address_space(1))) unsigned char*)a.ws; asm volatile("" : "+s"(w_)); a.ws = (unsigned char*)w_; } unsigned char* const ws = a.ws; (void)ws
__global__ void __launch_bounds__(NTHR, 2) mega_fwd(Args a_in) {
    extern __shared__ __attribute__((aligned(16))) unsigned char lds_raw[];
    LAS unsigned char* lds = (LAS unsigned char*)lds_raw;
    cg::grid_group grid = cg::this_grid();
    volatile LAS unsigned* bst = (volatile LAS unsigned*)(lds + 131072 + 64);
    if (threadIdx.x < 2) bst[threadIdx.x] = 0u;
    __syncthreads();
    XcdBarrier bar = xcd_barrier_post((unsigned*)(a_in.ws + WS_BAR), bst);
    const int G = gridDim.x, bid = blockIdx.x;
    const int lo = a_in.ph_lo, hi = a_in.ph_hi;
#define IN(k) (lo <= (k) && (k) < hi)
#define SEAM(k) do { if (IN((k) + 1)) { if ((k) == 0) grid.sync(); else { XcdBarrier b2 = bar; asm volatile("" : "+s"(b2.bar)); xcd_barrier(b2); } } } while (0)
    if (IN(0) && EN(0)) for (int rep = 0; rep < NREP(0); ++rep) { PH_ARGS; p0_prologue(a, lds); SEAM(0); }
    for (int l = 0; l < DEPTH; ++l) {
        const int P = 1 + 9 * l;
        if (IN(P) && EN(1)) for (int rep = 0; rep < NREP(1); ++rep) {
            PH_ARGS; const bf16* wl = (const bf16*)(ws + WS_W) + (size_t)l * W_LAYER;
            pg8::Gemm gm{(const bf16*)(ws + WS_XB), wl + W_IN, MT, NIN, DM, DM, DM}; pg8::StaticOrder S; S.init(MT, NIN, G, bid);
            pg8::EpiRow E{(bf16*)(ws + WS_PROJ), NIN, (const float*)(ws + WS_RSTD), 0, 0, 0.f, EPS, (float*)(ws + WS_PS_QKV), 16, 14, 18};
            pg8::gemm_phase<pg8::EpiRow, pg8::StaticOrder, true, true>(lds, gm, S, E); SEAM(P); }
        if (IN(P + 1) && EN(2)) for (int rep = 0; rep < NREP(2); ++rep) {
#define P1_ARGS PH_ARGS; const bf16* wl = (const bf16*)(ws + WS_W) + (size_t)l * W_LAYER; const bf16* proj = (const bf16*)(ws + WS_PROJ); float* ps_qkv = (float*)(ws + WS_PS_QKV); (void)wl; (void)proj; (void)ps_qkv
            { P1_ARGS; pg8::Gemm gm{proj + C_QC, wl + W_Q, MT, 1536, 512, NIN, 512}; pg8::StaticOrder S; S.init(MT, 1536, G, bid);
              pg8::EpiQ E{(bf16*)(ws + WS_Q), ps_qkv, EPS, QSCALE, (const float*)(ws + WS_COS), (const float*)(ws + WS_SIN)};
              pg8::gemm_phase<pg8::EpiQ, pg8::StaticOrder, true, true>(lds, gm, S, E); }
            { P1_ARGS; pg8::Gemm gm{proj + C_KVC, wl + W_K, MT, 1024, 512, NIN, 512}; pg8::StaticOrder S; S.init(MT, 1024, G, (bid + 64) % G);
              pg8::EpiRow E{(bf16*)(ws + WS_KN), 1024, ps_qkv + 8, 16, 8, 1.f / 512.f, EPS, nullptr, 0, 0, 0};
              pg8::gemm_phase<pg8::EpiRow, pg8::StaticOrder, true, true>(lds, gm, S, E); }
            { P1_ARGS; pg8::Gemm gm{wl + W_V, proj + C_KVC, 1024, MT, 512, 512, NIN}; pg8::StaticOrder S; S.init(1024, MT, G, (bid + 192) % G);
              pg8::EpiVT E{(bf16*)(ws + WS_VT), MT, ps_qkv, EPS};
              pg8::gemm_phase<pg8::EpiVT, pg8::StaticOrder, true, true>(lds, gm, S, E); }
            { PH_ARGS; kpe_rope(a); }
            __syncthreads();
            PH_ARGS;
            for (int it = bid; it < 1024; it += G) { if (it < 512) gla_local_item<0>(a, lds, l, it >> 6, it & 63); else gla_local_item<1>(a, lds, l, (it - 512) >> 6, it & 63); }
            SEAM(P + 1); }
        if (IN(P + 2) && EN(3)) for (int rep = 0; rep < NREP(3); ++rep) {
            PH_ARGS;
            for (int it = bid; it < 96; it += G) scan_item(a, it);
            attn_queue(a, lds, (unsigned*)(ws + WS_BAR) + 8 + 8 * l);
            if (l + 1 < DEPTH && rep == 0) conv_layer(a, l + 1, lds, (unsigned*)(ws + WS_BAR) + l);
            SEAM(P + 2); }
        if (IN(P + 3) && EN(4)) for (int rep = 0; rep < NREP(4); ++rep) {
            PH_ARGS;
            for (int it = bid; it < 256; it += G) gla_final_item(a, l, it);
            if (rep + 1 == NREP(4)) mla_finish(a);
            SEAM(P + 3); }
        if (IN(P + 4) && EN(5)) for (int rep = 0; rep < NREP(5); ++rep) {
            PH_ARGS; const bf16* wl = (const bf16*)(ws + WS_W) + (size_t)l * W_LAYER;
            pg8::Gemm gm{(const bf16*)(ws + WS_Y), wl + W_OUT, MT, DM, DM, DM, DM}; pg8::StaticOrder S; S.init(MT, DM, G, bid);
            pg8::EpiRow E{(bf16*)(ws + WS_MB), DM, nullptr, 0, 0, 0.f, EPS, (float*)(ws + WS_PS_M), 32, 0, 8};
            pg8::gemm_phase<pg8::EpiRow, pg8::StaticOrder, true, true>(lds, gm, S, E); SEAM(P + 4); }
        if (IN(P + 5) && EN(6)) { PH_ARGS; rowpass(l == 0 ? a.x : a.out, a.out, (const bf16*)(ws + WS_MB), (const float*)(ws + WS_PS_M), a.attn_post + l * DM, (bf16*)(ws + WS_XB), (float*)(ws + WS_RSTD)); SEAM(P + 5); }
        if (IN(P + 6) && EN(7)) for (int rep = 0; rep < NREP(7); ++rep) {
            PH_ARGS; const bf16* wl = (const bf16*)(ws + WS_W) + (size_t)l * W_LAYER;
            pg8::Gemm gm{(const bf16*)(ws + WS_XB), wl + W_GU, MT, NGU, DM, DM, DM}; pg8::StaticOrder S; S.init(MT, NGU, G, bid);
            pg8::EpiGU E{(bf16*)(ws + WS_HDN), DFF, (const float*)(ws + WS_RSTD)};
            pg8::gemm_phase<pg8::EpiGU, pg8::StaticOrder, true, true>(lds, gm, S, E); SEAM(P + 6); }
        if (IN(P + 7) && EN(8)) for (int rep = 0; rep < NREP(8); ++rep) {
            PH_ARGS; const bf16* wl = (const bf16*)(ws + WS_W) + (size_t)l * W_LAYER;
            pg8::Gemm gm{(const bf16*)(ws + WS_HDN), wl + W_DN, MT, DM, DFF, DFF, DFF}; pg8::StaticOrder S; S.init(MT, DM, G, bid);
            pg8::EpiRow E{(bf16*)(ws + WS_MB), DM, nullptr, 0, 0, 0.f, EPS, (float*)(ws + WS_PS_M), 32, 0, 8};
            pg8::gemm_phase<pg8::EpiRow, pg8::StaticOrder, true, true>(lds, gm, S, E); SEAM(P + 7); }
        if (IN(P + 8) && EN(9)) { PH_ARGS; rowpass(a.out, a.out, (const bf16*)(ws + WS_MB), (const float*)(ws + WS_PS_M), a.ffn_post + l * DM, (bf16*)(ws + WS_XB), (float*)(ws + WS_RSTD)); if (l + 1 < DEPTH) SEAM(P + 8); }
    }
#undef IN
#undef SEAM
}

extern "C" void kernel_launch(void* const* d_in, const int* in_sizes, int n_in, void* d_out, int out_size, void* d_ws, size_t ws_size, hipStream_t stream) {
    static int grid = 0;
    if (grid == 0) {
        if (n_in != 21 || in_sizes[0] != MT * DM || out_size != MT * DM || ws_size < WS_END) { fprintf(stderr, "kernel_launch: unexpected shapes (n_in %d, in0 %d, out %d, ws %zu, need %zu)\n", n_in, n_in > 0 ? in_sizes[0] : -1, out_size, ws_size, (size_t)WS_END); grid = -1; return; }
        int dev = 0, cus = 0, per_cu = 0;
        hipGetDevice(&dev); hipDeviceGetAttribute(&cus, hipDeviceAttributeMultiprocessorCount, dev);
        if (hipFuncSetAttribute((const void*)mega_fwd, hipFuncAttributeMaxDynamicSharedMemorySize, LDS_BYTES) != hipSuccess) { fprintf(stderr, "kernel_launch: hipFuncSetAttribute failed\n"); grid = -1; return; }
        if (hipOccupancyMaxActiveBlocksPerMultiprocessor(&per_cu, (const void*)mega_fwd, NTHR, LDS_BYTES) != hipSuccess || per_cu < 1) { fprintf(stderr, "kernel_launch: occupancy query says %d blocks per CU\n", per_cu); (void)hipGetLastError(); per_cu = 1; }
        grid = cus > 0 ? cus : 256;
    }
    if (grid < 0) return;
    Args a{};
    a.x = (const float*)d_in[0]; a.pos = (const int*)d_in[1]; a.attn_pre = (const float*)d_in[2]; a.w_in = (const float*)d_in[3]; a.gate_w2 = (const float*)d_in[4]; a.gate_b = (const float*)d_in[5];
    a.gla_norm = (const float*)d_in[6]; a.lb_logits = (const float*)d_in[7]; a.hgrn_norm = (const float*)d_in[8]; a.q_norm = (const float*)d_in[9]; a.wq_b = (const float*)d_in[10]; a.kv_norm = (const float*)d_in[11];
    a.wkv_b = (const float*)d_in[12]; a.mla_out_norm = (const float*)d_in[13]; a.w_out = (const float*)d_in[14]; a.attn_post = (const float*)d_in[15]; a.ffn_pre = (const float*)d_in[16];
    a.w_gate = (const float*)d_in[17]; a.w_up = (const float*)d_in[18]; a.w_down = (const float*)d_in[19]; a.ffn_post = (const float*)d_in[20]; a.out = (float*)d_out; a.ws = (unsigned char*)d_ws;
    if (hipMemsetAsync((char*)d_ws + WS_BAR, 0, BAR_BYTES, stream) != hipSuccess) { fprintf(stderr, "kernel_launch: memset failed\n"); return; }
#if MK_PER_PHASE
    for (int p = 0; p < N_PHASES; ++p) { a.ph_lo = p; a.ph_hi = p + 1; hipLaunchKernelGGL(mega_fwd, dim3(grid), dim3(NTHR), LDS_BYTES, stream, a); }
#else
    a.ph_lo = 0; a.ph_hi = N_PHASES; void* args[] = {&a};
    hipError_t e = hipLaunchCooperativeKernel((const void*)mega_fwd, dim3(grid), dim3(NTHR), args, LDS_BYTES, stream);
    if (e != hipSuccess) fprintf(stderr, "kernel_launch: cooperative launch failed: %s (grid %d)\n", hipGetErrorString(e), grid);
#endif
}
```
